# Optimizing an MI355X kernel written in HIP

```python
import math
import jax, jax.numpy as jnp
from jax import lax
import numpy as np

D_MODEL = 1024
BATCH = 8
SEQ = 2048
DEPTH = 1

PLE_DIM = 256
EPS = 1e-6
N_HEADS_MLA = 8
QK_NOPE_DIM = 64
QK_ROPE_DIM = 32
QK_HEAD_DIM = QK_NOPE_DIM + QK_ROPE_DIM
V_HEAD_DIM = 64
Q_LORA_RANK = 768
KV_LORA_RANK = 256
MLA_WIDTH = N_HEADS_MLA * V_HEAD_DIM
ROPE_BASE = 10000.0
Q_BLOCK = 128
HYENA_WIDTH = 512
FILTER_EMB_DIM = 33
FILTER_ORDER = 64
DECAY_TARGET = 1e-2
FAST_DECAY_PCT = 0.3
SLOW_DECAY_PCT = 1.5
MIX_WIDTH = MLA_WIDTH + HYENA_WIDTH
IN_PROJ_WIDTH = Q_LORA_RANK + KV_LORA_RANK + QK_ROPE_DIM + 3 * HYENA_WIDTH
D_FF = 2816

kernel_name = "hybrid_mla_hyena_convffn_ple_block"


def _rmsnorm(x, g):
    xf = x.astype(jnp.float32)
    y = xf * lax.rsqrt(jnp.mean(xf * xf, axis=-1, keepdims=True) + EPS)
    return (y * g.astype(jnp.float32)).astype(x.dtype)


def _dwconv3(x, w, b):
    xp = jnp.pad(x, ((0, 0), (1, 1), (0, 0)))
    return xp[:, :-2] * w[0] + xp[:, 1:-1] * w[1] + xp[:, 2:] * w[2] + b


def _rope(x, cos, sin):
    x1, x2 = jnp.split(x.astype(jnp.float32), 2, axis=-1)
    return jnp.concatenate([x1 * cos - x2 * sin, x2 * cos + x1 * sin], axis=-1).astype(x.dtype)


def _block_attention(q, k, v):
    B, S, H, Dq = q.shape
    nb = S // Q_BLOCK
    qb = q.reshape(B, nb, Q_BLOCK, H, Dq).transpose(1, 0, 2, 3, 4)
    scale = Dq ** -0.5

    def one_block(qi):
        s = jnp.einsum('bqhd,bkhd->bhqk', qi, k, preferred_element_type=jnp.float32) * scale
        w = jax.nn.softmax(s, axis=-1).astype(v.dtype)
        return jnp.einsum('bhqk,bkhd->bqhd', w, v)

    o = lax.map(one_block, qb)
    return o.transpose(1, 0, 2, 3, 4).reshape(B, S, H, v.shape[-1])


def _hyena_filters(L, w1, b1, w2, b2, w3, b3, w_out, freq):
    f32 = jnp.float32
    t = jnp.linspace(0.0, 1.0, L, dtype=f32)[:, None]
    bands = (FILTER_EMB_DIM - 1) // 2
    fb = jnp.linspace(1e-4, bands - 1, bands, dtype=f32)
    w = 2.0 * math.pi * jnp.arange(L, dtype=f32) / L
    ang = w[:, None] * fb[None, :]
    z = jnp.concatenate([t, jnp.cos(ang), -jnp.sin(ang)], axis=-1)
    fr = freq.astype(f32)
    h = jnp.sin(fr * (z @ w1.astype(f32) + b1.astype(f32)))
    h = jnp.sin(fr * (h @ w2.astype(f32) + b2.astype(f32)))
    h = jnp.sin(fr * (h @ w3.astype(f32) + b3.astype(f32)))
    h = h @ w_out.astype(f32)
    min_decay = math.log(DECAY_TARGET) / FAST_DECAY_PCT
    max_decay = math.log(DECAY_TARGET) / SLOW_DECAY_PCT
    deltas = jnp.abs(jnp.linspace(min_decay, max_decay, HYENA_WIDTH, dtype=f32))
    decay = jnp.exp(-t * deltas[None, :])
    h = h.reshape(L, 2, HYENA_WIDTH) * decay[:, None, :]
    return h[:, 0], h[:, 1]


def _bidir_long_conv(u, h_fwd, h_bwd, bias):
    B, L, C = u.shape
    n = 2 * L
    kcirc = jnp.concatenate([h_fwd, jnp.zeros((1, C), jnp.float32), h_bwd[1:][::-1]], axis=0)
    uf32 = u.astype(jnp.float32)
    uf = jnp.fft.rfft(uf32, n=n, axis=1)
    kf = jnp.fft.rfft(kcirc, n=n, axis=0)
    y = jnp.fft.irfft(uf * kf[None], n=n, axis=1)[:, :L]
    return (y + uf32 * bias.astype(jnp.float32)).astype(u.dtype)


def setup_inputs(seed: int = 0) -> dict:
    key = jax.random.key(seed)
    ks = iter(jax.random.split(key, 40))

    def nrm(shape, scale):
        return jax.random.normal(next(ks), shape, jnp.float32) * scale

    def gain(n):
        return 1.0 + nrm((DEPTH, n), 0.01)

    return {
        "x": nrm((BATCH, SEQ, D_MODEL), 1.0),
        "p": nrm((DEPTH, BATCH, SEQ, PLE_DIM), 1.0),
        "norm_mix": gain(D_MODEL),
        "w_in": nrm((DEPTH, D_MODEL, IN_PROJ_WIDTH), D_MODEL ** -0.5),
        "short_conv_w": nrm((DEPTH, 3, 3 * HYENA_WIDTH), 3 ** -0.5),
        "short_conv_b": nrm((DEPTH, 3 * HYENA_WIDTH), 0.01),
        "q_norm": gain(Q_LORA_RANK),
        "w_uq": nrm((DEPTH, Q_LORA_RANK, N_HEADS_MLA * QK_HEAD_DIM), Q_LORA_RANK ** -0.5),
        "kv_norm": gain(KV_LORA_RANK),
        "w_ukv": nrm((DEPTH, KV_LORA_RANK, N_HEADS_MLA * (QK_NOPE_DIM + V_HEAD_DIM)), KV_LORA_RANK ** -0.5),
        "qk_norm_q": gain(QK_HEAD_DIM),
        "qk_norm_k": gain(QK_HEAD_DIM),
        "filt_w1": nrm((DEPTH, FILTER_EMB_DIM, FILTER_ORDER), FILTER_EMB_DIM ** -0.5),
        "filt_b1": nrm((DEPTH, FILTER_ORDER), 0.01),
        "filt_w2": nrm((DEPTH, FILTER_ORDER, FILTER_ORDER), FILTER_ORDER ** -0.5),
        "filt_b2": nrm((DEPTH, FILTER_ORDER), 0.01),
        "filt_w3": nrm((DEPTH, FILTER_ORDER, FILTER_ORDER), FILTER_ORDER ** -0.5),
        "filt_b3": nrm((DEPTH, FILTER_ORDER), 0.01),
        "filt_w_out": nrm((DEPTH, FILTER_ORDER, 2 * HYENA_WIDTH), FILTER_ORDER ** -0.5),
        "filt_freq": gain(FILTER_ORDER),
        "hyena_bias": nrm((DEPTH, HYENA_WIDTH), 1.0),
        "out_norm_attn": gain(MLA_WIDTH),
        "out_norm_hyena": gain(HYENA_WIDTH),
        "w_out": nrm((DEPTH, MIX_WIDTH, D_MODEL), MIX_WIDTH ** -0.5),
        "norm_ffn": gain(D_MODEL),
        "w_up": nrm((DEPTH, D_MODEL, 2 * D_FF), D_MODEL ** -0.5),
        "ffn_conv_w": nrm((DEPTH, 3, 2 * D_FF), 3 ** -0.5),
        "ffn_conv_b": nrm((DEPTH, 2 * D_FF), 0.01),
        "w_down": nrm((DEPTH, D_FF, D_MODEL), D_FF ** -0.5),
        "w_ple": nrm((DEPTH, PLE_DIM, D_MODEL), PLE_DIM ** -0.5),
        "w_ple_gate": nrm((DEPTH, D_MODEL, D_MODEL), D_MODEL ** -0.5),
        "ple_norm": gain(D_MODEL),
    }


def reference(x, p, norm_mix, w_in, short_conv_w, short_conv_b, q_norm, w_uq, kv_norm, w_ukv,
              qk_norm_q, qk_norm_k, filt_w1, filt_b1, filt_w2, filt_b2, filt_w3, filt_b3,
              filt_w_out, filt_freq, hyena_bias, out_norm_attn, out_norm_hyena, w_out,
              norm_ffn, w_up, ffn_conv_w, ffn_conv_b, w_down, w_ple, w_ple_gate, ple_norm):
    B, S, _ = x.shape
    H = N_HEADS_MLA
    pos = jnp.arange(S, dtype=jnp.float32)
    inv_freq = ROPE_BASE ** (-jnp.arange(0, QK_ROPE_DIM, 2, dtype=jnp.float32) / QK_ROPE_DIM)
    ang = pos[:, None] * inv_freq[None, :]
    cos = jnp.cos(ang)[:, None, :]
    sin = jnp.sin(ang)[:, None, :]
    c1 = Q_LORA_RANK
    c2 = c1 + KV_LORA_RANK
    c3 = c2 + QK_ROPE_DIM

    for i in range(DEPTH):
        h = _rmsnorm(x, norm_mix[i])
        proj = h @ w_in[i]
        c_q, c_kv, k_pe, u_h = proj[..., :c1], proj[..., c1:c2], proj[..., c2:c3], proj[..., c3:]

        q = (_rmsnorm(c_q, q_norm[i]) @ w_uq[i]).reshape(B, S, H, QK_HEAD_DIM)
        kv = (_rmsnorm(c_kv, kv_norm[i]) @ w_ukv[i]).reshape(B, S, H, QK_NOPE_DIM + V_HEAD_DIM)
        k_nope, v = kv[..., :QK_NOPE_DIM], kv[..., QK_NOPE_DIM:]
        k_pe_h = jnp.broadcast_to(k_pe[:, :, None, :], (B, S, H, QK_ROPE_DIM))
        k = jnp.concatenate([k_nope, k_pe_h], axis=-1)
        q = _rmsnorm(q, qk_norm_q[i])
        k = _rmsnorm(k, qk_norm_k[i])
        q = jnp.concatenate([q[..., :QK_NOPE_DIM], _rope(q[..., QK_NOPE_DIM:], cos, sin)], axis=-1)
        k = jnp.concatenate([k[..., :QK_NOPE_DIM], _rope(k[..., QK_NOPE_DIM:], cos, sin)], axis=-1)
        y_attn = _block_attention(q, k, v).reshape(B, S, MLA_WIDTH)

        u_h = _dwconv3(u_h, short_conv_w[i], short_conv_b[i])
        x0, x1, vh = jnp.split(u_h, 3, axis=-1)
        h_fwd, h_bwd = _hyena_filters(S, filt_w1[i], filt_b1[i], filt_w2[i], filt_b2[i],
                                      filt_w3[i], filt_b3[i], filt_w_out[i], filt_freq[i])
        y_hyena = x0 * _bidir_long_conv(x1 * vh, h_fwd, h_bwd, hyena_bias[i])

        y_mix = jnp.concatenate([_rmsnorm(y_attn, out_norm_attn[i]),
                                 _rmsnorm(y_hyena, out_norm_hyena[i])], axis=-1)
        x = x + y_mix @ w_out[i]

        h = _rmsnorm(x, norm_ffn[i])
        up = _dwconv3(h @ w_up[i], ffn_conv_w[i], ffn_conv_b[i])
        g, u = up[..., :D_FF], up[..., D_FF:]
        x = x + (jax.nn.silu(g) * u) @ w_down[i]

        e = _rmsnorm(p[i] @ w_ple[i], ple_norm[i])
        x = x + jax.nn.sigmoid(x @ w_ple_gate[i]) * e
    return x
```

```cpp
#include <hip/hip_runtime.h>
#include <hip/hip_cooperative_groups.h>
#include <cstdio>
namespace cg = cooperative_groups;

#ifndef N_LAUNCH_MODE
#define N_LAUNCH_MODE 1
#endif
#ifndef PROBE_REP
#define PROBE_REP -1
#endif
#ifndef NAIVE_ATTN
#define NAIVE_ATTN 0
#endif
#ifndef NAIVE_HYENA
#define NAIVE_HYENA 0
#endif

typedef unsigned short bf16_t;
typedef short bf16x8 __attribute__((ext_vector_type(8)));
typedef float f32x4 __attribute__((ext_vector_type(4)));
typedef float f32x16 __attribute__((ext_vector_type(16)));
typedef unsigned u32x4 __attribute__((ext_vector_type(4)));
typedef unsigned u32x2 __attribute__((ext_vector_type(2)));
#define LAS __attribute__((address_space(3)))
#define DI __device__ __forceinline__

constexpr int MTOK = 16384, SEQ = 2048, NB = 8, DM = 1024, PLE = 256;
constexpr int NH = 8, QKD = 96, NOPE = 64, ROPE = 32, VD = 64, QL = 768, KVL = 256;
constexpr int HYW = 512, INW = 2592, INWP = 2816, MLAW = 1056, DFF = 2816;
constexpr float EPS = 1e-6f;
constexpr int NTHREADS = 512;
constexpr int LDS_BYTES = 160 * 1024 - 4096;

constexpr size_t MiB = 1024 * 1024;
constexpr size_t WS_WIN = 0;
constexpr size_t WS_WUQ = WS_WIN + (size_t)INWP * DM * 2;
constexpr size_t WS_WUKV = WS_WUQ + (size_t)QL * QL * 2;
constexpr size_t WS_WOUT = WS_WUKV + (size_t)1024 * KVL * 2;
constexpr size_t WS_WUP = WS_WOUT + (size_t)DM * DM * 2;
constexpr size_t WS_WDOWN = WS_WUP + (size_t)2 * DFF * DM * 2;
constexpr size_t WS_WPLE = WS_WDOWN + (size_t)DM * DFF * 2;
constexpr size_t WS_WGATE = WS_WPLE + (size_t)DM * PLE * 2;
constexpr size_t WS_WEND = WS_WGATE + (size_t)DM * DM * 2;
static_assert(WS_WEND <= 29 * MiB, "weights");
constexpr size_t WS_STATS = 29 * MiB;
constexpr size_t WS_BAR = 29 * MiB + 512 * 1024;
constexpr size_t WS_KFIL = 30 * MiB;
constexpr size_t WS_PB = 34 * MiB;
constexpr size_t WS_X = 42 * MiB;
constexpr size_t WS_Y = 75 * MiB;
constexpr size_t WS_Z = 109 * MiB;
constexpr size_t WS_Q = 157 * MiB;
constexpr size_t WS_K = 181 * MiB;
constexpr size_t WS_V = 205 * MiB;
constexpr size_t WS_YHT = 221 * MiB;
constexpr size_t WS_YATT = 237 * MiB;
constexpr size_t WS_ACT = 141 * MiB;
constexpr size_t WS_KRAW2 = WS_YATT;

struct P {
    const float *x, *p, *norm_mix, *w_in, *sc_w, *sc_b, *q_norm, *w_uq, *kv_norm, *w_ukv, *qk_nq, *qk_nk,
        *f_w1, *f_b1, *f_w2, *f_b2, *f_w3, *f_b3, *f_wout, *f_freq, *hy_bias, *on_attn, *on_hy, *w_out,
        *norm_ffn, *w_up, *fc_w, *fc_b, *w_down, *w_ple, *w_gate, *ple_norm;
    float* out; unsigned char* ws;
};

DI int o_tid() { int t = threadIdx.x; asm volatile("" : "+v"(t)); return t; }
DI int o_bid() { int t = blockIdx.x; asm volatile("" : "+s"(t)); return t; }
DI int o_nb() { int t = gridDim.x; asm volatile("" : "+s"(t)); return t; }
DI bf16_t f2bf(float f) { unsigned u = __float_as_uint(f); u += 0x7FFFu + ((u >> 16) & 1u); return (bf16_t)(u >> 16); }
DI float bf2f(bf16_t b) { return __uint_as_float(((unsigned)b) << 16); }
typedef __bf16 bf16x2_t __attribute__((ext_vector_type(2)));
typedef float f32x2_t __attribute__((ext_vector_type(2)));
DI unsigned pkbf(float a, float b) { f32x2_t f = {a, b}; bf16x2_t h = __builtin_convertvector(f, bf16x2_t); return __builtin_bit_cast(unsigned, h); }
DI unsigned pk2(float lo, float hi) { return (unsigned)f2bf(lo) | ((unsigned)f2bf(hi) << 16); }
DI float lo2f(unsigned w) { return __uint_as_float(w << 16); }
DI float hi2f(unsigned w) { return __uint_as_float(w & 0xffff0000u); }

namespace pg8 {
constexpr int BM = 256, BK = 64, HALF = 128, HTB = HALF * BK * 2, STAGE_BYTES = 8 * HTB, NXCD = 8, WGM = 8;
__host__ __device__ __forceinline__ int lds_byte(int r, int c) { const int st = (r >> 4) * 2 + (c >> 5), rr = r & 15, cc = c & 31, ob = rr * 64 + cc * 2; return st * 1024 + (ob ^ (((ob >> 9) & 1) << 5)); }
__host__ __device__ __forceinline__ void stage_rc(int b, int& R, int& C) { const int st = b / 1024, sb = b % 1024, swz = sb ^ (((sb >> 9) & 1) << 5); R = (st >> 1) * 16 + swz / 64; C = (st & 1) * 32 + (swz % 64) / 2; }
__host__ __device__ __forceinline__ int perm32(int rho) { const int n = rho >> 4, i = rho & 15; return 8 * (i >> 2) + 4 * n + (i & 3); }
struct Unit { int pm, pn; };
struct Gemm { const bf16_t* A; const bf16_t* Bt; int K, lda, nM, nN, TS, GS; int ldb = 0; int rperm = 0; int permB = 1; };
struct StaticOrder {
    int nM, nN, nwg, G, c;
    __host__ __device__ void init(int nM_, int nN_, int G_, int c_) { nM = nM_; nN = nN_; nwg = nM * nN; G = G_; c = c_; }
    __host__ __device__ bool next(int i, Unit& u) const {
        const long L = (long)i * G + c; if (L >= nwg) return false;
        int wgid = (int)L; { const int q = nwg / NXCD, r = nwg % NXCD, xcd = wgid % NXCD, off = wgid / NXCD; wgid = (xcd < r ? xcd * (q + 1) : r * (q + 1) + (xcd - r) * q) + off; }
        const int nig = WGM * nN, gid = wgid / nig, fm = gid * WGM, gsz = (nM - fm) < WGM ? (nM - fm) : WGM;
        u.pm = fm + ((wgid % nig) % gsz); u.pn = (wgid % nig) / gsz; return true;
    }
};
DI unsigned cvt_pk_bf16(float lo, float hi) { unsigned r; asm volatile("v_cvt_pk_bf16_f32 %0, %1, %2" : "=v"(r) : "v"(lo), "v"(hi)); return r; }

template <class Epi>
__device__ __forceinline__ void gemm_phase(LAS unsigned char* lds, const Gemm g, const StaticOrder& S, const Epi& E) {
    const int tid = o_tid(), wid = __builtin_amdgcn_readfirstlane(tid >> 6), lane = tid & 63, wr = wid >> 2, wc = wid & 3, fr = lane & 15, fq = lane >> 4;
    const int K = g.K, nt = K / BK, ldb = g.ldb ? g.ldb : K;
    unsigned voffA[2], voffB[2];
#pragma unroll
    for (int i = 0; i < 2; ++i) { int R, C; stage_rc(tid * 16 + i * 8192, R, C);
        const int rs = g.rperm ? (4 * (R & 15) + ((R >> 4) & 3)) : (R & 63);
        voffA[i] = (unsigned)(((R >> 6) * g.GS + rs) * g.lda + C) * 2u; const int Rb = g.permB ? ((R & ~31) + perm32(R & 31)) : R; voffB[i] = (unsigned)(Rb * ldb + C) * 2u; }
    const size_t kstep = (size_t)(BK * 2);
    const size_t hstepA = (size_t)(2 * g.GS) * g.lda * 2, tstepA = (size_t)g.TS * g.lda * 2;
    const size_t hstepB = (size_t)HALF * ldb * 2, tstepB = 2 * hstepB;
    const unsigned ldsw = (unsigned)wid * 1024u;
    const int aoff = lds_byte(wr * 64 + fr, fq * 8), boff = lds_byte(wc * 32 + fr, fq * 8);
#define PG8_SA(b, h) (((b) * 2 + (h)) * HTB)
#define PG8_SB(b, h) ((4 + (b) * 2 + (h)) * HTB)
#define PG8_STAGE(bufoff, gbase, voff) do { _Pragma("unroll") for (int _i = 0; _i < 2; ++_i) \
        __builtin_amdgcn_global_load_lds((const unsigned*)((const char*)(gbase) + (voff)[_i]), (LAS unsigned*)(lds + (bufoff) + ldsw + _i * 8192), 16, 0, 0); } while (0)
#define PG8_LDA(dst, b, h) do { _Pragma("unroll") for (int m = 0; m < 4; ++m) _Pragma("unroll") for (int k = 0; k < 2; ++k) dst[m][k] = *(const LAS bf16x8*)(lds + PG8_SA(b, h) + aoff + m * 2048 + k * 1024); } while (0)
#define PG8_LDB(dst, b, h) do { _Pragma("unroll") for (int n = 0; n < 2; ++n) _Pragma("unroll") for (int k = 0; k < 2; ++k) dst[n][k] = *(const LAS bf16x8*)(lds + PG8_SB(b, h) + boff + n * 2048 + k * 1024); } while (0)
#define PG8_MMA(ai, bj, At, Bt) do { __builtin_amdgcn_s_setprio(1); _Pragma("unroll") for (int m = 0; m < 4; ++m) _Pragma("unroll") for (int n = 0; n < 2; ++n) _Pragma("unroll") for (int k = 0; k < 2; ++k) \
        acc[ai][bj][m][n] = __builtin_amdgcn_mfma_f32_16x16x32_bf16(Bt[n][k], At[m][k], acc[ai][bj][m][n], 0, 0, 0); __builtin_amdgcn_s_setprio(0); } while (0)
#define PG8_WAIT_V(n) asm volatile("s_waitcnt vmcnt(" #n ")" ::: "memory")
#define PG8_WAIT_L(n) asm volatile("s_waitcnt lgkmcnt(" #n ")" ::: "memory")
#define PG8_BAR __builtin_amdgcn_s_barrier()
#define PG8_SCHED __builtin_amdgcn_sched_barrier(0)
    Unit cur, nxt; int ui = 0;
    if (!S.next(0, cur)) return;
    f32x4 acc[2][2][4][2];
    if constexpr (Epi::PREFETCH) E.prefetch(cur, wr, wc, lane);
    if constexpr (Epi::INIT) E.init(acc, cur, wr, wc, fr, fq);
    else {
#pragma unroll
    for (int a = 0; a < 2; ++a)
#pragma unroll
        for (int b = 0; b < 2; ++b)
#pragma unroll
            for (int m = 0; m < 4; ++m)
#pragma unroll
                for (int n = 0; n < 2; ++n) acc[a][b][m][n] = (f32x4){0.f, 0.f, 0.f, 0.f};
    }
    bf16x8 At[4][2], B0[2][2], B1[2][2];
    const char* cA = (const char*)g.A + (size_t)cur.pm * tstepA; const char* cB = (const char*)g.Bt + (size_t)cur.pn * tstepB;
    PG8_STAGE(PG8_SB(0, 0), cB, voffB); PG8_STAGE(PG8_SA(0, 0), cA, voffA); PG8_STAGE(PG8_SB(0, 1), cB + hstepB, voffB); PG8_STAGE(PG8_SA(0, 1), cA + hstepA, voffA);
    if (wr == 1) PG8_BAR;
    PG8_WAIT_V(4); PG8_BAR;
    PG8_STAGE(PG8_SB(1, 0), cB + kstep, voffB); PG8_STAGE(PG8_SA(1, 0), cA + kstep, voffA); PG8_STAGE(PG8_SB(1, 1), cB + hstepB + kstep, voffB);
    PG8_WAIT_V(6); PG8_BAR;
    for (;;) {
        const bool has_next = S.next(ui + 1, nxt);
        const char* nA = has_next ? (const char*)g.A + (size_t)nxt.pm * tstepA : cA; const char* nB = has_next ? (const char*)g.Bt + (size_t)nxt.pn * tstepB : cB;
        for (int t = 0; t < nt; t += 2) {
            const bool last = (t == nt - 2);
            const char* a1 = cA + (size_t)(t + 1) * kstep;
            const char* a2 = last ? nA : cA + (size_t)(t + 2) * kstep; const char* b2 = last ? nB : cB + (size_t)(t + 2) * kstep;
            const char* a3 = a2 + kstep; const char* b3 = b2 + kstep;
            PG8_LDB(B0, 0, 0); PG8_SCHED; PG8_LDA(At, 0, 0); PG8_STAGE(PG8_SA(1, 1), a1 + hstepA, voffA);
            PG8_WAIT_L(8); PG8_BAR; PG8_WAIT_L(0); PG8_MMA(0, 0, At, B0); PG8_BAR; PG8_SCHED;
            PG8_LDB(B1, 0, 1); PG8_STAGE(PG8_SB(0, 0), b2, voffB);
            PG8_BAR; PG8_WAIT_L(0); PG8_MMA(0, 1, At, B1); PG8_BAR;
            PG8_LDA(At, 0, 1); PG8_STAGE(PG8_SA(0, 0), a2, voffA);
            PG8_BAR; PG8_WAIT_L(0); PG8_MMA(1, 0, At, B0); PG8_BAR; PG8_SCHED;
            PG8_STAGE(PG8_SB(0, 1), b2 + hstepB, voffB);
            PG8_WAIT_V(6); PG8_BAR; PG8_MMA(1, 1, At, B1); PG8_BAR;
            PG8_LDB(B0, 1, 0); PG8_SCHED; PG8_LDA(At, 1, 0); PG8_STAGE(PG8_SA(0, 1), a2 + hstepA, voffA);
            PG8_WAIT_L(8); PG8_BAR; PG8_WAIT_L(0); PG8_MMA(0, 0, At, B0); PG8_BAR; PG8_SCHED;
            PG8_LDB(B1, 1, 1); PG8_STAGE(PG8_SB(1, 0), b3, voffB);
            PG8_BAR; PG8_WAIT_L(0); PG8_MMA(0, 1, At, B1); PG8_BAR;
            PG8_LDA(At, 1, 1); PG8_STAGE(PG8_SA(1, 0), a3, voffA);
            PG8_BAR; PG8_WAIT_L(0); PG8_MMA(1, 0, At, B0); PG8_BAR; PG8_SCHED;
            PG8_STAGE(PG8_SB(1, 1), b3 + hstepB, voffB);
            PG8_WAIT_V(6); PG8_BAR; PG8_MMA(1, 1, At, B1); PG8_BAR;
        }
        E(acc, cur, wr, wc, fr, fq);
        if (!has_next) break;
        if constexpr (Epi::PREFETCH) E.prefetch(nxt, wr, wc, lane);
        if constexpr (Epi::INIT) E.init(acc, nxt, wr, wc, fr, fq);
        else {
#pragma unroll
        for (int a = 0; a < 2; ++a)
#pragma unroll
            for (int b = 0; b < 2; ++b)
#pragma unroll
                for (int m = 0; m < 4; ++m)
#pragma unroll
                    for (int n = 0; n < 2; ++n) acc[a][b][m][n] = (f32x4){0.f, 0.f, 0.f, 0.f};
        }
        cur = nxt; cA = nA; cB = nB; ++ui;
    }
    PG8_WAIT_V(0);
    if (wr == 0) PG8_BAR;
    PG8_BAR;
#undef PG8_SA
#undef PG8_SB
#undef PG8_STAGE
#undef PG8_LDA
#undef PG8_LDB
#undef PG8_MMA
#undef PG8_WAIT_V
#undef PG8_WAIT_L
#undef PG8_BAR
#undef PG8_SCHED
}
}
typedef f32x4 Acc[2][2][4][2];

struct EpiProj {
    static constexpr bool PREFETCH = false;
    static constexpr bool INIT = false;
    bf16_t* projm; const float* rs1; float* ssq_q; float* ssq_kv; int dry;
    DI void operator()(const Acc& acc, const pg8::Unit& u, int wr, int wc, int fr, int fq) const {
        asm volatile("" : "+v"(fr), "+v"(fq));
        float rsv[2][4];
#pragma unroll
        for (int ai = 0; ai < 2; ++ai)
#pragma unroll
            for (int m = 0; m < 4; ++m) rsv[ai][m] = rs1[u.pm * 256 + ai * 128 + wr * 64 + m * 16 + fr];
#pragma unroll
        for (int ai = 0; ai < 2; ++ai)
#pragma unroll
            for (int m = 0; m < 4; ++m) {
                const int row = u.pm * 256 + ai * 128 + wr * 64 + m * 16 + fr; const float rs = rsv[ai][m]; float ss = 0.f;
#pragma unroll
                for (int bj = 0; bj < 2; ++bj)
                    { const int c0 = u.pn * 256 + bj * 128 + wc * 32 + 8 * fq; const f32x4 v0 = acc[ai][bj][m][0] * rs, v1 = acc[ai][bj][m][1] * rs;
                        if (c0 < MLAW) { u32x4 w; w.x = pkbf(v0[0], v0[1]); w.y = pkbf(v0[2], v0[3]); w.z = pkbf(v1[0], v1[1]); w.w = pkbf(v1[2], v1[3]); *(u32x4*)(projm + (size_t)row * MLAW + c0) = w;
                            ss += v0[0] * v0[0] + v0[1] * v0[1] + v0[2] * v0[2] + v0[3] * v0[3] + v1[0] * v1[0] + v1[1] * v1[1] + v1[2] * v1[2] + v1[3] * v1[3]; }
                    }
                if (u.pn <= 3 && !dry) { ss += __shfl_xor(ss, 16); ss += __shfl_xor(ss, 32); if (fq == 0) atomicAdd((u.pn < 3 ? ssq_q : ssq_kv) + row, ss); }
            }
    }
};
struct EpiHyT {
    static constexpr bool PREFETCH = false;
    static constexpr bool INIT = false;
    bf16_t* uhT; const float* rs1;
    DI void operator()(const Acc& acc, const pg8::Unit& u, int wr, int wc, int fr, int fq) const {
        asm volatile("" : "+v"(fr), "+v"(fq));
        f32x4 rsv[2][2];
#pragma unroll
        for (int bj = 0; bj < 2; ++bj)
#pragma unroll
            for (int n = 0; n < 2; ++n) rsv[bj][n] = *(const f32x4*)(rs1 + u.pn * 256 + bj * 128 + wc * 32 + 8 * fq + 4 * n);
#pragma unroll
        for (int ai = 0; ai < 2; ++ai)
#pragma unroll
            for (int m = 0; m < 4; ++m) {
                const int ch = u.pm * 256 + ai * 128 + wr * 64 + m * 16 + fr;
#pragma unroll
                for (int bj = 0; bj < 2; ++bj)
                    { const int c0 = u.pn * 256 + bj * 128 + wc * 32 + 8 * fq; const f32x4 v0 = acc[ai][bj][m][0] * rsv[bj][0], v1 = acc[ai][bj][m][1] * rsv[bj][1];
                        u32x4 w; w.x = pkbf(v0[0], v0[1]); w.y = pkbf(v0[2], v0[3]); w.z = pkbf(v1[0], v1[1]); w.w = pkbf(v1[2], v1[3]); *(u32x4*)(uhT + (size_t)ch * MTOK + c0) = w; }
            }
    }
};
struct EpiQ {
    static constexpr bool PREFETCH = false;
    static constexpr bool INIT = false;
    bf16_t* qraw; const float* ssq_q;
    DI void operator()(const Acc& acc, const pg8::Unit& u, int wr, int wc, int fr, int fq) const {
        asm volatile("" : "+v"(fr), "+v"(fq));
        float rsv[2][4];
#pragma unroll
        for (int ai = 0; ai < 2; ++ai)
#pragma unroll
            for (int m = 0; m < 4; ++m) rsv[ai][m] = ssq_q[u.pm * 256 + ai * 128 + wr * 64 + m * 16 + fr];
#pragma unroll
        for (int ai = 0; ai < 2; ++ai)
#pragma unroll
            for (int m = 0; m < 4; ++m) {
                const int row = u.pm * 256 + ai * 128 + wr * 64 + m * 16 + fr; const float rs = rsqrtf(rsv[ai][m] * (1.0f / QL) + EPS);
#pragma unroll
                for (int bj = 0; bj < 2; ++bj)
                    { const int c0 = u.pn * 256 + bj * 128 + wc * 32 + 8 * fq; const f32x4 v0 = acc[ai][bj][m][0] * rs, v1 = acc[ai][bj][m][1] * rs;
                        u32x4 w; w.x = pkbf(v0[0], v0[1]); w.y = pkbf(v0[2], v0[3]); w.z = pkbf(v1[0], v1[1]); w.w = pkbf(v1[2], v1[3]); *(u32x4*)(qraw + (size_t)row * QL + c0) = w; }
                asm volatile("" ::: "memory");
            }
    }
};
struct EpiK {
    static constexpr bool PREFETCH = false;
    static constexpr bool INIT = false;
    bf16_t* kraw; const float* ssq_kv;
    DI void operator()(const Acc& acc, const pg8::Unit& u, int wr, int wc, int fr, int fq) const {
        asm volatile("" : "+v"(fr), "+v"(fq));
        float rsv[2][4];
#pragma unroll
        for (int ai = 0; ai < 2; ++ai)
#pragma unroll
            for (int m = 0; m < 4; ++m) rsv[ai][m] = ssq_kv[u.pm * 256 + ai * 128 + wr * 64 + m * 16 + fr];
#pragma unroll
        for (int ai = 0; ai < 2; ++ai)
#pragma unroll
            for (int m = 0; m < 4; ++m) {
                const int row = u.pm * 256 + ai * 128 + wr * 64 + m * 16 + fr; const float rs = rsqrtf(rsv[ai][m] * (1.0f / KVL) + EPS);
#pragma unroll
                for (int bj = 0; bj < 2; ++bj)
                    { const int c0 = u.pn * 256 + bj * 128 + wc * 32 + 8 * fq; const f32x4 v0 = acc[ai][bj][m][0] * rs, v1 = acc[ai][bj][m][1] * rs;
                        u32x4 w; w.x = pkbf(v0[0], v0[1]); w.y = pkbf(v0[2], v0[3]); w.z = pkbf(v1[0], v1[1]); w.w = pkbf(v1[2], v1[3]); *(u32x4*)(kraw + (size_t)row * 512 + c0) = w; }
            }
    }
};
struct EpiVT {
    static constexpr bool PREFETCH = false;
    static constexpr bool INIT = false;
    bf16_t* vt; const float* ssq_kv;
    DI void operator()(const Acc& acc, const pg8::Unit& u, int wr, int wc, int fr, int fq) const {
        asm volatile("" : "+v"(fr), "+v"(fq));
        f32x4 rsv[2][2];
#pragma unroll
        for (int bj = 0; bj < 2; ++bj)
#pragma unroll
            for (int n = 0; n < 2; ++n) { const f32x4 q = *(const f32x4*)(ssq_kv + u.pn * 256 + bj * 128 + wc * 32 + 8 * fq + 4 * n);
#pragma unroll
                for (int j = 0; j < 4; ++j) rsv[bj][n][j] = rsqrtf(q[j] * (1.0f / KVL) + EPS); }
#pragma unroll
        for (int ai = 0; ai < 2; ++ai)
#pragma unroll
            for (int m = 0; m < 4; ++m) {
                const int ch = u.pm * 256 + ai * 128 + wr * 64 + m * 16 + fr;
#pragma unroll
                for (int bj = 0; bj < 2; ++bj)
                    { const int c0 = u.pn * 256 + bj * 128 + wc * 32 + 8 * fq, b = c0 >> 11, s0 = c0 & 2047; const f32x4 v0 = acc[ai][bj][m][0] * rsv[bj][0], v1 = acc[ai][bj][m][1] * rsv[bj][1];
                        u32x4 w; w.x = pkbf(v0[0], v0[1]); w.y = pkbf(v0[2], v0[3]); w.z = pkbf(v1[0], v1[1]); w.w = pkbf(v1[2], v1[3]); *(u32x4*)(vt + ((size_t)b * 512 + ch) * SEQ + s0) = w; }
            }
    }
};
struct EpiOut {
    static constexpr bool PREFETCH = false;
    static constexpr bool INIT = true;
    const bf16_t* xb; bf16_t* x1b; float* ssq2; int dry;
    DI void init(Acc& acc, const pg8::Unit& u, int wr, int wc, int fr, int fq) const {
        asm volatile("" : "+v"(fr), "+v"(fq));
#pragma unroll
        for (int ai = 0; ai < 2; ++ai)
#pragma unroll
            for (int m = 0; m < 4; ++m) { const int row = u.pm * 256 + ai * 128 + wr * 64 + m * 16 + fr;
#pragma unroll
                for (int bj = 0; bj < 2; ++bj)
                    { const u32x4 w = *(const u32x4*)(xb + (size_t)row * DM + u.pn * 256 + bj * 128 + wc * 32 + 8 * fq);
                        acc[ai][bj][m][0] = (f32x4){lo2f(w.x), hi2f(w.x), lo2f(w.y), hi2f(w.y)}; acc[ai][bj][m][1] = (f32x4){lo2f(w.z), hi2f(w.z), lo2f(w.w), hi2f(w.w)}; } }
    }
    DI void operator()(const Acc& acc, const pg8::Unit& u, int wr, int wc, int fr, int fq) const {
        asm volatile("" : "+v"(fr), "+v"(fq));
#pragma unroll
        for (int ai = 0; ai < 2; ++ai)
#pragma unroll
            for (int m = 0; m < 4; ++m) {
                const int row = u.pm * 256 + ai * 128 + wr * 64 + m * 16 + fr; float ss = 0.f;
#pragma unroll
                for (int bj = 0; bj < 2; ++bj)
                    { const int c0 = u.pn * 256 + bj * 128 + wc * 32 + 8 * fq; const size_t o = (size_t)row * DM + c0;
                        const f32x4 v0 = acc[ai][bj][m][0], v1 = acc[ai][bj][m][1];
                        u32x4 w; w.x = pkbf(v0[0], v0[1]); w.y = pkbf(v0[2], v0[3]); w.z = pkbf(v1[0], v1[1]); w.w = pkbf(v1[2], v1[3]); *(u32x4*)(x1b + o) = w;
                        ss += v0[0] * v0[0] + v0[1] * v0[1] + v0[2] * v0[2] + v0[3] * v0[3] + v1[0] * v1[0] + v1[1] * v1[1] + v1[2] * v1[2] + v1[3] * v1[3]; }
                ss += __shfl_xor(ss, 16); ss += __shfl_xor(ss, 32); if (fq == 0 && !dry) atomicAdd(ssq2 + row, ss);
            }
    }
};
struct EpiPle {
    static constexpr bool PREFETCH = false;
    static constexpr bool INIT = false;
    bf16_t* eraw; float* ssq_e; int dry;
    DI void operator()(const Acc& acc, const pg8::Unit& u, int wr, int wc, int fr, int fq) const {
        asm volatile("" : "+v"(fr), "+v"(fq));
#pragma unroll
        for (int ai = 0; ai < 2; ++ai)
#pragma unroll
            for (int m = 0; m < 4; ++m) {
                const int row = u.pm * 256 + ai * 128 + wr * 64 + m * 16 + fr; float ss = 0.f;
#pragma unroll
                for (int bj = 0; bj < 2; ++bj)
                    { const int c0 = u.pn * 256 + bj * 128 + wc * 32 + 8 * fq; const f32x4 v0 = acc[ai][bj][m][0], v1 = acc[ai][bj][m][1];
                        u32x4 w; w.x = pkbf(v0[0], v0[1]); w.y = pkbf(v0[2], v0[3]); w.z = pkbf(v1[0], v1[1]); w.w = pkbf(v1[2], v1[3]); *(u32x4*)(eraw + (size_t)row * DM + c0) = w;
                        ss += v0[0] * v0[0] + v0[1] * v0[1] + v0[2] * v0[2] + v0[3] * v0[3] + v1[0] * v1[0] + v1[1] * v1[1] + v1[2] * v1[2] + v1[3] * v1[3]; }
                ss += __shfl_xor(ss, 16); ss += __shfl_xor(ss, 32); if (fq == 0 && !dry) atomicAdd(ssq_e + row, ss);                asm volatile("" ::: "memory");
            }
    }
};
DI float dpp_prev16(float v) { return __builtin_bit_cast(float, __builtin_amdgcn_update_dpp(0, __builtin_bit_cast(int, v), 0x121, 0xf, 0xf, false)); }
DI float dpp_next16(float v) { return __builtin_bit_cast(float, __builtin_amdgcn_update_dpp(0, __builtin_bit_cast(int, v), 0x12f, 0xf, 0xf, false)); }
struct EpiFfn {
    static constexpr bool PREFETCH = true;
    static constexpr bool INIT = false;
    bf16_t* act; const float* ssq2; const float* cw; const float* cb; LAS float* slots;
    DI void prefetch(const pg8::Unit& u, int wr, int wc, int lane) const {
        asm volatile("" : "+v"(lane) :: "memory");
        LAS float* sl = slots + (wr * 4 + wc) * 384;
        const int pi = lane >> 3, fg = lane & 7, fb = u.pn * 128 + wc * 32 + 4 * fg;
        const float* src = ((pi & 3) == 3) ? (cb + (pi >> 2) * DFF + fb) : (cw + (pi & 3) * (2 * DFF) + (pi >> 2) * DFF + fb);
        __builtin_amdgcn_global_load_lds((const unsigned*)src, (LAS unsigned*)sl, 16, 0, 0);
#pragma unroll
        for (int ai = 0; ai < 2; ++ai) { const int tk = u.pm * 248 - 1 + (2 * ai + wr) * 62 + lane; const int tc = tk < 0 ? 0 : (tk >= MTOK ? MTOK - 1 : tk);
            __builtin_amdgcn_global_load_lds((const unsigned*)(ssq2 + tc), (LAS unsigned*)(sl + 256 + ai * 64), 4, 0, 0); }
    }
    DI void operator()(const Acc& acc, const pg8::Unit& u, int wr, int wc, int fr, int fq) const {
        asm volatile("" : "+v"(fr), "+v"(fq));
        LAS float* sl = slots + (wr * 4 + wc) * 384;
        f32x4 rsa[2];
#pragma unroll
        for (int ai = 0; ai < 2; ++ai) rsa[ai] = *(const LAS f32x4*)(sl + 256 + ai * 64 + 4 * fr);
#pragma unroll
        for (int ai = 0; ai < 2; ++ai) {
            const int tok0 = u.pm * 248 - 1 + (2 * ai + wr) * 62 + 4 * fr;
            float rsv[4], sP[4], sN[4];
#pragma unroll
            for (int m = 0; m < 4; ++m) { rsv[m] = rsqrtf(rsa[ai][m] * (1.0f / DM) + EPS); const int t = (tok0 + m) & 2047; sP[m] = (t == 2047) ? 0.f : rsv[m]; sN[m] = (t == 0) ? 0.f : rsv[m]; }
#pragma unroll
            for (int n = 0; n < 2; ++n) {
                const int f0 = u.pn * 128 + wc * 32 + 8 * fq + 4 * n;
                unsigned pk[2][4];
#pragma unroll
                for (int jp = 0; jp < 2; ++jp) {
                    float r[2][4];
#pragma unroll
                    for (int jj = 0; jj < 2; ++jj) {
                        const int j = 2 * jp + jj;
                        float gc[4];
#pragma unroll
                        for (int half = 0; half < 2; ++half) {
                            const LAS float* pp = sl + (4 * half) * 32 + 8 * fq + 4 * n + j; const float w0 = pp[0], w1 = pp[32], w2 = pp[64], bb = pp[96];
                            float x[4], xp[4], xn[4];
#pragma unroll
                            for (int m = 0; m < 4; ++m) { const float a = acc[ai][half][m][n][j]; x[m] = a * rsv[m]; xp[m] = a * sP[m]; xn[m] = a * sN[m]; }
                            const float pe = __builtin_bit_cast(float, __builtin_amdgcn_update_dpp(0, __builtin_bit_cast(int, xp[3]), 0x111, 0xf, 0xf, true));
                            const float ne = __builtin_bit_cast(float, __builtin_amdgcn_update_dpp(0, __builtin_bit_cast(int, xn[0]), 0x101, 0xf, 0xf, true));
#pragma unroll
                            for (int m = 0; m < 4; ++m) {
                                const float pv = (m == 0) ? pe : xp[m > 0 ? m - 1 : 0], nv = (m == 3) ? ne : xn[m < 3 ? m + 1 : 3];
                                const float cv = w0 * pv + w1 * x[m] + w2 * nv + bb;
                                if (half == 0) gc[m] = cv; else r[jj][m] = gc[m] * __builtin_amdgcn_rcpf(1.0f + __builtin_amdgcn_exp2f(-1.4426950408889634f * gc[m])) * cv; }
                        }
                    }
#pragma unroll
                    for (int m = 0; m < 4; ++m) pk[jp][m] = pkbf(r[0][m], r[1][m]);
                    __builtin_amdgcn_sched_barrier(0);
                }
#pragma unroll
                for (int m = 0; m < 4; ++m) {
                    const int L = 4 * fr + m, tk = tok0 + m;
                    if (L >= 1 && L <= 62 && tk >= 0 && tk < MTOK) { u32x2 w; w.x = pk[0][m]; w.y = pk[1][m]; *(u32x2*)(act + (size_t)tk * DFF + f0) = w; }
                }
            }
        }
    }
};
struct EpiDown {
    static constexpr bool PREFETCH = false;
    static constexpr bool INIT = true;
    const bf16_t* x1b; bf16_t* x2b; int dry;
    DI void init(Acc& acc, const pg8::Unit& u, int wr, int wc, int fr, int fq) const {
        asm volatile("" : "+v"(fr), "+v"(fq));
#pragma unroll
        for (int ai = 0; ai < 2; ++ai)
#pragma unroll
            for (int m = 0; m < 4; ++m) { const int row = u.pm * 256 + ai * 128 + wr * 64 + m * 16 + fr;
#pragma unroll
                for (int bj = 0; bj < 2; ++bj)
                    { const u32x4 w = *(const u32x4*)(x1b + (size_t)row * DM + u.pn * 256 + bj * 128 + wc * 32 + 8 * fq);
                        acc[ai][bj][m][0] = (f32x4){lo2f(w.x), hi2f(w.x), lo2f(w.y), hi2f(w.y)}; acc[ai][bj][m][1] = (f32x4){lo2f(w.z), hi2f(w.z), lo2f(w.w), hi2f(w.w)}; } }
    }
    DI void operator()(const Acc& acc, const pg8::Unit& u, int wr, int wc, int fr, int fq) const {
        asm volatile("" : "+v"(fr), "+v"(fq));
        if (dry) return;
#pragma unroll
        for (int ai = 0; ai < 2; ++ai)
#pragma unroll
            for (int m = 0; m < 4; ++m) {
                const int row = u.pm * 256 + ai * 128 + wr * 64 + m * 16 + fr;
#pragma unroll
                for (int bj = 0; bj < 2; ++bj)
                    { const int c0 = u.pn * 256 + bj * 128 + wc * 32 + 8 * fq; const size_t o = (size_t)row * DM + c0;
                        const f32x4 v0 = acc[ai][bj][m][0], v1 = acc[ai][bj][m][1];
                        u32x4 w; w.x = pkbf(v0[0], v0[1]); w.y = pkbf(v0[2], v0[3]); w.z = pkbf(v1[0], v1[1]); w.w = pkbf(v1[2], v1[3]); *(u32x4*)(x2b + o) = w; }
            }
    }
};
struct EpiGate {
    static constexpr bool PREFETCH = false;
    static constexpr bool INIT = false;
    float* out; const bf16_t* x2b; const bf16_t* eraw; const float* ssq_e; const float* gn; int dry;
    DI void operator()(const Acc& acc, const pg8::Unit& u, int wr, int wc, int fr, int fq) const {
        asm volatile("" : "+v"(fr), "+v"(fq));
        float rsv[2][4];
#pragma unroll
        for (int ai = 0; ai < 2; ++ai)
#pragma unroll
            for (int m = 0; m < 4; ++m) rsv[ai][m] = ssq_e[u.pm * 256 + ai * 128 + wr * 64 + m * 16 + fr];
#pragma unroll
        for (int ai = 0; ai < 2; ++ai)
#pragma unroll
            for (int m = 0; m < 4; ++m) {
                const int row = u.pm * 256 + ai * 128 + wr * 64 + m * 16 + fr; const float rs = rsqrtf(rsv[ai][m] * (1.0f / DM) + EPS);
#pragma unroll
                for (int bj = 0; bj < 2; ++bj)
#pragma unroll
                    for (int n = 0; n < 2; ++n) {
                        const int c0 = u.pn * 256 + bj * 128 + wc * 32 + 8 * fq + 4 * n; const size_t o = (size_t)row * DM + c0;
                        const u32x2 ew = *(const u32x2*)(eraw + o); const f32x4 g4 = *(const f32x4*)(gn + c0); const f32x4 a = acc[ai][bj][m][n];
                        f32x4 e; e[0] = lo2f(ew.x); e[1] = hi2f(ew.x); e[2] = lo2f(ew.y); e[3] = hi2f(ew.y);
                        const u32x2 xw = *(const u32x2*)(x2b + o); f32x4 v = (f32x4){lo2f(xw.x), hi2f(xw.x), lo2f(xw.y), hi2f(xw.y)};
#pragma unroll
                        for (int j = 0; j < 4; ++j) v[j] += __builtin_amdgcn_rcpf(1.0f + __builtin_amdgcn_exp2f(-1.4426950408889634f * a[j])) * e[j] * rs * g4[j];
                        if (!dry) *(f32x4*)(out + o) = v; }
                if (m & 1) asm volatile("" ::: "memory");
            }
    }
};

DI float wt_gain(const P& p, int mode, int k) {
    switch (mode) { case 1: return p.norm_mix[k]; case 2: return p.q_norm[k]; case 3: return p.kv_norm[k]; case 4: return k < 512 ? p.on_attn[k] : p.on_hy[k - 512]; case 5: return p.norm_ffn[k]; default: return 1.0f; }
}
DI void wt_tile_wave(const P& p, const float* __restrict__ src, bf16_t* __restrict__ dst, int K, int N, int tk, int tn, int mode, LAS float* lw, int lane) {
    const int k0 = tk * 64, n0 = tn * 64;
#pragma unroll
    for (int i = 0; i < 16; ++i) { const int idx = lane + 64 * i, kk = idx >> 4, c4 = idx & 15, n = n0 + 4 * c4;
        f32x4 v = (f32x4){0.f, 0.f, 0.f, 0.f}; if (n < N) v = *(const f32x4*)(src + (size_t)(k0 + kk) * N + n);
        lw[kk * 65 + 4 * c4] = v[0]; lw[kk * 65 + 4 * c4 + 1] = v[1]; lw[kk * 65 + 4 * c4 + 2] = v[2]; lw[kk * 65 + 4 * c4 + 3] = v[3]; }
#pragma unroll
    for (int i = 0; i < 8; ++i) { const int idx = lane + 64 * i, nn = idx >> 3, k8 = idx & 7, n = n0 + nn, k = k0 + 8 * k8;
        float v[8];
#pragma unroll
        for (int j = 0; j < 8; ++j) v[j] = lw[(8 * k8 + j) * 65 + nn] * wt_gain(p, mode, k + j);
        if (n < N) { int dr = n; if (mode == 5) { dr = (n < DFF) ? ((n >> 7) * 256 + (n & 127)) : (((n - DFF) >> 7) * 256 + 128 + ((n - DFF) & 127)); }
            if (mode == 3) { dr = ((n & 127) < 64) ? ((n >> 7) * 64 + (n & 63)) : (512 + (n >> 7) * 64 + (n & 63)); }
            u32x4 w; w.x = pkbf(v[0], v[1]); w.y = pkbf(v[2], v[3]); w.z = pkbf(v[4], v[5]); w.w = pkbf(v[6], v[7]);
            *(u32x4*)(dst + (size_t)dr * K + k) = w; } }
}
DI void phase_prep(const P& p, LAS unsigned char* lds) {
    const int bid = o_bid(), nb = o_nb(), tid = o_tid(), lane = tid & 63, wid = tid >> 6;
    unsigned char* ws = p.ws;
    { LAS float* lw = (LAS float*)(lds + wid * (64 * 65 * 4));
      const int gw = bid * 8 + wid, nw = nb * 8;
      int base = 0;
#define WT_JOB(SRC, DST, KK, NN, MODE) do { const int tK = (KK) / 64, tN = ((NN) + 63) / 64, nt = tK * tN; \
          for (int t = ((gw - base) % nw + nw) % nw; t < nt; t += nw) wt_tile_wave(p, (SRC), (bf16_t*)(ws + (DST)), (KK), (NN), t % tK, t / tK, (MODE), lw, lane); \
          base += nt; } while (0)
      WT_JOB(p.w_up, WS_WUP, DM, 2 * DFF, 5);
      WT_JOB(p.w_down, WS_WDOWN, DFF, DM, 0);
      WT_JOB(p.w_in, WS_WIN, DM, INW, 1);
      WT_JOB(p.w_out, WS_WOUT, DM, DM, 4);
      WT_JOB(p.w_gate, WS_WGATE, DM, DM, 0);
      WT_JOB(p.w_uq, WS_WUQ, QL, QL, 2);
      WT_JOB(p.w_ukv, WS_WUKV, KVL, 1024, 3);
      WT_JOB(p.w_ple, WS_WPLE, PLE, DM, 0);
#undef WT_JOB
    }
    { u32x4* z = (u32x4*)(ws + WS_WIN + (size_t)INW * DM * 2); const int n16 = (INWP - INW) * DM * 2 / 16;
      for (int i = bid * NTHREADS + tid; i < n16; i += nb * NTHREADS) z[i] = (u32x4){0u, 0u, 0u, 0u}; }
    { float* st = (float*)(ws + WS_STATS) + MTOK; for (int i = bid * NTHREADS + tid; i < 4 * MTOK; i += nb * NTHREADS) st[i] = 0.f; }
    { bf16_t* xb = (bf16_t*)(ws + WS_X); float* rs1 = (float*)(ws + WS_STATS);
      for (int row0 = (bid * 8 + wid) * 4; row0 < MTOK; row0 += nb * 32) {
          f32x4 v[4][4];
#pragma unroll
          for (int r = 0; r < 4; ++r)
#pragma unroll
              for (int i = 0; i < 4; ++i) v[r][i] = ((const f32x4*)(p.x + (size_t)(row0 + r) * DM))[lane + 64 * i];
#pragma unroll
          for (int r = 0; r < 4; ++r) { float ss = 0.f;
#pragma unroll
              for (int i = 0; i < 4; ++i) { const f32x4 t = v[r][i]; ss += t[0] * t[0] + t[1] * t[1] + t[2] * t[2] + t[3] * t[3];
                  u32x2 w; w.x = pkbf(t[0], t[1]); w.y = pkbf(t[2], t[3]); ((u32x2*)(xb + (size_t)(row0 + r) * DM))[lane + 64 * i] = w; }
#pragma unroll
              for (int o = 32; o >= 1; o >>= 1) ss += __shfl_xor(ss, o);
              if (lane == 0) rs1[row0 + r] = rsqrtf(ss * (1.0f / DM) + EPS); }
      } }
    { const f32x4* ps = (const f32x4*)p.p; u32x2* pd = (u32x2*)(ws + WS_PB);
      for (int i0 = bid * NTHREADS + tid; i0 < MTOK * PLE / 4; i0 += 8 * nb * NTHREADS) {
          f32x4 v[8];
#pragma unroll
          for (int k = 0; k < 8; ++k) { const int i = i0 + k * nb * NTHREADS; v[k] = (i < MTOK * PLE / 4) ? ps[i] : (f32x4){0.f, 0.f, 0.f, 0.f}; }
#pragma unroll
          for (int k = 0; k < 8; ++k) { const int i = i0 + k * nb * NTHREADS; if (i < MTOK * PLE / 4) { u32x2 w; w.x = pkbf(v[k][0], v[k][1]); w.y = pkbf(v[k][2], v[k][3]); pd[i] = w; } } } }
    { bf16_t* kfil = (bf16_t*)(ws + WS_KFIL);
      LAS float* h3s = (LAS float*)(lds + 8 * 64 * 65 * 4);
      for (int lg = bid; lg < SEQ / 8; lg += nb) {
          const int l = lg * 8 + wid;
          const float t = (float)l / (float)(SEQ - 1);
          const float w = 6.283185307179586f * (float)l / (float)SEQ;
          float z = 0.f;
          if (lane == 0) z = t;
          else if (lane <= 16) { const float fb = 1e-4f + (float)(lane - 1) * ((15.0f - 1e-4f) / 15.0f); z = cosf(w * fb); }
          else if (lane <= 32) { const float fb = 1e-4f + (float)(lane - 17) * ((15.0f - 1e-4f) / 15.0f); z = -sinf(w * fb); }
          const float fr = p.f_freq[lane];
          float a = p.f_b1[lane];
          for (int i = 0; i < 33; ++i) a += __shfl(z, i) * p.f_w1[i * 64 + lane];
          float h = sinf(fr * a);
          a = p.f_b2[lane];
          for (int i = 0; i < 64; ++i) a += __shfl(h, i) * p.f_w2[i * 64 + lane];
          h = sinf(fr * a);
          a = p.f_b3[lane];
          for (int i = 0; i < 64; ++i) a += __shfl(h, i) * p.f_w3[i * 64 + lane];
          h = sinf(fr * a);
          __syncthreads();
          h3s[wid * 64 + lane] = h;
          __syncthreads();
          float o[8][2];
#pragma unroll
          for (int q = 0; q < 8; ++q) { o[q][0] = 0.f; o[q][1] = 0.f; }
#pragma unroll 1
          for (int jb = 0; jb < 64; jb += 16) {
              float w0[16], w1[16];
              const float* wp = p.f_wout + (size_t)jb * 1024 + tid;
#pragma unroll
              for (int j = 0; j < 16; ++j) { w0[j] = wp[j * 1024]; w1[j] = wp[j * 1024 + 512]; }
#pragma unroll
              for (int j4 = 0; j4 < 4; ++j4) {
#pragma unroll
                  for (int q = 0; q < 8; ++q) { const f32x4 hv = *(const LAS f32x4*)(h3s + q * 64 + jb + 4 * j4);
#pragma unroll
                      for (int k = 0; k < 4; ++k) { o[q][0] += hv[k] * w0[4 * j4 + k]; o[q][1] += hv[k] * w1[4 * j4 + k]; } }
                  __builtin_amdgcn_sched_barrier(0); } }
          const float mind = logf(1e-2f) / 0.3f, maxd = logf(1e-2f) / 1.5f;
          const int c = tid; const float delta = fabsf(mind + (float)c * ((maxd - mind) / 511.0f));
          float ff[8], fb[8];
#pragma unroll
          for (int q = 0; q < 8; ++q) { const int lq = lg * 8 + q; const float tq = (float)lq / (float)(SEQ - 1); const float dec = expf(-tq * delta); ff[q] = o[q][0] * dec; fb[q] = o[q][1] * dec; }
          { bf16_t* row = kfil + (size_t)c * 4096;
            u32x4 w; w.x = pkbf(lg == 0 ? ff[0] : fb[0], fb[1]); w.y = pkbf(fb[2], fb[3]); w.z = pkbf(fb[4], fb[5]); w.w = pkbf(fb[6], fb[7]);
            *(u32x4*)(row + 2048 + 8 * lg) = w;
            bf16_t* f0 = row + 2041 - 8 * lg;
            f0[0] = f2bf(ff[7]); *(unsigned*)(f0 + 1) = pkbf(ff[6], ff[5]); *(unsigned*)(f0 + 3) = pkbf(ff[4], ff[3]); *(unsigned*)(f0 + 5) = pkbf(ff[2], ff[1]);
            if (lg != 0) f0[7] = f2bf(ff[0]); }
          if (lg == 0) kfil[(size_t)c * 4096] = 0;
      } }
}

DI void phase_qkprep(const P& p) {
    const int bid = o_bid(), nb = o_nb(), lane = o_tid() & 63, wid = o_tid() >> 6;
    unsigned char* ws = p.ws;
    const bf16_t* qraw = (const bf16_t*)p.out; const bf16_t* kraw = (const bf16_t*)(ws + WS_KRAW2); const bf16_t* projm = (const bf16_t*)(ws + WS_Y);
    bf16_t* Qh = (bf16_t*)(ws + WS_Q); bf16_t* Kh = (bf16_t*)(ws + WS_K);
    const int h = lane >> 3, sub = lane & 7;
    const float qscale = 0.10206207261596575f * 1.4426950408889634f;
    float gq[12], gk[12];
#pragma unroll
    for (int i = 0; i < 8; ++i) { gq[i] = p.qk_nq[8 * sub + i]; gk[i] = p.qk_nk[8 * sub + i]; }
#pragma unroll
    for (int e = 0; e < 2; ++e) { gq[8 + e] = p.qk_nq[64 + 2 * sub + e]; gq[10 + e] = p.qk_nq[80 + 2 * sub + e]; gk[8 + e] = p.qk_nk[64 + 2 * sub + e]; gk[10 + e] = p.qk_nk[80 + 2 * sub + e]; }
    float invf[2];
#pragma unroll
    for (int e = 0; e < 2; ++e) invf[e] = powf(10000.0f, -(float)(2 * sub + e) / 16.0f);
    for (int row0 = (bid * 8 + wid) * 2; row0 < MTOK; row0 += nb * 16) {
        u32x4 la[2][2]; unsigned l1[2][2], l2[2][2];
#pragma unroll
        for (int tt = 0; tt < 2; ++tt) {
            const int row = row0 + tt;
            const bf16_t* q = qraw + (size_t)row * QL + h * QKD; const bf16_t* k = kraw + (size_t)row * 512 + h * 64; const bf16_t* pe = projm + (size_t)row * MLAW + 1024;
            la[tt][0] = *(const u32x4*)(q + 8 * sub); l1[tt][0] = *(const unsigned*)(q + 64 + 2 * sub); l2[tt][0] = *(const unsigned*)(q + 80 + 2 * sub);
            la[tt][1] = *(const u32x4*)(k + 8 * sub); l1[tt][1] = *(const unsigned*)(pe + 2 * sub); l2[tt][1] = *(const unsigned*)(pe + 16 + 2 * sub);
        }
#pragma unroll
        for (int tt = 0; tt < 2; ++tt) {
        const int row = row0 + tt;
        const int b = row >> 11, s = row & 2047;
        float cs[2], sn[2];
#pragma unroll
        for (int e = 0; e < 2; ++e) { const float ang = (float)s * invf[e]; sn[e] = sinf(ang); cs[e] = cosf(ang); }
#pragma unroll
        for (int which = 0; which < 2; ++which) {
            float v[12];
            { const u32x4 a = la[tt][which]; const unsigned r1 = l1[tt][which], r2 = l2[tt][which];
              v[0] = lo2f(a.x); v[1] = hi2f(a.x); v[2] = lo2f(a.y); v[3] = hi2f(a.y); v[4] = lo2f(a.z); v[5] = hi2f(a.z); v[6] = lo2f(a.w); v[7] = hi2f(a.w);
              v[8] = lo2f(r1); v[9] = hi2f(r1); v[10] = lo2f(r2); v[11] = hi2f(r2); }
            float ss = 0.f;
#pragma unroll
            for (int i = 0; i < 12; ++i) ss += v[i] * v[i];
            ss += __shfl_xor(ss, 1); ss += __shfl_xor(ss, 2); ss += __shfl_xor(ss, 4);
            const float rs = rsqrtf(ss * (1.0f / QKD) + EPS) * (which == 0 ? qscale : 1.0f);
#pragma unroll
            for (int i = 0; i < 12; ++i) v[i] *= rs * (which == 0 ? gq[i] : gk[i]);
            float r[4];
#pragma unroll
            for (int e = 0; e < 2; ++e) { r[e] = v[8 + e] * cs[e] - v[10 + e] * sn[e]; r[2 + e] = v[10 + e] * cs[e] + v[8 + e] * sn[e]; }
            bf16_t* dst = (which == 0 ? Qh : Kh) + ((size_t)(b * NH + h) * SEQ + s) * QKD;
            u32x4 w; w.x = pkbf(v[0], v[1]); w.y = pkbf(v[2], v[3]); w.z = pkbf(v[4], v[5]); w.w = pkbf(v[6], v[7]);
            *(u32x4*)(dst + 8 * sub) = w; *(unsigned*)(dst + 64 + 2 * sub) = pkbf(r[0], r[1]); *(unsigned*)(dst + 80 + 2 * sub) = pkbf(r[2], r[3]);
        }
        }
    }
}

DI void phase_mixprep(const P& p, unsigned char* shm) {
    const int bid = o_bid(), nb = o_nb(), tid = o_tid(), lane = tid & 63, wid = tid >> 6;
    unsigned char* ws = p.ws;
    const bf16_t* yatt = (const bf16_t*)(ws + WS_YATT); const bf16_t* yhT = (const bf16_t*)(ws + WS_YHT); bf16_t* ymix = (bf16_t*)p.out;
    bf16_t* tile = (bf16_t*)shm;
    float* part = (float*)(shm + 512 * 66 * 2);
    for (int t0 = bid; t0 < MTOK / 64; t0 += nb) {
        const int m0 = t0 * 64;
        u32x4 ar[8], hr[8];
#pragma unroll
        for (int i = 0; i < 8; ++i) ar[i] = *(const u32x4*)(yatt + (size_t)(m0 + wid + 8 * i) * 512 + lane * 8);
#pragma unroll
        for (int i = 0; i < 8; ++i) { const int idx = tid + NTHREADS * i, c = idx >> 3, q = idx & 7; hr[i] = *(const u32x4*)(yhT + (size_t)c * MTOK + m0 + q * 8); }
#pragma unroll
        for (int i = 0; i < 8; ++i) {
            const size_t row = m0 + wid + 8 * i; const u32x4 a = ar[i];
            float v[8] = {lo2f(a.x), hi2f(a.x), lo2f(a.y), hi2f(a.y), lo2f(a.z), hi2f(a.z), lo2f(a.w), hi2f(a.w)}; float ss = 0.f;
#pragma unroll
            for (int k = 0; k < 8; ++k) ss += v[k] * v[k];
#pragma unroll
            for (int o = 32; o >= 1; o >>= 1) ss += __shfl_xor(ss, o);
            const float rs = rsqrtf(ss * (1.0f / 512) + EPS);
            u32x4 w; w.x = pkbf(v[0] * rs, v[1] * rs); w.y = pkbf(v[2] * rs, v[3] * rs); w.z = pkbf(v[4] * rs, v[5] * rs); w.w = pkbf(v[6] * rs, v[7] * rs);
            *(u32x4*)(ymix + row * DM + lane * 8) = w;
        }
#pragma unroll
        for (int i = 0; i < 8; ++i) { const int idx = tid + NTHREADS * i, c = idx >> 3, q = idx & 7; const u32x4 a = hr[i];
            unsigned* d = (unsigned*)(tile + c * 66 + q * 8); d[0] = a.x; d[1] = a.y; d[2] = a.z; d[3] = a.w; }
        __syncthreads();
        { const int tok = lane, part_i = wid; float ss = 0.f;
          for (int c = part_i * 64; c < part_i * 64 + 64; ++c) { const float v = bf2f(tile[c * 66 + tok]); ss += v * v; }
          part[part_i * 64 + tok] = ss; }
        __syncthreads();
        { const int tok = lane, part_i = wid; float ss = 0.f;
#pragma unroll
          for (int i = 0; i < 8; ++i) ss += part[i * 64 + tok];
          const float rs = rsqrtf(ss * (1.0f / 512) + EPS);
          bf16_t* dst = ymix + (size_t)(m0 + tok) * DM + 512 + part_i * 64;
#pragma unroll
          for (int g = 0; g < 8; ++g) { float v[8];
#pragma unroll
              for (int i = 0; i < 8; ++i) v[i] = bf2f(tile[(part_i * 64 + g * 8 + i) * 66 + tok]) * rs;
              u32x4 w; w.x = pkbf(v[0], v[1]); w.y = pkbf(v[2], v[3]); w.z = pkbf(v[4], v[5]); w.w = pkbf(v[6], v[7]); *(u32x4*)(dst + g * 8) = w; } }
        __syncthreads();
    }
}

DI void phase_g1(const P& p, LAS unsigned char* shm, int dry) {
    unsigned char* ws = p.ws; float* st = (float*)(ws + WS_STATS);
    { pg8::Gemm g{(const bf16_t*)(ws + WS_X), (const bf16_t*)(ws + WS_WIN), DM, DM, 64, 5, 256, 64};
      pg8::StaticOrder S; S.init(g.nM, g.nN, o_nb(), o_bid());
      EpiProj E{(bf16_t*)(ws + WS_Y), st, st + MTOK, st + 2 * MTOK, dry};
      pg8::gemm_phase(shm, g, S, E); }
    { pg8::Gemm g{(const bf16_t*)(ws + WS_WIN) + (size_t)MLAW * DM, (const bf16_t*)(ws + WS_X), DM, DM, 6, 64, 256, 64};
      pg8::StaticOrder S; S.init(g.nM, g.nN, o_nb(), (o_bid() + 192) % o_nb());
      EpiHyT E{(bf16_t*)(ws + WS_Z), st};
      pg8::gemm_phase(shm, g, S, E); }
}
DI void phase_g23(const P& p, LAS unsigned char* shm) {
    unsigned char* ws = p.ws; float* st = (float*)(ws + WS_STATS);
    { pg8::Gemm g{(const bf16_t*)(ws + WS_Y), (const bf16_t*)(ws + WS_WUQ), QL, MLAW, 64, 3, 256, 64};
      pg8::StaticOrder S; S.init(g.nM, g.nN, o_nb(), o_bid());
      EpiQ E{(bf16_t*)p.out, st + MTOK};
      pg8::gemm_phase(shm, g, S, E); }
    { pg8::Gemm g{(const bf16_t*)(ws + WS_Y) + QL, (const bf16_t*)(ws + WS_WUKV), KVL, MLAW, 64, 2, 256, 64};
      pg8::StaticOrder S; S.init(g.nM, g.nN, o_nb(), (o_bid() + 64) % o_nb());
      EpiK E{(bf16_t*)(ws + WS_KRAW2), st + 2 * MTOK};
      pg8::gemm_phase(shm, g, S, E); }
    { pg8::Gemm g{(const bf16_t*)(ws + WS_WUKV) + (size_t)512 * KVL, (const bf16_t*)(ws + WS_Y) + QL, KVL, KVL, 2, 64, 256, 64, MLAW};
      pg8::StaticOrder S; S.init(g.nM, g.nN, o_nb(), (o_bid() + 192) % o_nb());
      EpiVT E{(bf16_t*)(ws + WS_V), st + 2 * MTOK};
      pg8::gemm_phase(shm, g, S, E); }
}
DI void phase_g4(const P& p, LAS unsigned char* shm, int dry) {
    unsigned char* ws = p.ws; float* st = (float*)(ws + WS_STATS);
    { pg8::Gemm g{(const bf16_t*)p.out, (const bf16_t*)(ws + WS_WOUT), DM, DM, 64, 4, 256, 64};
      pg8::StaticOrder S; S.init(g.nM, g.nN, o_nb(), o_bid());
      EpiOut E{(const bf16_t*)(ws + WS_X), (bf16_t*)(ws + WS_Y + 4096), st + 3 * MTOK, dry};
      pg8::gemm_phase(shm, g, S, E); }
    { pg8::Gemm g{(const bf16_t*)(ws + WS_PB), (const bf16_t*)(ws + WS_WPLE), PLE, PLE, 64, 4, 256, 64};
      pg8::StaticOrder S; S.init(g.nM, g.nN, o_nb(), o_bid());
      EpiPle E{(bf16_t*)(ws + WS_Z), st + 4 * MTOK, dry};
      pg8::gemm_phase(shm, g, S, E); }
}
DI void phase_g5(const P& p, LAS unsigned char* shm) {
    unsigned char* ws = p.ws; float* st = (float*)(ws + WS_STATS);
    pg8::Gemm g{(const bf16_t*)(ws + WS_Y + 4096) - DM, (const bf16_t*)(ws + WS_WUP), DM, DM, 67, 22, 248, 62, 0, 1};
    pg8::StaticOrder S; S.init(g.nM, g.nN, o_nb(), o_bid());
    EpiFfn E{(bf16_t*)(ws + WS_ACT), st + 3 * MTOK, p.fc_w, p.fc_b, (LAS float*)(shm + pg8::STAGE_BYTES)};
    pg8::gemm_phase(shm, g, S, E);
}
DI void phase_g6(const P& p, LAS unsigned char* shm, int dry) {
    unsigned char* ws = p.ws;
    pg8::Gemm g{(const bf16_t*)(ws + WS_ACT), (const bf16_t*)(ws + WS_WDOWN), DFF, DFF, 64, 4, 256, 64};
    pg8::StaticOrder S; S.init(g.nM, g.nN, o_nb(), o_bid());
    EpiDown E{(const bf16_t*)(ws + WS_Y + 4096), (bf16_t*)(ws + WS_X), dry};
    pg8::gemm_phase(shm, g, S, E);
}
DI void phase_g7(const P& p, LAS unsigned char* shm, int dry) {
    unsigned char* ws = p.ws; float* st = (float*)(ws + WS_STATS);
    pg8::Gemm g{(const bf16_t*)(ws + WS_X), (const bf16_t*)(ws + WS_WGATE), DM, DM, 64, 4, 256, 64};
    pg8::StaticOrder S; S.init(g.nM, g.nN, o_nb(), o_bid());
    EpiGate E{p.out, (const bf16_t*)(ws + WS_X), (const bf16_t*)(ws + WS_Z), st + 4 * MTOK, p.ple_norm, dry};
    pg8::gemm_phase(shm, g, S, E);
}

#define MFMA32(a, b, c) __builtin_amdgcn_mfma_f32_32x32x16_bf16((a), (b), (c), 0, 0, 0)
constexpr int AT_KRS = 208, AT_VRS = 136, AT_KBYTES = 64 * AT_KRS, AT_VBYTES = 64 * AT_VRS, AT_BUF = AT_KBYTES + AT_VBYTES;
DI void phase_attn(const P& p, LAS unsigned char* lds) {
    const int tid = o_tid(), lane = tid & 63, wid = tid >> 6, l31 = lane & 31, hl = lane >> 5;
    const int bid = o_bid(), nb = o_nb();
    const bf16_t* Qg = (const bf16_t*)(p.ws + WS_Q); const bf16_t* Kg = (const bf16_t*)(p.ws + WS_K); const bf16_t* Vg = (const bf16_t*)(p.ws + WS_V);
    bf16_t* Y = (bf16_t*)(p.ws + WS_YATT);
    const int kl0 = (tid / 12) * AT_KRS + (tid % 12) * 16, kl1 = ((512 + tid) / 12) * AT_KRS + ((512 + tid) % 12) * 16;
    const int vdv = tid >> 3, vpart = tid & 7, vl = vdv * AT_VRS + vpart * 16;
    for (int item = bid; item < 256; item += nb) {
        const int bh = item >> 2, q0 = (item & 3) * 512;
        bf16x8 Qf[2][6];
#pragma unroll
        for (int qb = 0; qb < 2; ++qb)
#pragma unroll
            for (int kk = 0; kk < 6; ++kk) Qf[qb][kk] = *(const bf16x8*)(Qg + ((size_t)bh * SEQ + q0 + 64 * wid + 32 * qb + l31) * QKD + 16 * kk + 8 * hl);
        f32x16 O[2][2];
#pragma unroll
        for (int a = 0; a < 2; ++a)
#pragma unroll
            for (int b = 0; b < 2; ++b)
#pragma unroll
                for (int i = 0; i < 16; ++i) O[a][b][i] = 0.f;
        float mrow[2] = {0.f, 0.f}, lsum[2] = {0.f, 0.f}; bool refs = false;
        const unsigned char* Kt = (const unsigned char*)(Kg + (size_t)bh * SEQ * QKD);
        const unsigned char* Vt = (const unsigned char*)(Vg + (size_t)bh * VD * SEQ) + (size_t)vdv * SEQ * 2 + vpart * 16;
        u32x4 kr0 = *(const u32x4*)(Kt + tid * 16), kr1 = (u32x4){0u, 0u, 0u, 0u}, vr = *(const u32x4*)(Vt);
        if (tid < 256) kr1 = *(const u32x4*)(Kt + (512 + tid) * 16);
        __syncthreads();
        *(LAS u32x4*)(lds + kl0) = kr0; if (tid < 256) *(LAS u32x4*)(lds + kl1) = kr1;
        *(LAS u32x2*)(lds + AT_KBYTES + vl) = (u32x2){vr.x, vr.y}; *(LAS u32x2*)(lds + AT_KBYTES + vl + 8) = (u32x2){vr.z, vr.w};
        __syncthreads();
#pragma unroll 1
        for (int it = 0; it < 32; ++it) {
            LAS unsigned char* kb_ = lds + (it & 1) * AT_BUF; LAS unsigned char* vb_ = kb_ + AT_KBYTES;
            if (it + 1 < 32) {
                kr0 = *(const u32x4*)(Kt + (size_t)(it + 1) * 12288 + tid * 16); if (tid < 256) kr1 = *(const u32x4*)(Kt + (size_t)(it + 1) * 12288 + (512 + tid) * 16);
                vr = *(const u32x4*)(Vt + (size_t)(it + 1) * 128); }
            f32x16 S[2][2];
#pragma unroll
            for (int a = 0; a < 2; ++a)
#pragma unroll
                for (int b = 0; b < 2; ++b)
#pragma unroll
                    for (int i = 0; i < 16; ++i) S[a][b][i] = 0.f;
#pragma unroll
            for (int kb = 0; kb < 2; ++kb)
#pragma unroll
                for (int kk = 0; kk < 6; ++kk) {
                    const bf16x8 a = *(const LAS bf16x8*)(kb_ + (32 * kb + l31) * AT_KRS + 32 * kk + 16 * hl);
                    S[kb][0] = MFMA32(a, Qf[0][kk], S[kb][0]); S[kb][1] = MFMA32(a, Qf[1][kk], S[kb][1]); }
#pragma unroll
            for (int qb = 0; qb < 2; ++qb) {
                float mx = S[0][qb][0];
#pragma unroll
                for (int i = 1; i < 16; ++i) mx = fmaxf(mx, S[0][qb][i]);
#pragma unroll
                for (int i = 0; i < 16; ++i) mx = fmaxf(mx, S[1][qb][i]);
                { const auto r = __builtin_amdgcn_permlane32_swap(__builtin_bit_cast(unsigned, mx), __builtin_bit_cast(unsigned, mx), false, false);
                  mx = fmaxf(__builtin_bit_cast(float, r[0]), __builtin_bit_cast(float, r[1])); }
                { const float rel = mx - mrow[qb]; const bool need = (it == 0) ? (fabsf(rel) > 8.0f) : (rel > 8.0f);
                  if (__builtin_amdgcn_ballot_w64(need) != 0ull) {
                      const float d = need ? rel : 0.f, alpha = (it == 0) ? 1.0f : __builtin_amdgcn_exp2f(-d);
                      mrow[qb] += d; lsum[qb] *= alpha; refs = true;
#pragma unroll
                      for (int dvb = 0; dvb < 2; ++dvb)
#pragma unroll
                          for (int i = 0; i < 16; ++i) O[dvb][qb][i] *= alpha;
                  } }
                if (refs) {
                    const float mm = mrow[qb];
#pragma unroll
                    for (int kb = 0; kb < 2; ++kb)
#pragma unroll
                        for (int i = 0; i < 16; ++i) S[kb][qb][i] -= mm;
                }
                float ps = 0.f;
#pragma unroll
                for (int kb = 0; kb < 2; ++kb)
#pragma unroll
                    for (int i = 0; i < 16; ++i) { const float e = __builtin_amdgcn_exp2f(S[kb][qb][i]); S[kb][qb][i] = e; ps += e; }
                lsum[qb] += ps;
            }
#pragma unroll
            for (int c = 0; c < 4; ++c) {
                const int kb = c >> 1, s8 = (c & 1) * 8;
                bf16x8 pf[2];
#pragma unroll
                for (int qb = 0; qb < 2; ++qb) { u32x4 w; w.x = pkbf(S[kb][qb][s8 + 0], S[kb][qb][s8 + 1]); w.y = pkbf(S[kb][qb][s8 + 2], S[kb][qb][s8 + 3]);
                    w.z = pkbf(S[kb][qb][s8 + 4], S[kb][qb][s8 + 5]); w.w = pkbf(S[kb][qb][s8 + 6], S[kb][qb][s8 + 7]); pf[qb] = __builtin_bit_cast(bf16x8, w); }
#pragma unroll
                for (int dvb = 0; dvb < 2; ++dvb) {
                    const LAS unsigned char* va = vb_ + (32 * dvb + l31) * AT_VRS + (16 * c + 4 * hl) * 2;
                    const u32x2 lo = *(const LAS u32x2*)va, hi = *(const LAS u32x2*)(va + 16);
                    const bf16x8 a = __builtin_bit_cast(bf16x8, (u32x4){lo.x, lo.y, hi.x, hi.y});
                    O[dvb][0] = MFMA32(a, pf[0], O[dvb][0]); O[dvb][1] = MFMA32(a, pf[1], O[dvb][1]); }
            }
            if (it + 1 < 32) {
                LAS unsigned char* kn = lds + ((it + 1) & 1) * AT_BUF;
                *(LAS u32x4*)(kn + kl0) = kr0; if (tid < 256) *(LAS u32x4*)(kn + kl1) = kr1;
                *(LAS u32x2*)(kn + AT_KBYTES + vl) = (u32x2){vr.x, vr.y}; *(LAS u32x2*)(kn + AT_KBYTES + vl + 8) = (u32x2){vr.z, vr.w}; }
            __syncthreads();
        }
        const int b = bh >> 3, h = bh & 7;
#pragma unroll
        for (int qb = 0; qb < 2; ++qb) {
            const float lt = lsum[qb] + __shfl_xor(lsum[qb], 32), inv = 1.0f / lt;
            bf16_t* dst = Y + ((size_t)b * SEQ + q0 + 64 * wid + 32 * qb + l31) * 512 + h * VD;
#pragma unroll
            for (int dvb = 0; dvb < 2; ++dvb)
#pragma unroll
                for (int g = 0; g < 4; g += 2) {
                    const unsigned a0 = pkbf(O[dvb][qb][4 * g] * inv, O[dvb][qb][4 * g + 1] * inv), a1 = pkbf(O[dvb][qb][4 * g + 2] * inv, O[dvb][qb][4 * g + 3] * inv);
                    const unsigned b0 = pkbf(O[dvb][qb][4 * g + 4] * inv, O[dvb][qb][4 * g + 5] * inv), b1 = pkbf(O[dvb][qb][4 * g + 6] * inv, O[dvb][qb][4 * g + 7] * inv);
                    const auto s0 = __builtin_amdgcn_permlane32_swap(a0, b0, false, false), s1 = __builtin_amdgcn_permlane32_swap(a1, b1, false, false);
                    u32x4 w; w.x = s0[0]; w.y = s1[0]; w.z = s0[1]; w.w = s1[1];
                    *(u32x4*)(dst + 32 * dvb + 8 * (g + hl)) = w; }
        }
    }
}

constexpr int HY_CS = 8224, HY_URS = 4880, HY_UP = 8 * HY_CS, HY_X0 = HY_UP + 8 * HY_URS, HY_END = HY_X0 + 8 * 2048 * 2;
static_assert(HY_END <= LDS_BYTES, "hyena LDS");
DI void phase_hyena(const P& p, LAS unsigned char* lds) {
    const int tid = o_tid(), lane = tid & 63, wid = tid >> 6, l31 = lane & 31, hl = lane >> 5;
    const int bid = o_bid(), nb = o_nb();
    const bf16_t* uhT = (const bf16_t*)(p.ws + WS_Z); const bf16_t* kfil = (const bf16_t*)(p.ws + WS_KFIL); bf16_t* yhT = (bf16_t*)(p.ws + WS_YHT);
    for (int c = bid; c < HYW; c += nb) {
        __syncthreads();
        { const bf16_t* kr = kfil + (size_t)c * 4096; const int q = tid;
          const u32x4 A = *(const u32x4*)(kr + 8 * q); const u32x4 B = (q < 511) ? *(const u32x4*)(kr + 8 * q + 8) : (u32x4){0u, 0u, 0u, 0u};
          const unsigned d[8] = {A.x, A.y, A.z, A.w, B.x, B.y, B.z, B.w};
#pragma unroll
          for (int r = 0; r < 8; ++r) { const int e = r >> 1; u32x4 o;
              if ((r & 1) == 0) { o.x = d[e]; o.y = d[e + 1]; o.z = d[e + 2]; o.w = d[e + 3]; }
              else { o.x = __builtin_amdgcn_alignbit(d[e + 1], d[e], 16); o.y = __builtin_amdgcn_alignbit(d[e + 2], d[e + 1], 16); o.z = __builtin_amdgcn_alignbit(d[e + 3], d[e + 2], 16); o.w = __builtin_amdgcn_alignbit(d[e + 4], d[e + 3], 16); }
              *(LAS u32x4*)(lds + r * HY_CS + 16 * q) = o; } }
        if (tid < 384) { const int b = tid / 48, k = tid % 48; LAS unsigned char* row = lds + HY_UP + b * HY_URS; const int off = (k < 24) ? k * 16 : (2240 * 2 + (k - 24) * 16); *(LAS u32x4*)(row + off) = (u32x4){0u, 0u, 0u, 0u}; }
        { float w0[3], w1[3], w2[3], bb[3];
#pragma unroll
          for (int a = 0; a < 3; ++a) { const int ch = a * HYW + c; w0[a] = p.sc_w[ch]; w1[a] = p.sc_w[1536 + ch]; w2[a] = p.sc_w[3072 + ch]; bb[a] = p.sc_b[ch]; }
#pragma unroll 2
          for (int i = 0; i < 4; ++i) {
              const int ch = tid + 512 * i, b = ch >> 8, t0 = (ch & 255) * 8, m0 = b * SEQ + t0;
              float r[3][8];
#pragma unroll
              for (int a = 0; a < 3; ++a) {
                  const bf16_t* row = uhT + (size_t)(a * HYW + c) * MTOK + m0;
                  const u32x4 v = *(const u32x4*)row; const float pv = t0 > 0 ? bf2f(row[-1]) : 0.f, nv = t0 < SEQ - 8 ? bf2f(row[8]) : 0.f;
                  const float x[10] = {pv, lo2f(v.x), hi2f(v.x), lo2f(v.y), hi2f(v.y), lo2f(v.z), hi2f(v.z), lo2f(v.w), hi2f(v.w), nv};
#pragma unroll
                  for (int k = 0; k < 8; ++k) r[a][k] = w0[a] * x[k] + w1[a] * x[k + 1] + w2[a] * x[k + 2] + bb[a];
              }
              u32x4 uo, xo;
              uo.x = pkbf(r[1][0] * r[2][0], r[1][1] * r[2][1]); uo.y = pkbf(r[1][2] * r[2][2], r[1][3] * r[2][3]); uo.z = pkbf(r[1][4] * r[2][4], r[1][5] * r[2][5]); uo.w = pkbf(r[1][6] * r[2][6], r[1][7] * r[2][7]);
              xo.x = pkbf(r[0][0], r[0][1]); xo.y = pkbf(r[0][2], r[0][3]); xo.z = pkbf(r[0][4], r[0][5]); xo.w = pkbf(r[0][6], r[0][7]);
              *(LAS u32x4*)(lds + HY_UP + b * HY_URS + (192 + t0) * 2) = uo; *(LAS u32x4*)(lds + HY_X0 + (b * SEQ + t0) * 2) = xo;
          } }
        __syncthreads();
        const int T0 = 256 * wid, rho = (-l31) & 7, bcol = l31 & 7, mcol = l31 >> 3;
        const LAS unsigned char* ap = lds + rho * HY_CS + 2 * (1856 - T0 + 8 * hl - l31 - rho);
        const LAS unsigned char* bp = lds + HY_UP + bcol * HY_URS + (64 * mcol + 8 * hl) * 2;
        f32x16 C0, C1;
#pragma unroll
        for (int i = 0; i < 16; ++i) { C0[i] = 0.f; C1[i] = 0.f; }
        bf16x8 am2 = *(const LAS bf16x8*)(ap - 64), am1 = *(const LAS bf16x8*)(ap - 32);
#pragma unroll 4
        for (int e = 0; e < 140; ++e) {
            const bf16x8 ac = *(const LAS bf16x8*)(ap + 32 * e); const bf16x8 bf = *(const LAS bf16x8*)(bp + 32 * e);
            C0 = MFMA32(ac, bf, C0); C1 = MFMA32(am2, bf, C1);
            am2 = am1; am1 = ac;
        }
        { const float bias = p.hy_bias[c];
#pragma unroll
          for (int rb = 0; rb < 2; ++rb)
#pragma unroll
              for (int g = 0; g < 4; g += 2) {
                  unsigned pw[2][2];
#pragma unroll
                  for (int gg = 0; gg < 2; ++gg) {
                      const int t0 = T0 + 64 * mcol + 32 * rb + 8 * (g + gg) + 4 * hl;
                      const u32x2 uw = *(const LAS u32x2*)(lds + HY_UP + bcol * HY_URS + (192 + t0) * 2), xw = *(const LAS u32x2*)(lds + HY_X0 + (bcol * SEQ + t0) * 2);
                      const float uu[4] = {lo2f(uw.x), hi2f(uw.x), lo2f(uw.y), hi2f(uw.y)}, xx[4] = {lo2f(xw.x), hi2f(xw.x), lo2f(xw.y), hi2f(xw.y)};
                      float y[4];
#pragma unroll
                      for (int j = 0; j < 4; ++j) { const float cv = rb == 0 ? C0[4 * (g + gg) + j] : C1[4 * (g + gg) + j]; y[j] = xx[j] * (cv + bias * uu[j]); }
                      pw[gg][0] = pkbf(y[0], y[1]); pw[gg][1] = pkbf(y[2], y[3]); }
                  const auto s0 = __builtin_amdgcn_permlane32_swap(pw[0][0], pw[1][0], false, false), s1 = __builtin_amdgcn_permlane32_swap(pw[0][1], pw[1][1], false, false);
                  u32x4 w; w.x = s0[0]; w.y = s1[0]; w.z = s0[1]; w.w = s1[1];
                  *(u32x4*)(yhT + (size_t)c * MTOK + bcol * SEQ + T0 + 64 * mcol + 32 * rb + 8 * (g + hl)) = w; } }
    }
}

DI void phase_attn_naive(const P& p) {
    const int lane = o_tid() & 63, wid = o_tid() >> 6;
    for (int vb = o_bid() * 8 + wid; vb < 64 * 32; vb += o_nb() * 8) {
    const int bh = vb >> 5, q = (vb & 31) * 64 + lane;
    const bf16_t* Q = (const bf16_t*)(p.ws + WS_Q) + ((size_t)bh * SEQ + q) * QKD;
    const bf16_t* K = (const bf16_t*)(p.ws + WS_K) + (size_t)bh * SEQ * QKD;
    const bf16_t* V = (const bf16_t*)(p.ws + WS_V) + (size_t)bh * VD * SEQ;
    float qv[QKD];
#pragma unroll
    for (int i = 0; i < QKD; ++i) qv[i] = bf2f(Q[i]);
    float o[VD];
#pragma unroll
    for (int i = 0; i < VD; ++i) o[i] = 0.f;
    float mx = -1e30f, l = 0.f;
    for (int k = 0; k < SEQ; ++k) {
        float s = 0.f;
#pragma unroll
        for (int i = 0; i < QKD; ++i) s += qv[i] * bf2f(K[(size_t)k * QKD + i]);
        const float mn = fmaxf(mx, s), al = exp2f(mx - mn), pr = exp2f(s - mn); mx = mn; l = l * al + pr;
#pragma unroll
        for (int i = 0; i < VD; ++i) o[i] = o[i] * al + pr * bf2f(V[(size_t)i * SEQ + k]);
    }
    const int b = bh >> 3, h = bh & 7; bf16_t* dst = (bf16_t*)(p.ws + WS_YATT) + ((size_t)(b * SEQ + q)) * 512 + h * VD;
#pragma unroll
    for (int i = 0; i < VD; ++i) dst[i] = f2bf(o[i] / l);
    }
}
DI void phase_hy_prep_naive(const P& p) {
    for (size_t idx = (size_t)o_bid() * NTHREADS + o_tid(); idx < (size_t)512 * MTOK; idx += (size_t)o_nb() * NTHREADS) {
    const int c = idx / MTOK, m = idx % MTOK, t = m & 2047;
    const bf16_t* uhT = (const bf16_t*)(p.ws + WS_Z);
    float r[3];
#pragma unroll
    for (int part = 0; part < 3; ++part) { const int ch = part * 512 + c; const bf16_t* row = uhT + (size_t)ch * MTOK + m;
        const float a = t > 0 ? bf2f(row[-1]) : 0.f, b = bf2f(row[0]), d = t < 2047 ? bf2f(row[1]) : 0.f;
        r[part] = a * p.sc_w[ch] + b * p.sc_w[1536 + ch] + d * p.sc_w[2 * 1536 + ch] + p.sc_b[ch]; }
    bf16_t* U = (bf16_t*)p.out; bf16_t* X0 = U + (size_t)512 * MTOK;
    U[idx] = f2bf(r[1] * r[2]); X0[idx] = f2bf(r[0]);
    }
}
DI void phase_hy_conv_naive(const P& p) {
    for (size_t idx = (size_t)o_bid() * NTHREADS + o_tid(); idx < (size_t)512 * MTOK; idx += (size_t)o_nb() * NTHREADS) {
    const int c = idx / MTOK, m = idx % MTOK, t = m & 2047, b = m >> 11;
    const bf16_t* U = (const bf16_t*)p.out + (size_t)c * MTOK + (size_t)b * SEQ; const bf16_t* X0 = (const bf16_t*)p.out + (size_t)512 * MTOK;
    const bf16_t* kr = (const bf16_t*)(p.ws + WS_KFIL) + (size_t)c * 4096;
    float acc = 0.f;
    for (int s = 0; s < SEQ; ++s) acc += bf2f(kr[2048 - t + s]) * bf2f(U[s]);
    const float y = bf2f(X0[idx]) * (acc + p.hy_bias[c] * bf2f(U[t]));
    ((bf16_t*)(p.ws + WS_YHT))[idx] = f2bf(y);
    }
}

#define XB_TMO      128
#define XB_XCNT(j)  (256  + 64 * (j))
#define XB_XSUB(j)  (1280 + 64 * (j))
#define XB_XGEN(j)  (2304 + 64 * (j))
#define XB_TOP      3328
#define XB_TOPGEN   3392
#define XCD_BAR_WORDS 3456
#define XB_SPIN_CAP (1u << 18)
DI unsigned xb_ld(unsigned* p)              { return __hip_atomic_load(p, __ATOMIC_RELAXED, __HIP_MEMORY_SCOPE_AGENT); }
DI unsigned xb_add(unsigned* p, unsigned v) { return __hip_atomic_fetch_add(p, v, __ATOMIC_RELAXED, __HIP_MEMORY_SCOPE_AGENT); }
DI unsigned xb_xcc_id() { return (unsigned)__builtin_amdgcn_s_getreg((3 << 11) | 20) & 0xFu; }
#define XB_SPIN(cond, bar) do { unsigned _sp = 0; while (cond) { __builtin_amdgcn_s_sleep(1); \
    if ((++_sp & 255u) == 0u) { if (xb_ld(&(bar)[XB_TMO])) break; if (_sp > XB_SPIN_CAP) { atomicAdd(&(bar)[XB_TMO], 1u); break; } } } } while (0)
struct XcdBarrier { unsigned* bar; unsigned x; volatile LAS unsigned* st; };
DI XcdBarrier xcd_barrier_post(unsigned* bar, volatile LAS unsigned* st) {
    XcdBarrier b; b.bar = bar; b.x = xb_xcc_id(); b.st = st;
    if (threadIdx.x == 0) (void)xb_add(&bar[XB_XCNT(b.x)], 1u);
    return b;
}
DI void xcd_barrier_complete(unsigned* bar, unsigned x, unsigned& nloc, unsigned& nx) {
    const unsigned G = gridDim.x * gridDim.y * gridDim.z;
    unsigned sum, cnt, mine, sp = 0u;
    for (;;) {
        sum = 0u; cnt = 0u; mine = 0u;
#pragma unroll
        for (unsigned j = 0; j < 16; ++j) { const unsigned c = xb_ld(&bar[XB_XCNT(j)]); sum += c; cnt += (c > 0u) ? 1u : 0u; mine = (j == x) ? c : mine; }
        if (sum == G) break;
        __builtin_amdgcn_s_sleep(1);
        if ((++sp & 255u) == 0u) { if (xb_ld(&bar[XB_TMO])) break; if (sp > XB_SPIN_CAP) { atomicAdd(&bar[XB_TMO], 1u); break; } }
    }
    nloc = mine > 0u ? mine : 1u; nx = cnt > 0u ? cnt : 1u;
}
DI void xcd_barrier(const XcdBarrier& b) {
    asm volatile("s_waitcnt vmcnt(0)" ::: "memory");
    __syncthreads();
    if (threadIdx.x == 0) {
        unsigned* bar = b.bar;
        __builtin_amdgcn_s_waitcnt(0);
        unsigned nloc = b.st[0], nx = b.st[1];
        if (nloc == 0u) { xcd_barrier_complete(bar, b.x, nloc, nx); b.st[0] = nloc; b.st[1] = nx; }
        const unsigned old = xb_add(&bar[XB_XSUB(b.x)], 1u);
        const unsigned gen = old / nloc;
        if (old + 1u == (gen + 1u) * nloc) {
            __builtin_amdgcn_fence(__ATOMIC_RELEASE, "agent");
            asm volatile("s_waitcnt vmcnt(0)" ::: "memory");
            const unsigned og = xb_add(&bar[XB_TOP], 1u);
            const unsigned tg = og / nx;
            if (og + 1u == (tg + 1u) * nx) xb_add(&bar[XB_TOPGEN], 1u);
            else XB_SPIN(xb_ld(&bar[XB_TOPGEN]) == tg, bar);
            __builtin_amdgcn_fence(__ATOMIC_ACQUIRE, "agent");
            xb_add(&bar[XB_XGEN(b.x)], 1u);
            asm volatile("s_waitcnt vmcnt(0)" ::: "memory");
        } else {
            XB_SPIN(xb_ld(&bar[XB_XGEN(b.x)]) == gen, bar);
            __builtin_amdgcn_fence(__ATOMIC_ACQUIRE, "agent");
            asm volatile("s_waitcnt vmcnt(0)" ::: "memory");
        }
    }
    __syncthreads();
}

enum { PH_PREP = 0, PH_G1, PH_G23, PH_HYP, PH_HYC, PH_QKPREP, PH_ATTN, PH_MIX, PH_G4, PH_G5, PH_G6, PH_G7, PH_COUNT };
DI void run_phase(const P& p, int ph, int dry = 0) {
    extern __shared__ __attribute__((aligned(16))) unsigned char shm[];
    switch (ph) {
        case PH_PREP: phase_prep(p, (LAS unsigned char*)shm); break;
        case PH_G1: phase_g1(p, (LAS unsigned char*)shm, dry); break;
#if NAIVE_HYENA
        case PH_G23: phase_g23(p, (LAS unsigned char*)shm); break;
#else
        case PH_G23: phase_g23(p, (LAS unsigned char*)shm); phase_hyena(p, (LAS unsigned char*)shm); break;
#endif
        case PH_QKPREP: phase_qkprep(p); break;
        case PH_HYP: phase_hy_prep_naive(p); break;
        case PH_HYC: phase_hy_conv_naive(p); break;
#if NAIVE_ATTN
        case PH_ATTN: phase_attn_naive(p); break;
#else
        case PH_ATTN: phase_attn(p, (LAS unsigned char*)shm); break;
#endif
        case PH_MIX: phase_mixprep(p, shm); break;
        case PH_G4: phase_g4(p, (LAS unsigned char*)shm, dry); break;
        case PH_G5: phase_g5(p, (LAS unsigned char*)shm); break;
        case PH_G6: phase_g6(p, (LAS unsigned char*)shm, dry); break;
        case PH_G7: phase_g7(p, (LAS unsigned char*)shm, dry); break;
    }
}
template <int PH> __global__ void __launch_bounds__(NTHREADS, 2) k_multi(P p) {
    run_phase(p, PH);
}
template <int PH> static void launch_phase(const P& p, int grid, hipStream_t stream) {
    static bool attr = false;
    if (!attr) { hipFuncSetAttribute((const void*)k_multi<PH>, hipFuncAttributeMaxDynamicSharedMemorySize, LDS_BYTES); attr = true; }
    hipLaunchKernelGGL(k_multi<PH>, dim3(grid), dim3(NTHREADS), LDS_BYTES, stream, p);
}
__global__ void __launch_bounds__(NTHREADS, 2) k_mega(P p) {
    cg::grid_group grid = cg::this_grid();
    extern __shared__ __attribute__((aligned(16))) unsigned char shm_top[];
    volatile LAS unsigned* st = (volatile LAS unsigned*)((LAS unsigned char*)shm_top + LDS_BYTES - 16);
    if (threadIdx.x == 0) { st[0] = 0u; st[1] = 0u; }
    __syncthreads();
    const XcdBarrier bar = xcd_barrier_post((unsigned*)(p.ws + WS_BAR), st);
#define GSYNC() xcd_barrier(bar)
#define RUNP(ph) do { run_phase(p, ph, 0); if (PROBE_REP == (ph)) { GSYNC(); run_phase(p, ph, 1); } } while (0)
    if (p.ws == nullptr) grid.sync();
    RUNP(PH_PREP); GSYNC();
    RUNP(PH_G1); GSYNC();
    RUNP(PH_G23); GSYNC();
    if (PROBE_REP == 100) { extern __shared__ __attribute__((aligned(16))) unsigned char shm_h[]; phase_hyena(p, (LAS unsigned char*)shm_h); GSYNC(); }
#if NAIVE_HYENA
    run_phase(p, PH_HYP); GSYNC();
    run_phase(p, PH_HYC); GSYNC();
#endif
    RUNP(PH_QKPREP); GSYNC();
    RUNP(PH_ATTN); GSYNC();
    RUNP(PH_MIX); GSYNC();
    RUNP(PH_G4); GSYNC();
    RUNP(PH_G5); GSYNC();
    RUNP(PH_G6); GSYNC();
    RUNP(PH_G7);
}

extern "C" void kernel_launch(void* const* d_in, const int* in_sizes, int n_in, void* d_out, int out_size, void* d_ws, size_t ws_size, hipStream_t stream) {
    static int grid = 0;
    if (grid == 0) {
        int dev = 0, cus = 0, per_cu = 0;
        hipGetDevice(&dev); hipDeviceGetAttribute(&cus, hipDeviceAttributeMultiprocessorCount, dev);
        if (cus <= 0) cus = 256;
        grid = cus;
#if N_LAUNCH_MODE == 1
        hipFuncSetAttribute((const void*)k_mega, hipFuncAttributeMaxDynamicSharedMemorySize, LDS_BYTES);
        hipOccupancyMaxActiveBlocksPerMultiprocessor(&per_cu, (const void*)k_mega, NTHREADS, LDS_BYTES);
        if (per_cu < 1) { fprintf(stderr, "kernel_launch: occupancy query says %d blocks/CU\n", per_cu); per_cu = 1; }
        grid = cus;
#endif
        if (ws_size < 256 * MiB) fprintf(stderr, "kernel_launch: workspace too small: %zu\n", ws_size);
    }
    P p{};
    const float** pp = (const float**)&p;
    for (int i = 0; i < 32; ++i) pp[i] = (const float*)d_in[i];
    p.out = (float*)d_out; p.ws = (unsigned char*)d_ws;
#if N_LAUNCH_MODE == 1
    hipMemsetAsync((unsigned char*)d_ws + WS_BAR, 0, XCD_BAR_WORDS * 4, stream);
    void* args[] = {&p};
    hipError_t e = hipLaunchCooperativeKernel((const void*)k_mega, dim3(grid), dim3(NTHREADS), args, LDS_BYTES, stream);
    if (e != hipSuccess) fprintf(stderr, "cooperative launch failed: %s (grid %d)\n", hipGetErrorString(e), grid);
#else
    launch_phase<PH_PREP>(p, grid, stream);
    launch_phase<PH_G1>(p, grid, stream);
    launch_phase<PH_G23>(p, grid, stream);
    launch_phase<PH_HYP>(p, grid, stream);
    launch_phase<PH_HYC>(p, grid, stream);
    launch_phase<PH_QKPREP>(p, grid, stream);
    launch_phase<PH_ATTN>(p, grid, stream);
    launch_phase<PH_MIX>(p, grid, stream);
    launch_phase<PH_G4>(p, grid, stream);
    launch_phase<PH_G5>(p, grid, stream);
    launch_phase<PH_G6>(p, grid, stream);
    launch_phase<PH_G7>(p, grid, stream);
#endif
}
```

```cpp
#include <hip/hip_runtime.h>
#include <hip/hip_cooperative_groups.h>
#include <cstdio>
namespace cg = cooperative_groups;

#ifndef N_LAUNCH_MODE
#define N_LAUNCH_MODE 1
#endif
#ifndef PROBE_REP
#define PROBE_REP -1
#endif
#ifndef NAIVE_ATTN
#define NAIVE_ATTN 0
#endif
#ifndef NAIVE_HYENA
#define NAIVE_HYENA 0
#endif

typedef unsigned short bf16_t;
typedef short bf16x8 __attribute__((ext_vector_type(8)));
typedef float f32x4 __attribute__((ext_vector_type(4)));
typedef float f32x16 __attribute__((ext_vector_type(16)));
typedef unsigned u32x4 __attribute__((ext_vector_type(4)));
typedef unsigned u32x2 __attribute__((ext_vector_type(2)));
#define LAS __attribute__((address_space(3)))
#define DI __device__ __forceinline__

constexpr int MTOK = 16384, SEQ = 2048, NB = 8, DM = 1024, PLE = 256;
constexpr int NH = 8, QKD = 96, NOPE = 64, ROPE = 32, VD = 64, QL = 768, KVL = 256;
constexpr int HYW = 512, INW = 2592, INWP = 2816, MLAW = 1056, DFF = 2816;
constexpr float EPS = 1e-6f;
constexpr int NTHREADS = 512;
constexpr int LDS_BYTES = 160 * 1024 - 4096;

constexpr size_t MiB = 1024 * 1024;
constexpr size_t WS_WIN = 0;
constexpr size_t WS_WUQ = WS_WIN + (size_t)INWP * DM * 2;
constexpr size_t WS_WUKV = WS_WUQ + (size_t)QL * QL * 2;
constexpr size_t WS_WOUT = WS_WUKV + (size_t)1024 * KVL * 2;
constexpr size_t WS_WUP = WS_WOUT + (size_t)DM * DM * 2;
constexpr size_t WS_WDOWN = WS_WUP + (size_t)2 * DFF * DM * 2;
constexpr size_t WS_WPLE = WS_WDOWN + (size_t)DM * DFF * 2;
constexpr size_t WS_WGATE = WS_WPLE + (size_t)DM * PLE * 2;
constexpr size_t WS_WEND = WS_WGATE + (size_t)DM * DM * 2;
static_assert(WS_WEND <= 29 * MiB, "weights");
constexpr size_t WS_STATS = 29 * MiB;
constexpr size_t WS_BAR = 29 * MiB + 512 * 1024;
constexpr size_t WS_KFIL = 30 * MiB;
constexpr size_t WS_PB = 34 * MiB;
constexpr size_t WS_X = 42 * MiB;
constexpr size_t WS_Y = 75 * MiB;
constexpr size_t WS_Z = 109 * MiB;
constexpr size_t WS_Q = 157 * MiB;
constexpr size_t WS_K = 181 * MiB;
constexpr size_t WS_V = 205 * MiB;
constexpr size_t WS_YHT = 221 * MiB;
constexpr size_t WS_YATT = 237 * MiB;
constexpr size_t WS_SSQAH = 253 * MiB;
constexpr size_t WS_ACT = 141 * MiB;
constexpr size_t WS_KRAW2 = WS_YATT;

struct P {
    const float *x, *p, *norm_mix, *w_in, *sc_w, *sc_b, *q_norm, *w_uq, *kv_norm, *w_ukv, *qk_nq, *qk_nk,
        *f_w1, *f_b1, *f_w2, *f_b2, *f_w3, *f_b3, *f_wout, *f_freq, *hy_bias, *on_attn, *on_hy, *w_out,
        *norm_ffn, *w_up, *fc_w, *fc_b, *w_down, *w_ple, *w_gate, *ple_norm;
    float* out; unsigned char* ws;
};

DI int o_tid() { int t = threadIdx.x; asm volatile("" : "+v"(t)); return t; }
DI int o_bid() { int t = blockIdx.x; asm volatile("" : "+s"(t)); return t; }
DI int o_nb() { int t = gridDim.x; asm volatile("" : "+s"(t)); return t; }
DI bf16_t f2bf(float f) { unsigned u = __float_as_uint(f); u += 0x7FFFu + ((u >> 16) & 1u); return (bf16_t)(u >> 16); }
DI float bf2f(bf16_t b) { return __uint_as_float(((unsigned)b) << 16); }
typedef __bf16 bf16x2_t __attribute__((ext_vector_type(2)));
typedef float f32x2_t __attribute__((ext_vector_type(2)));
DI unsigned pkbf(float a, float b) { f32x2_t f = {a, b}; bf16x2_t h = __builtin_convertvector(f, bf16x2_t); return __builtin_bit_cast(unsigned, h); }
DI unsigned pk2(float lo, float hi) { return (unsigned)f2bf(lo) | ((unsigned)f2bf(hi) << 16); }
DI float lo2f(unsigned w) { return __uint_as_float(w << 16); }
DI float hi2f(unsigned w) { return __uint_as_float(w & 0xffff0000u); }

namespace pg8 {
constexpr int BM = 256, BK = 64, HALF = 128, HTB = HALF * BK * 2, STAGE_BYTES = 8 * HTB, NXCD = 8, WGM = 8;
__host__ __device__ __forceinline__ int lds_byte(int r, int c) { const int st = (r >> 4) * 2 + (c >> 5), rr = r & 15, cc = c & 31, ob = rr * 64 + cc * 2; return st * 1024 + (ob ^ (((ob >> 9) & 1) << 5)); }
__host__ __device__ __forceinline__ void stage_rc(int b, int& R, int& C) { const int st = b / 1024, sb = b % 1024, swz = sb ^ (((sb >> 9) & 1) << 5); R = (st >> 1) * 16 + swz / 64; C = (st & 1) * 32 + (swz % 64) / 2; }
__host__ __device__ __forceinline__ int perm32(int rho) { const int n = rho >> 4, i = rho & 15; return 8 * (i >> 2) + 4 * n + (i & 3); }
struct Unit { int pm, pn; };
struct Gemm { const bf16_t* A; const bf16_t* Bt; int K, lda, nM, nN, TS, GS; int ldb = 0; int rperm = 0; int permB = 1; };
struct StaticOrder {
    int nM, nN, nwg, G, c;
    __host__ __device__ void init(int nM_, int nN_, int G_, int c_) { nM = nM_; nN = nN_; nwg = nM * nN; G = G_; c = c_; }
    __host__ __device__ bool next(int i, Unit& u) const {
        const long L = (long)i * G + c; if (L >= nwg) return false;
        int wgid = (int)L; { const int q = nwg / NXCD, r = nwg % NXCD, xcd = wgid % NXCD, off = wgid / NXCD; wgid = (xcd < r ? xcd * (q + 1) : r * (q + 1) + (xcd - r) * q) + off; }
        const int nig = WGM * nN, gid = wgid / nig, fm = gid * WGM, gsz = (nM - fm) < WGM ? (nM - fm) : WGM;
        u.pm = fm + ((wgid % nig) % gsz); u.pn = (wgid % nig) / gsz; return true;
    }
};
DI unsigned cvt_pk_bf16(float lo, float hi) { unsigned r; asm volatile("v_cvt_pk_bf16_f32 %0, %1, %2" : "=v"(r) : "v"(lo), "v"(hi)); return r; }

template <class Epi>
__device__ __forceinline__ void gemm_phase(LAS unsigned char* lds, const Gemm g, const StaticOrder& S, const Epi& E) {
    const int tid = o_tid(), wid = __builtin_amdgcn_readfirstlane(tid >> 6), lane = tid & 63, wr = wid >> 2, wc = wid & 3, fr = lane & 15, fq = lane >> 4;
    const int K = g.K, nt = K / BK, ldb = g.ldb ? g.ldb : K;
    unsigned voffA[2], voffB[2];
#pragma unroll
    for (int i = 0; i < 2; ++i) { int R, C; stage_rc(tid * 16 + i * 8192, R, C);
        const int rs = g.rperm ? (4 * (R & 15) + ((R >> 4) & 3)) : (R & 63);
        voffA[i] = (unsigned)(((R >> 6) * g.GS + rs) * g.lda + C) * 2u; const int Rb = g.permB ? ((R & ~31) + perm32(R & 31)) : R; voffB[i] = (unsigned)(Rb * ldb + C) * 2u; }
    const size_t kstep = (size_t)(BK * 2);
    const size_t hstepA = (size_t)(2 * g.GS) * g.lda * 2, tstepA = (size_t)g.TS * g.lda * 2;
    const size_t hstepB = (size_t)HALF * ldb * 2, tstepB = 2 * hstepB;
    const unsigned ldsw = (unsigned)wid * 1024u;
    const int aoff = lds_byte(wr * 64 + fr, fq * 8), boff = lds_byte(wc * 32 + fr, fq * 8);
#define PG8_SA(b, h) (((b) * 2 + (h)) * HTB)
#define PG8_SB(b, h) ((4 + (b) * 2 + (h)) * HTB)
#define PG8_STAGE(bufoff, gbase, voff) do { _Pragma("unroll") for (int _i = 0; _i < 2; ++_i) \
        __builtin_amdgcn_global_load_lds((const unsigned*)((const char*)(gbase) + (voff)[_i]), (LAS unsigned*)(lds + (bufoff) + ldsw + _i * 8192), 16, 0, 0); } while (0)
#define PG8_LDA(dst, b, h) do { _Pragma("unroll") for (int m = 0; m < 4; ++m) _Pragma("unroll") for (int k = 0; k < 2; ++k) dst[m][k] = *(const LAS bf16x8*)(lds + PG8_SA(b, h) + aoff + m * 2048 + k * 1024); } while (0)
#define PG8_LDB(dst, b, h) do { _Pragma("unroll") for (int n = 0; n < 2; ++n) _Pragma("unroll") for (int k = 0; k < 2; ++k) dst[n][k] = *(const LAS bf16x8*)(lds + PG8_SB(b, h) + boff + n * 2048 + k * 1024); } while (0)
#define PG8_MMA(ai, bj, At, Bt) do { __builtin_amdgcn_s_setprio(1); _Pragma("unroll") for (int m = 0; m < 4; ++m) _Pragma("unroll") for (int n = 0; n < 2; ++n) _Pragma("unroll") for (int k = 0; k < 2; ++k) \
        acc[ai][bj][m][n] = __builtin_amdgcn_mfma_f32_16x16x32_bf16(Bt[n][k], At[m][k], acc[ai][bj][m][n], 0, 0, 0); __builtin_amdgcn_s_setprio(0); } while (0)
#define PG8_WAIT_V(n) asm volatile("s_waitcnt vmcnt(" #n ")" ::: "memory")
#define PG8_WAIT_L(n) asm volatile("s_waitcnt lgkmcnt(" #n ")" ::: "memory")
#define PG8_BAR __builtin_amdgcn_s_barrier()
#define PG8_SCHED __builtin_amdgcn_sched_barrier(0)
    Unit cur, nxt; int ui = 0;
    if (!S.next(0, cur)) return;
    f32x4 acc[2][2][4][2];
    if constexpr (Epi::PREFETCH) E.prefetch(cur, wr, wc, lane);
    if constexpr (Epi::INIT) E.init(acc, cur, wr, wc, fr, fq);
    else {
#pragma unroll
    for (int a = 0; a < 2; ++a)
#pragma unroll
        for (int b = 0; b < 2; ++b)
#pragma unroll
            for (int m = 0; m < 4; ++m)
#pragma unroll
                for (int n = 0; n < 2; ++n) acc[a][b][m][n] = (f32x4){0.f, 0.f, 0.f, 0.f};
    }
    bf16x8 At[4][2], B0[2][2], B1[2][2];
    const char* cA = (const char*)g.A + (size_t)cur.pm * tstepA; const char* cB = (const char*)g.Bt + (size_t)cur.pn * tstepB;
    PG8_STAGE(PG8_SB(0, 0), cB, voffB); PG8_STAGE(PG8_SA(0, 0), cA, voffA); PG8_STAGE(PG8_SB(0, 1), cB + hstepB, voffB); PG8_STAGE(PG8_SA(0, 1), cA + hstepA, voffA);
    if (wr == 1) PG8_BAR;
    PG8_WAIT_V(4); PG8_BAR;
    PG8_STAGE(PG8_SB(1, 0), cB + kstep, voffB); PG8_STAGE(PG8_SA(1, 0), cA + kstep, voffA); PG8_STAGE(PG8_SB(1, 1), cB + hstepB + kstep, voffB);
    PG8_WAIT_V(6); PG8_BAR;
    for (;;) {
        const bool has_next = S.next(ui + 1, nxt);
        const char* nA = has_next ? (const char*)g.A + (size_t)nxt.pm * tstepA : cA; const char* nB = has_next ? (const char*)g.Bt + (size_t)nxt.pn * tstepB : cB;
        for (int t = 0; t < nt; t += 2) {
            const bool last = (t == nt - 2);
            if constexpr (Epi::MIDSCALE) { if (t == Epi::MID_T) E.mid(acc, cur, wr, wc, fr, fq); }
            const char* a1 = cA + (size_t)(t + 1) * kstep;
            const char* a2 = last ? nA : cA + (size_t)(t + 2) * kstep; const char* b2 = last ? nB : cB + (size_t)(t + 2) * kstep;
            const char* a3 = a2 + kstep; const char* b3 = b2 + kstep;
            PG8_LDB(B0, 0, 0); PG8_SCHED; PG8_LDA(At, 0, 0); PG8_STAGE(PG8_SA(1, 1), a1 + hstepA, voffA);
            PG8_WAIT_L(8); PG8_BAR; PG8_WAIT_L(0); PG8_MMA(0, 0, At, B0); PG8_BAR; PG8_SCHED;
            PG8_LDB(B1, 0, 1); PG8_STAGE(PG8_SB(0, 0), b2, voffB);
            PG8_BAR; PG8_WAIT_L(0); PG8_MMA(0, 1, At, B1); PG8_BAR;
            PG8_LDA(At, 0, 1); PG8_STAGE(PG8_SA(0, 0), a2, voffA);
            PG8_BAR; PG8_WAIT_L(0); PG8_MMA(1, 0, At, B0); PG8_BAR; PG8_SCHED;
            PG8_STAGE(PG8_SB(0, 1), b2 + hstepB, voffB);
            PG8_WAIT_V(6); PG8_BAR; PG8_MMA(1, 1, At, B1); PG8_BAR;
            PG8_LDB(B0, 1, 0); PG8_SCHED; PG8_LDA(At, 1, 0); PG8_STAGE(PG8_SA(0, 1), a2 + hstepA, voffA);
            PG8_WAIT_L(8); PG8_BAR; PG8_WAIT_L(0); PG8_MMA(0, 0, At, B0); PG8_BAR; PG8_SCHED;
            PG8_LDB(B1, 1, 1); PG8_STAGE(PG8_SB(1, 0), b3, voffB);
            PG8_BAR; PG8_WAIT_L(0); PG8_MMA(0, 1, At, B1); PG8_BAR;
            PG8_LDA(At, 1, 1); PG8_STAGE(PG8_SA(1, 0), a3, voffA);
            PG8_BAR; PG8_WAIT_L(0); PG8_MMA(1, 0, At, B0); PG8_BAR; PG8_SCHED;
            PG8_STAGE(PG8_SB(1, 1), b3 + hstepB, voffB);
            PG8_WAIT_V(6); PG8_BAR; PG8_MMA(1, 1, At, B1); PG8_BAR;
        }
        E(acc, cur, wr, wc, fr, fq);
        if (!has_next) break;
        if constexpr (Epi::PREFETCH) E.prefetch(nxt, wr, wc, lane);
        if constexpr (Epi::INIT) E.init(acc, nxt, wr, wc, fr, fq);
        else {
#pragma unroll
        for (int a = 0; a < 2; ++a)
#pragma unroll
            for (int b = 0; b < 2; ++b)
#pragma unroll
                for (int m = 0; m < 4; ++m)
#pragma unroll
                    for (int n = 0; n < 2; ++n) acc[a][b][m][n] = (f32x4){0.f, 0.f, 0.f, 0.f};
        }
        cur = nxt; cA = nA; cB = nB; ++ui;
    }
    PG8_WAIT_V(0);
    if (wr == 0) PG8_BAR;
    PG8_BAR;
#undef PG8_SA
#undef PG8_SB
#undef PG8_STAGE
#undef PG8_LDA
#undef PG8_LDB
#undef PG8_MMA
#undef PG8_WAIT_V
#undef PG8_WAIT_L
#undef PG8_BAR
#undef PG8_SCHED
}
}
typedef f32x4 Acc[2][2][4][2];

struct EpiProj {
    static constexpr bool MIDSCALE = false;
    static constexpr bool PREFETCH = false;
    static constexpr bool INIT = false;
    bf16_t* projm; const float* rs1; float* ssq_q; float* ssq_kv; int dry;
    DI void operator()(const Acc& acc, const pg8::Unit& u, int wr, int wc, int fr, int fq) const {
        asm volatile("" : "+v"(fr), "+v"(fq));
        float rsv[2][4];
#pragma unroll
        for (int ai = 0; ai < 2; ++ai)
#pragma unroll
            for (int m = 0; m < 4; ++m) rsv[ai][m] = rs1[u.pm * 256 + ai * 128 + wr * 64 + m * 16 + fr];
#pragma unroll
        for (int ai = 0; ai < 2; ++ai)
#pragma unroll
            for (int m = 0; m < 4; ++m) {
                const int row = u.pm * 256 + ai * 128 + wr * 64 + m * 16 + fr; const float rs = rsv[ai][m]; float ss = 0.f;
#pragma unroll
                for (int bj = 0; bj < 2; ++bj)
                    { const int c0 = u.pn * 256 + bj * 128 + wc * 32 + 8 * fq; const f32x4 v0 = acc[ai][bj][m][0] * rs, v1 = acc[ai][bj][m][1] * rs;
                        if (c0 < MLAW) { u32x4 w; w.x = pkbf(v0[0], v0[1]); w.y = pkbf(v0[2], v0[3]); w.z = pkbf(v1[0], v1[1]); w.w = pkbf(v1[2], v1[3]); *(u32x4*)(projm + (size_t)row * MLAW + c0) = w;
                            ss += v0[0] * v0[0] + v0[1] * v0[1] + v0[2] * v0[2] + v0[3] * v0[3] + v1[0] * v1[0] + v1[1] * v1[1] + v1[2] * v1[2] + v1[3] * v1[3]; }
                    }
                if (u.pn <= 3 && !dry) { ss += __shfl_xor(ss, 16); ss += __shfl_xor(ss, 32); if (fq == 0) atomicAdd((u.pn < 3 ? ssq_q : ssq_kv) + row, ss); }
            }
    }
};
struct EpiHyT {
    static constexpr bool MIDSCALE = false;
    static constexpr bool PREFETCH = false;
    static constexpr bool INIT = false;
    bf16_t* uhT; const float* rs1;
    DI void operator()(const Acc& acc, const pg8::Unit& u, int wr, int wc, int fr, int fq) const {
        asm volatile("" : "+v"(fr), "+v"(fq));
        f32x4 rsv[2][2];
#pragma unroll
        for (int bj = 0; bj < 2; ++bj)
#pragma unroll
            for (int n = 0; n < 2; ++n) rsv[bj][n] = *(const f32x4*)(rs1 + u.pn * 256 + bj * 128 + wc * 32 + 8 * fq + 4 * n);
#pragma unroll
        for (int ai = 0; ai < 2; ++ai)
#pragma unroll
            for (int m = 0; m < 4; ++m) {
                const int ch = u.pm * 256 + ai * 128 + wr * 64 + m * 16 + fr;
#pragma unroll
                for (int bj = 0; bj < 2; ++bj)
                    { const int c0 = u.pn * 256 + bj * 128 + wc * 32 + 8 * fq; const f32x4 v0 = acc[ai][bj][m][0] * rsv[bj][0], v1 = acc[ai][bj][m][1] * rsv[bj][1];
                        u32x4 w; w.x = pkbf(v0[0], v0[1]); w.y = pkbf(v0[2], v0[3]); w.z = pkbf(v1[0], v1[1]); w.w = pkbf(v1[2], v1[3]); *(u32x4*)(uhT + (size_t)ch * MTOK + c0) = w; }
            }
    }
};
struct EpiQ {
    static constexpr bool MIDSCALE = false;
    static constexpr bool PREFETCH = false;
    static constexpr bool INIT = false;
    bf16_t* qraw; const float* ssq_q;
    DI void operator()(const Acc& acc, const pg8::Unit& u, int wr, int wc, int fr, int fq) const {
        asm volatile("" : "+v"(fr), "+v"(fq));
        float rsv[2][4];
#pragma unroll
        for (int ai = 0; ai < 2; ++ai)
#pragma unroll
            for (int m = 0; m < 4; ++m) rsv[ai][m] = ssq_q[u.pm * 256 + ai * 128 + wr * 64 + m * 16 + fr];
#pragma unroll
        for (int ai = 0; ai < 2; ++ai)
#pragma unroll
            for (int m = 0; m < 4; ++m) {
                const int row = u.pm * 256 + ai * 128 + wr * 64 + m * 16 + fr; const float rs = rsqrtf(rsv[ai][m] * (1.0f / QL) + EPS);
#pragma unroll
                for (int bj = 0; bj < 2; ++bj)
                    { const int c0 = u.pn * 256 + bj * 128 + wc * 32 + 8 * fq; const f32x4 v0 = acc[ai][bj][m][0] * rs, v1 = acc[ai][bj][m][1] * rs;
                        u32x4 w; w.x = pkbf(v0[0], v0[1]); w.y = pkbf(v0[2], v0[3]); w.z = pkbf(v1[0], v1[1]); w.w = pkbf(v1[2], v1[3]); *(u32x4*)(qraw + (size_t)row * QL + c0) = w; }
                asm volatile("" ::: "memory");
            }
    }
};
struct EpiK {
    static constexpr bool MIDSCALE = false;
    static constexpr bool PREFETCH = false;
    static constexpr bool INIT = false;
    bf16_t* kraw; const float* ssq_kv;
    DI void operator()(const Acc& acc, const pg8::Unit& u, int wr, int wc, int fr, int fq) const {
        asm volatile("" : "+v"(fr), "+v"(fq));
        float rsv[2][4];
#pragma unroll
        for (int ai = 0; ai < 2; ++ai)
#pragma unroll
            for (int m = 0; m < 4; ++m) rsv[ai][m] = ssq_kv[u.pm * 256 + ai * 128 + wr * 64 + m * 16 + fr];
#pragma unroll
        for (int ai = 0; ai < 2; ++ai)
#pragma unroll
            for (int m = 0; m < 4; ++m) {
                const int row = u.pm * 256 + ai * 128 + wr * 64 + m * 16 + fr; const float rs = rsqrtf(rsv[ai][m] * (1.0f / KVL) + EPS);
#pragma unroll
                for (int bj = 0; bj < 2; ++bj)
                    { const int c0 = u.pn * 256 + bj * 128 + wc * 32 + 8 * fq; const f32x4 v0 = acc[ai][bj][m][0] * rs, v1 = acc[ai][bj][m][1] * rs;
                        u32x4 w; w.x = pkbf(v0[0], v0[1]); w.y = pkbf(v0[2], v0[3]); w.z = pkbf(v1[0], v1[1]); w.w = pkbf(v1[2], v1[3]); *(u32x4*)(kraw + (size_t)row * 512 + c0) = w; }
            }
    }
};
struct EpiVT {
    static constexpr bool MIDSCALE = false;
    static constexpr bool PREFETCH = false;
    static constexpr bool INIT = false;
    bf16_t* vt; const float* ssq_kv;
    DI void operator()(const Acc& acc, const pg8::Unit& u, int wr, int wc, int fr, int fq) const {
        asm volatile("" : "+v"(fr), "+v"(fq));
        f32x4 rsv[2][2];
#pragma unroll
        for (int bj = 0; bj < 2; ++bj)
#pragma unroll
            for (int n = 0; n < 2; ++n) { const f32x4 q = *(const f32x4*)(ssq_kv + u.pn * 256 + bj * 128 + wc * 32 + 8 * fq + 4 * n);
#pragma unroll
                for (int j = 0; j < 4; ++j) rsv[bj][n][j] = rsqrtf(q[j] * (1.0f / KVL) + EPS); }
#pragma unroll
        for (int ai = 0; ai < 2; ++ai)
#pragma unroll
            for (int m = 0; m < 4; ++m) {
                const int ch = u.pm * 256 + ai * 128 + wr * 64 + m * 16 + fr;
#pragma unroll
                for (int bj = 0; bj < 2; ++bj)
                    { const int c0 = u.pn * 256 + bj * 128 + wc * 32 + 8 * fq, b = c0 >> 11, s0 = c0 & 2047; const f32x4 v0 = acc[ai][bj][m][0] * rsv[bj][0], v1 = acc[ai][bj][m][1] * rsv[bj][1];
                        u32x4 w; w.x = pkbf(v0[0], v0[1]); w.y = pkbf(v0[2], v0[3]); w.z = pkbf(v1[0], v1[1]); w.w = pkbf(v1[2], v1[3]); *(u32x4*)(vt + ((size_t)b * 512 + ch) * SEQ + s0) = w; }
            }
    }
};
struct EpiOut {
    static constexpr bool MIDSCALE = true;
    static constexpr bool PREFETCH = false;
    static constexpr bool INIT = true;
    static constexpr int MID_T = 8;
    const bf16_t* xb; bf16_t* x1b; float* ssq2; const float* ssq_a; int dry;
    DI void mid(Acc& acc, const pg8::Unit& u, int wr, int wc, int fr, int fq) const {
        asm volatile("" : "+v"(fr), "+v"(fq));
#pragma unroll
        for (int ai = 0; ai < 2; ++ai)
#pragma unroll
            for (int m = 0; m < 4; ++m) { const f32x4* q = (const f32x4*)(ssq_a + (size_t)(u.pm * 256 + ai * 128 + wr * 64 + m * 16 + fr) * NH); const f32x4 q0 = q[0], q1 = q[1];
                const float rs = rsqrtf(((q0[0] + q0[1]) + (q0[2] + q0[3]) + (q1[0] + q1[1]) + (q1[2] + q1[3])) * (1.0f / 512) + EPS);
#pragma unroll
                for (int bj = 0; bj < 2; ++bj)
#pragma unroll
                    for (int n = 0; n < 2; ++n) acc[ai][bj][m][n] *= rs; }
    }
    DI void init(Acc& acc, const pg8::Unit& u, int wr, int wc, int fr, int fq) const {
        asm volatile("" : "+v"(fr), "+v"(fq));
#pragma unroll
        for (int ai = 0; ai < 2; ++ai)
#pragma unroll
            for (int m = 0; m < 4; ++m) { const int row = u.pm * 256 + ai * 128 + wr * 64 + m * 16 + fr; const f32x4* q = (const f32x4*)(ssq_a + (size_t)row * NH); const f32x4 q0 = q[0], q1 = q[1];
                const float ir = sqrtf(((q0[0] + q0[1]) + (q0[2] + q0[3]) + (q1[0] + q1[1]) + (q1[2] + q1[3])) * (1.0f / 512) + EPS);
#pragma unroll
                for (int bj = 0; bj < 2; ++bj)
                    { const u32x4 w = *(const u32x4*)(xb + (size_t)row * DM + u.pn * 256 + bj * 128 + wc * 32 + 8 * fq);
                        acc[ai][bj][m][0] = (f32x4){lo2f(w.x), hi2f(w.x), lo2f(w.y), hi2f(w.y)} * ir; acc[ai][bj][m][1] = (f32x4){lo2f(w.z), hi2f(w.z), lo2f(w.w), hi2f(w.w)} * ir; } }
    }
    DI void operator()(const Acc& acc, const pg8::Unit& u, int wr, int wc, int fr, int fq) const {
        asm volatile("" : "+v"(fr), "+v"(fq));
#pragma unroll
        for (int ai = 0; ai < 2; ++ai)
#pragma unroll
            for (int m = 0; m < 4; ++m) {
                const int row = u.pm * 256 + ai * 128 + wr * 64 + m * 16 + fr; float ss = 0.f;
#pragma unroll
                for (int bj = 0; bj < 2; ++bj)
                    { const int c0 = u.pn * 256 + bj * 128 + wc * 32 + 8 * fq; const size_t o = (size_t)row * DM + c0;
                        const f32x4 v0 = acc[ai][bj][m][0], v1 = acc[ai][bj][m][1];
                        u32x4 w; w.x = pkbf(v0[0], v0[1]); w.y = pkbf(v0[2], v0[3]); w.z = pkbf(v1[0], v1[1]); w.w = pkbf(v1[2], v1[3]); *(u32x4*)(x1b + o) = w;
                        ss += v0[0] * v0[0] + v0[1] * v0[1] + v0[2] * v0[2] + v0[3] * v0[3] + v1[0] * v1[0] + v1[1] * v1[1] + v1[2] * v1[2] + v1[3] * v1[3]; }
                ss += __shfl_xor(ss, 16); ss += __shfl_xor(ss, 32); if (fq == 0 && !dry) atomicAdd(ssq2 + row, ss);
            }
    }
};
struct EpiPle {
    static constexpr bool MIDSCALE = false;
    static constexpr bool PREFETCH = false;
    static constexpr bool INIT = false;
    bf16_t* eraw; float* ssq_e; int dry;
    DI void operator()(const Acc& acc, const pg8::Unit& u, int wr, int wc, int fr, int fq) const {
        asm volatile("" : "+v"(fr), "+v"(fq));
#pragma unroll
        for (int ai = 0; ai < 2; ++ai)
#pragma unroll
            for (int m = 0; m < 4; ++m) {
                const int row = u.pm * 256 + ai * 128 + wr * 64 + m * 16 + fr; float ss = 0.f;
#pragma unroll
                for (int bj = 0; bj < 2; ++bj)
                    { const int c0 = u.pn * 256 + bj * 128 + wc * 32 + 8 * fq; const f32x4 v0 = acc[ai][bj][m][0], v1 = acc[ai][bj][m][1];
                        u32x4 w; w.x = pkbf(v0[0], v0[1]); w.y = pkbf(v0[2], v0[3]); w.z = pkbf(v1[0], v1[1]); w.w = pkbf(v1[2], v1[3]); *(u32x4*)(eraw + (size_t)row * DM + c0) = w;
                        ss += v0[0] * v0[0] + v0[1] * v0[1] + v0[2] * v0[2] + v0[3] * v0[3] + v1[0] * v1[0] + v1[1] * v1[1] + v1[2] * v1[2] + v1[3] * v1[3]; }
                ss += __shfl_xor(ss, 16); ss += __shfl_xor(ss, 32); if (fq == 0 && !dry) atomicAdd(ssq_e + row, ss);                asm volatile("" ::: "memory");
            }
    }
};
DI float dpp_prev16(float v) { return __builtin_bit_cast(float, __builtin_amdgcn_update_dpp(0, __builtin_bit_cast(int, v), 0x121, 0xf, 0xf, false)); }
DI float dpp_next16(float v) { return __builtin_bit_cast(float, __builtin_amdgcn_update_dpp(0, __builtin_bit_cast(int, v), 0x12f, 0xf, 0xf, false)); }
struct EpiFfn {
    static constexpr bool MIDSCALE = false;
    static constexpr bool PREFETCH = true;
    static constexpr bool INIT = false;
    bf16_t* act; const float* ssq2; const float* cw; const float* cb; LAS float* slots;
    DI void prefetch(const pg8::Unit& u, int wr, int wc, int lane) const {
        asm volatile("" : "+v"(lane) :: "memory");
        LAS float* sl = slots + (wr * 4 + wc) * 384;
        const int pi = lane >> 3, fg = lane & 7, fb = u.pn * 128 + wc * 32 + 4 * fg;
        const float* src = ((pi & 3) == 3) ? (cb + (pi >> 2) * DFF + fb) : (cw + (pi & 3) * (2 * DFF) + (pi >> 2) * DFF + fb);
        __builtin_amdgcn_global_load_lds((const unsigned*)src, (LAS unsigned*)sl, 16, 0, 0);
#pragma unroll
        for (int ai = 0; ai < 2; ++ai) { const int tk = u.pm * 248 - 1 + (2 * ai + wr) * 62 + lane; const int tc = tk < 0 ? 0 : (tk >= MTOK ? MTOK - 1 : tk);
            __builtin_amdgcn_global_load_lds((const unsigned*)(ssq2 + tc), (LAS unsigned*)(sl + 256 + ai * 64), 4, 0, 0); }
    }
    DI void operator()(const Acc& acc, const pg8::Unit& u, int wr, int wc, int fr, int fq) const {
        asm volatile("" : "+v"(fr), "+v"(fq));
        LAS float* sl = slots + (wr * 4 + wc) * 384;
        f32x4 rsa[2];
#pragma unroll
        for (int ai = 0; ai < 2; ++ai) rsa[ai] = *(const LAS f32x4*)(sl + 256 + ai * 64 + 4 * fr);
#pragma unroll
        for (int ai = 0; ai < 2; ++ai) {
            const int tok0 = u.pm * 248 - 1 + (2 * ai + wr) * 62 + 4 * fr;
            float rsv[4], sP[4], sN[4];
#pragma unroll
            for (int m = 0; m < 4; ++m) { rsv[m] = rsqrtf(rsa[ai][m] * (1.0f / DM) + EPS); const int t = (tok0 + m) & 2047; sP[m] = (t == 2047) ? 0.f : rsv[m]; sN[m] = (t == 0) ? 0.f : rsv[m]; }
#pragma unroll
            for (int n = 0; n < 2; ++n) {
                const int f0 = u.pn * 128 + wc * 32 + 8 * fq + 4 * n;
                unsigned pk[2][4];
#pragma unroll
                for (int jp = 0; jp < 2; ++jp) {
                    float r[2][4];
#pragma unroll
                    for (int jj = 0; jj < 2; ++jj) {
                        const int j = 2 * jp + jj;
                        float gc[4];
#pragma unroll
                        for (int half = 0; half < 2; ++half) {
                            const LAS float* pp = sl + (4 * half) * 32 + 8 * fq + 4 * n + j; const float w0 = pp[0], w1 = pp[32], w2 = pp[64], bb = pp[96];
                            float x[4], xp[4], xn[4];
#pragma unroll
                            for (int m = 0; m < 4; ++m) { const float a = acc[ai][half][m][n][j]; x[m] = a * rsv[m]; xp[m] = a * sP[m]; xn[m] = a * sN[m]; }
                            const float pe = __builtin_bit_cast(float, __builtin_amdgcn_update_dpp(0, __builtin_bit_cast(int, xp[3]), 0x111, 0xf, 0xf, true));
                            const float ne = __builtin_bit_cast(float, __builtin_amdgcn_update_dpp(0, __builtin_bit_cast(int, xn[0]), 0x101, 0xf, 0xf, true));
#pragma unroll
                            for (int m = 0; m < 4; ++m) {
                                const float pv = (m == 0) ? pe : xp[m > 0 ? m - 1 : 0], nv = (m == 3) ? ne : xn[m < 3 ? m + 1 : 3];
                                const float cv = w0 * pv + w1 * x[m] + w2 * nv + bb;
                                if (half == 0) gc[m] = cv; else r[jj][m] = gc[m] * __builtin_amdgcn_rcpf(1.0f + __builtin_amdgcn_exp2f(-1.4426950408889634f * gc[m])) * cv; }
                        }
                    }
#pragma unroll
                    for (int m = 0; m < 4; ++m) pk[jp][m] = pkbf(r[0][m], r[1][m]);
                    __builtin_amdgcn_sched_barrier(0);
                }
#pragma unroll
                for (int m = 0; m < 4; ++m) {
                    const int L = 4 * fr + m, tk = tok0 + m;
                    if (L >= 1 && L <= 62 && tk >= 0 && tk < MTOK) { u32x2 w; w.x = pk[0][m]; w.y = pk[1][m]; *(u32x2*)(act + (size_t)tk * DFF + f0) = w; }
                }
            }
        }
    }
};
struct EpiDown {
    static constexpr bool MIDSCALE = false;
    static constexpr bool PREFETCH = false;
    static constexpr bool INIT = true;
    const bf16_t* x1b; bf16_t* x2b; int dry;
    DI void init(Acc& acc, const pg8::Unit& u, int wr, int wc, int fr, int fq) const {
        asm volatile("" : "+v"(fr), "+v"(fq));
#pragma unroll
        for (int ai = 0; ai < 2; ++ai)
#pragma unroll
            for (int m = 0; m < 4; ++m) { const int row = u.pm * 256 + ai * 128 + wr * 64 + m * 16 + fr;
#pragma unroll
                for (int bj = 0; bj < 2; ++bj)
                    { const u32x4 w = *(const u32x4*)(x1b + (size_t)row * DM + u.pn * 256 + bj * 128 + wc * 32 + 8 * fq);
                        acc[ai][bj][m][0] = (f32x4){lo2f(w.x), hi2f(w.x), lo2f(w.y), hi2f(w.y)}; acc[ai][bj][m][1] = (f32x4){lo2f(w.z), hi2f(w.z), lo2f(w.w), hi2f(w.w)}; } }
    }
    DI void operator()(const Acc& acc, const pg8::Unit& u, int wr, int wc, int fr, int fq) const {
        asm volatile("" : "+v"(fr), "+v"(fq));
        if (dry) return;
#pragma unroll
        for (int ai = 0; ai < 2; ++ai)
#pragma unroll
            for (int m = 0; m < 4; ++m) {
                const int row = u.pm * 256 + ai * 128 + wr * 64 + m * 16 + fr;
#pragma unroll
                for (int bj = 0; bj < 2; ++bj)
                    { const int c0 = u.pn * 256 + bj * 128 + wc * 32 + 8 * fq; const size_t o = (size_t)row * DM + c0;
                        const f32x4 v0 = acc[ai][bj][m][0], v1 = acc[ai][bj][m][1];
                        u32x4 w; w.x = pkbf(v0[0], v0[1]); w.y = pkbf(v0[2], v0[3]); w.z = pkbf(v1[0], v1[1]); w.w = pkbf(v1[2], v1[3]); *(u32x4*)(x2b + o) = w; }
            }
    }
};
struct EpiGate {
    static constexpr bool MIDSCALE = false;
    static constexpr bool PREFETCH = false;
    static constexpr bool INIT = false;
    float* out; const bf16_t* x2b; const bf16_t* eraw; const float* ssq_e; const float* gn; int dry;
    DI void operator()(const Acc& acc, const pg8::Unit& u, int wr, int wc, int fr, int fq) const {
        asm volatile("" : "+v"(fr), "+v"(fq));
        float rsv[2][4];
#pragma unroll
        for (int ai = 0; ai < 2; ++ai)
#pragma unroll
            for (int m = 0; m < 4; ++m) rsv[ai][m] = ssq_e[u.pm * 256 + ai * 128 + wr * 64 + m * 16 + fr];
#pragma unroll
        for (int ai = 0; ai < 2; ++ai)
#pragma unroll
            for (int m = 0; m < 4; ++m) {
                const int row = u.pm * 256 + ai * 128 + wr * 64 + m * 16 + fr; const float rs = rsqrtf(rsv[ai][m] * (1.0f / DM) + EPS);
#pragma unroll
                for (int bj = 0; bj < 2; ++bj)
#pragma unroll
                    for (int n = 0; n < 2; ++n) {
                        const int c0 = u.pn * 256 + bj * 128 + wc * 32 + 8 * fq + 4 * n; const size_t o = (size_t)row * DM + c0;
                        const u32x2 ew = *(const u32x2*)(eraw + o); const f32x4 g4 = *(const f32x4*)(gn + c0); const f32x4 a = acc[ai][bj][m][n];
                        f32x4 e; e[0] = lo2f(ew.x); e[1] = hi2f(ew.x); e[2] = lo2f(ew.y); e[3] = hi2f(ew.y);
                        const u32x2 xw = *(const u32x2*)(x2b + o); f32x4 v = (f32x4){lo2f(xw.x), hi2f(xw.x), lo2f(xw.y), hi2f(xw.y)};
#pragma unroll
                        for (int j = 0; j < 4; ++j) v[j] += __builtin_amdgcn_rcpf(1.0f + __builtin_amdgcn_exp2f(-1.4426950408889634f * a[j])) * e[j] * rs * g4[j];
                        if (!dry) *(f32x4*)(out + o) = v; }
                if (m & 1) asm volatile("" ::: "memory");
            }
    }
};

DI float wt_gain(const P& p, int mode, int k) {
    switch (mode) { case 1: return p.norm_mix[k]; case 2: return p.q_norm[k]; case 3: return p.kv_norm[k]; case 4: return k < 512 ? p.on_attn[k] : p.on_hy[k - 512]; case 5: return p.norm_ffn[k]; default: return 1.0f; }
}
DI void wt_tile_wave(const P& p, const float* __restrict__ src, bf16_t* __restrict__ dst, int K, int N, int tk, int tn, int mode, LAS float* lw, int lane) {
    const int k0 = tk * 64, n0 = tn * 64;
#pragma unroll
    for (int i = 0; i < 16; ++i) { const int idx = lane + 64 * i, kk = idx >> 4, c4 = idx & 15, n = n0 + 4 * c4;
        f32x4 v = (f32x4){0.f, 0.f, 0.f, 0.f}; if (n < N) v = *(const f32x4*)(src + (size_t)(k0 + kk) * N + n);
        lw[kk * 65 + 4 * c4] = v[0]; lw[kk * 65 + 4 * c4 + 1] = v[1]; lw[kk * 65 + 4 * c4 + 2] = v[2]; lw[kk * 65 + 4 * c4 + 3] = v[3]; }
#pragma unroll
    for (int i = 0; i < 8; ++i) { const int idx = lane + 64 * i, nn = idx >> 3, k8 = idx & 7, n = n0 + nn, k = k0 + 8 * k8;
        float v[8];
#pragma unroll
        for (int j = 0; j < 8; ++j) v[j] = lw[(8 * k8 + j) * 65 + nn] * wt_gain(p, mode, k + j);
        if (n < N) { int dr = n; if (mode == 5) { dr = (n < DFF) ? ((n >> 7) * 256 + (n & 127)) : (((n - DFF) >> 7) * 256 + 128 + ((n - DFF) & 127)); }
            if (mode == 3) { dr = ((n & 127) < 64) ? ((n >> 7) * 64 + (n & 63)) : (512 + (n >> 7) * 64 + (n & 63)); }
            u32x4 w; w.x = pkbf(v[0], v[1]); w.y = pkbf(v[2], v[3]); w.z = pkbf(v[4], v[5]); w.w = pkbf(v[6], v[7]);
            *(u32x4*)(dst + (size_t)dr * K + k) = w; } }
}
DI void phase_prep(const P& p, LAS unsigned char* lds) {
    const int bid = o_bid(), nb = o_nb(), tid = o_tid(), lane = tid & 63, wid = tid >> 6;
    unsigned char* ws = p.ws;
    { LAS float* lw = (LAS float*)(lds + wid * (64 * 65 * 4));
      const int gw = bid * 8 + wid, nw = nb * 8;
      int base = 0;
#define WT_JOB(SRC, DST, KK, NN, MODE) do { const int tK = (KK) / 64, tN = ((NN) + 63) / 64, nt = tK * tN; \
          for (int t = ((gw - base) % nw + nw) % nw; t < nt; t += nw) wt_tile_wave(p, (SRC), (bf16_t*)(ws + (DST)), (KK), (NN), t % tK, t / tK, (MODE), lw, lane); \
          base += nt; } while (0)
      WT_JOB(p.w_up, WS_WUP, DM, 2 * DFF, 5);
      WT_JOB(p.w_down, WS_WDOWN, DFF, DM, 0);
      WT_JOB(p.w_in, WS_WIN, DM, INW, 1);
      WT_JOB(p.w_out, WS_WOUT, DM, DM, 4);
      WT_JOB(p.w_gate, WS_WGATE, DM, DM, 0);
      WT_JOB(p.w_uq, WS_WUQ, QL, QL, 2);
      WT_JOB(p.w_ukv, WS_WUKV, KVL, 1024, 3);
      WT_JOB(p.w_ple, WS_WPLE, PLE, DM, 0);
#undef WT_JOB
    }
    { u32x4* z = (u32x4*)(ws + WS_WIN + (size_t)INW * DM * 2); const int n16 = (INWP - INW) * DM * 2 / 16;
      for (int i = bid * NTHREADS + tid; i < n16; i += nb * NTHREADS) z[i] = (u32x4){0u, 0u, 0u, 0u}; }
    { float* st = (float*)(ws + WS_STATS) + MTOK; for (int i = bid * NTHREADS + tid; i < 5 * MTOK; i += nb * NTHREADS) st[i] = 0.f; }
    { bf16_t* xb = (bf16_t*)(ws + WS_X); float* rs1 = (float*)(ws + WS_STATS);
      for (int row0 = (bid * 8 + wid) * 4; row0 < MTOK; row0 += nb * 32) {
          f32x4 v[4][4];
#pragma unroll
          for (int r = 0; r < 4; ++r)
#pragma unroll
              for (int i = 0; i < 4; ++i) v[r][i] = ((const f32x4*)(p.x + (size_t)(row0 + r) * DM))[lane + 64 * i];
#pragma unroll
          for (int r = 0; r < 4; ++r) { float ss = 0.f;
#pragma unroll
              for (int i = 0; i < 4; ++i) { const f32x4 t = v[r][i]; ss += t[0] * t[0] + t[1] * t[1] + t[2] * t[2] + t[3] * t[3];
                  u32x2 w; w.x = pkbf(t[0], t[1]); w.y = pkbf(t[2], t[3]); ((u32x2*)(xb + (size_t)(row0 + r) * DM))[lane + 64 * i] = w; }
#pragma unroll
              for (int o = 32; o >= 1; o >>= 1) ss += __shfl_xor(ss, o);
              if (lane == 0) rs1[row0 + r] = rsqrtf(ss * (1.0f / DM) + EPS); }
      } }
    { const f32x4* ps = (const f32x4*)p.p; u32x2* pd = (u32x2*)(ws + WS_PB);
      for (int i0 = bid * NTHREADS + tid; i0 < MTOK * PLE / 4; i0 += 8 * nb * NTHREADS) {
          f32x4 v[8];
#pragma unroll
          for (int k = 0; k < 8; ++k) { const int i = i0 + k * nb * NTHREADS; v[k] = (i < MTOK * PLE / 4) ? ps[i] : (f32x4){0.f, 0.f, 0.f, 0.f}; }
#pragma unroll
          for (int k = 0; k < 8; ++k) { const int i = i0 + k * nb * NTHREADS; if (i < MTOK * PLE / 4) { u32x2 w; w.x = pkbf(v[k][0], v[k][1]); w.y = pkbf(v[k][2], v[k][3]); pd[i] = w; } } } }
    { bf16_t* kfil = (bf16_t*)(ws + WS_KFIL);
      LAS float* h3s = (LAS float*)(lds + 8 * 64 * 65 * 4);
      for (int lg = bid; lg < SEQ / 8; lg += nb) {
          const int l = lg * 8 + wid;
          const float t = (float)l / (float)(SEQ - 1);
          const float w = 6.283185307179586f * (float)l / (float)SEQ;
          float z = 0.f;
          if (lane == 0) z = t;
          else if (lane <= 16) { const float fb = 1e-4f + (float)(lane - 1) * ((15.0f - 1e-4f) / 15.0f); z = cosf(w * fb); }
          else if (lane <= 32) { const float fb = 1e-4f + (float)(lane - 17) * ((15.0f - 1e-4f) / 15.0f); z = -sinf(w * fb); }
          const float fr = p.f_freq[lane];
          float a = p.f_b1[lane];
          for (int i = 0; i < 33; ++i) a += __shfl(z, i) * p.f_w1[i * 64 + lane];
          float h = sinf(fr * a);
          a = p.f_b2[lane];
          for (int i = 0; i < 64; ++i) a += __shfl(h, i) * p.f_w2[i * 64 + lane];
          h = sinf(fr * a);
          a = p.f_b3[lane];
          for (int i = 0; i < 64; ++i) a += __shfl(h, i) * p.f_w3[i * 64 + lane];
          h = sinf(fr * a);
          __syncthreads();
          h3s[wid * 64 + lane] = h;
          __syncthreads();
          float o[8][2];
#pragma unroll
          for (int q = 0; q < 8; ++q) { o[q][0] = 0.f; o[q][1] = 0.f; }
#pragma unroll 1
          for (int jb = 0; jb < 64; jb += 16) {
              float w0[16], w1[16];
              const float* wp = p.f_wout + (size_t)jb * 1024 + tid;
#pragma unroll
              for (int j = 0; j < 16; ++j) { w0[j] = wp[j * 1024]; w1[j] = wp[j * 1024 + 512]; }
#pragma unroll
              for (int j4 = 0; j4 < 4; ++j4) {
#pragma unroll
                  for (int q = 0; q < 8; ++q) { const f32x4 hv = *(const LAS f32x4*)(h3s + q * 64 + jb + 4 * j4);
#pragma unroll
                      for (int k = 0; k < 4; ++k) { o[q][0] += hv[k] * w0[4 * j4 + k]; o[q][1] += hv[k] * w1[4 * j4 + k]; } }
                  __builtin_amdgcn_sched_barrier(0); } }
          const float mind = logf(1e-2f) / 0.3f, maxd = logf(1e-2f) / 1.5f;
          const int c = tid; const float delta = fabsf(mind + (float)c * ((maxd - mind) / 511.0f));
          float ff[8], fb[8];
#pragma unroll
          for (int q = 0; q < 8; ++q) { const int lq = lg * 8 + q; const float tq = (float)lq / (float)(SEQ - 1); const float dec = expf(-tq * delta); ff[q] = o[q][0] * dec; fb[q] = o[q][1] * dec; }
          { bf16_t* row = kfil + (size_t)c * 4096;
            u32x4 w; w.x = pkbf(lg == 0 ? ff[0] : fb[0], fb[1]); w.y = pkbf(fb[2], fb[3]); w.z = pkbf(fb[4], fb[5]); w.w = pkbf(fb[6], fb[7]);
            *(u32x4*)(row + 2048 + 8 * lg) = w;
            bf16_t* f0 = row + 2041 - 8 * lg;
            f0[0] = f2bf(ff[7]); *(unsigned*)(f0 + 1) = pkbf(ff[6], ff[5]); *(unsigned*)(f0 + 3) = pkbf(ff[4], ff[3]); *(unsigned*)(f0 + 5) = pkbf(ff[2], ff[1]);
            if (lg != 0) f0[7] = f2bf(ff[0]); }
          if (lg == 0) kfil[(size_t)c * 4096] = 0;
      } }
}

DI void phase_qkprep(const P& p) {
    const int bid = o_bid(), nb = o_nb(), lane = o_tid() & 63, wid = o_tid() >> 6;
    unsigned char* ws = p.ws;
    const bf16_t* qraw = (const bf16_t*)((const unsigned char*)p.out + 32 * MiB); const bf16_t* kraw = (const bf16_t*)(ws + WS_KRAW2); const bf16_t* projm = (const bf16_t*)(ws + WS_Y);
    bf16_t* Qh = (bf16_t*)(ws + WS_Q); bf16_t* Kh = (bf16_t*)(ws + WS_K);
    const int h = lane >> 3, sub = lane & 7;
    const float qscale = 0.10206207261596575f * 1.4426950408889634f;
    float gq[12], gk[12];
#pragma unroll
    for (int i = 0; i < 8; ++i) { gq[i] = p.qk_nq[8 * sub + i]; gk[i] = p.qk_nk[8 * sub + i]; }
#pragma unroll
    for (int e = 0; e < 2; ++e) { gq[8 + e] = p.qk_nq[64 + 2 * sub + e]; gq[10 + e] = p.qk_nq[80 + 2 * sub + e]; gk[8 + e] = p.qk_nk[64 + 2 * sub + e]; gk[10 + e] = p.qk_nk[80 + 2 * sub + e]; }
    float invf[2];
#pragma unroll
    for (int e = 0; e < 2; ++e) invf[e] = powf(10000.0f, -(float)(2 * sub + e) / 16.0f);
    for (int row0 = (bid * 8 + wid) * 2; row0 < MTOK; row0 += nb * 16) {
        u32x4 la[2][2]; unsigned l1[2][2], l2[2][2];
#pragma unroll
        for (int tt = 0; tt < 2; ++tt) {
            const int row = row0 + tt;
            const bf16_t* q = qraw + (size_t)row * QL + h * QKD; const bf16_t* k = kraw + (size_t)row * 512 + h * 64; const bf16_t* pe = projm + (size_t)row * MLAW + 1024;
            la[tt][0] = *(const u32x4*)(q + 8 * sub); l1[tt][0] = *(const unsigned*)(q + 64 + 2 * sub); l2[tt][0] = *(const unsigned*)(q + 80 + 2 * sub);
            la[tt][1] = *(const u32x4*)(k + 8 * sub); l1[tt][1] = *(const unsigned*)(pe + 2 * sub); l2[tt][1] = *(const unsigned*)(pe + 16 + 2 * sub);
        }
#pragma unroll
        for (int tt = 0; tt < 2; ++tt) {
        const int row = row0 + tt;
        const int b = row >> 11, s = row & 2047;
        float cs[2], sn[2];
#pragma unroll
        for (int e = 0; e < 2; ++e) { const float ang = (float)s * invf[e]; sn[e] = sinf(ang); cs[e] = cosf(ang); }
#pragma unroll
        for (int which = 0; which < 2; ++which) {
            float v[12];
            { const u32x4 a = la[tt][which]; const unsigned r1 = l1[tt][which], r2 = l2[tt][which];
              v[0] = lo2f(a.x); v[1] = hi2f(a.x); v[2] = lo2f(a.y); v[3] = hi2f(a.y); v[4] = lo2f(a.z); v[5] = hi2f(a.z); v[6] = lo2f(a.w); v[7] = hi2f(a.w);
              v[8] = lo2f(r1); v[9] = hi2f(r1); v[10] = lo2f(r2); v[11] = hi2f(r2); }
            float ss = 0.f;
#pragma unroll
            for (int i = 0; i < 12; ++i) ss += v[i] * v[i];
            ss += __shfl_xor(ss, 1); ss += __shfl_xor(ss, 2); ss += __shfl_xor(ss, 4);
            const float rs = rsqrtf(ss * (1.0f / QKD) + EPS) * (which == 0 ? qscale : 1.0f);
#pragma unroll
            for (int i = 0; i < 12; ++i) v[i] *= rs * (which == 0 ? gq[i] : gk[i]);
            float r[4];
#pragma unroll
            for (int e = 0; e < 2; ++e) { r[e] = v[8 + e] * cs[e] - v[10 + e] * sn[e]; r[2 + e] = v[10 + e] * cs[e] + v[8 + e] * sn[e]; }
            bf16_t* dst = (which == 0 ? Qh : Kh) + ((size_t)(b * NH + h) * SEQ + s) * QKD;
            u32x4 w; w.x = pkbf(v[0], v[1]); w.y = pkbf(v[2], v[3]); w.z = pkbf(v[4], v[5]); w.w = pkbf(v[6], v[7]);
            *(u32x4*)(dst + 8 * sub) = w; *(unsigned*)(dst + 64 + 2 * sub) = pkbf(r[0], r[1]); *(unsigned*)(dst + 80 + 2 * sub) = pkbf(r[2], r[3]);
        }
        }
    }
}

DI void phase_mixprep(const P& p, unsigned char* shm) {
    const int bid = o_bid(), nb = o_nb(), tid = o_tid(), lane = tid & 63, wid = tid >> 6;
    unsigned char* ws = p.ws;
    const bf16_t* yhT = (const bf16_t*)(ws + WS_YHT); bf16_t* ymix = (bf16_t*)p.out;
    bf16_t* tile = (bf16_t*)shm;
    float* part = (float*)(shm + 512 * 66 * 2);
    for (int t0 = bid; t0 < MTOK / 64; t0 += nb) {
        const int m0 = t0 * 64;
        u32x4 hr[8];
#pragma unroll
        for (int i = 0; i < 8; ++i) { const int idx = tid + NTHREADS * i, c = idx >> 3, q = idx & 7; hr[i] = *(const u32x4*)(yhT + (size_t)c * MTOK + m0 + q * 8); }
#pragma unroll
        for (int i = 0; i < 8; ++i) { const int idx = tid + NTHREADS * i, c = idx >> 3, q = idx & 7; const u32x4 a = hr[i];
            unsigned* d = (unsigned*)(tile + c * 66 + q * 8); d[0] = a.x; d[1] = a.y; d[2] = a.z; d[3] = a.w; }
        __syncthreads();
        { const int tok = lane, part_i = wid; float ss = 0.f;
          for (int c = part_i * 64; c < part_i * 64 + 64; ++c) { const float v = bf2f(tile[c * 66 + tok]); ss += v * v; }
          part[part_i * 64 + tok] = ss; }
        __syncthreads();
        { const int tok = lane, part_i = wid; float ss = 0.f;
#pragma unroll
          for (int i = 0; i < 8; ++i) ss += part[i * 64 + tok];
          const float rs = rsqrtf(ss * (1.0f / 512) + EPS);
          bf16_t* dst = ymix + (size_t)(m0 + tok) * DM + 512 + part_i * 64;
#pragma unroll
          for (int g = 0; g < 8; ++g) { float v[8];
#pragma unroll
              for (int i = 0; i < 8; ++i) v[i] = bf2f(tile[(part_i * 64 + g * 8 + i) * 66 + tok]) * rs;
              u32x4 w; w.x = pkbf(v[0], v[1]); w.y = pkbf(v[2], v[3]); w.z = pkbf(v[4], v[5]); w.w = pkbf(v[6], v[7]); *(u32x4*)(dst + g * 8) = w; } }
        __syncthreads();
    }
}

DI void phase_g1(const P& p, LAS unsigned char* shm, int dry) {
    unsigned char* ws = p.ws; float* st = (float*)(ws + WS_STATS);
    { pg8::Gemm g{(const bf16_t*)(ws + WS_X), (const bf16_t*)(ws + WS_WIN), DM, DM, 64, 5, 256, 64};
      pg8::StaticOrder S; S.init(g.nM, g.nN, o_nb(), o_bid());
      EpiProj E{(bf16_t*)(ws + WS_Y), st, st + MTOK, st + 2 * MTOK, dry};
      pg8::gemm_phase(shm, g, S, E); }
    { pg8::Gemm g{(const bf16_t*)(ws + WS_WIN) + (size_t)MLAW * DM, (const bf16_t*)(ws + WS_X), DM, DM, 6, 64, 256, 64};
      pg8::StaticOrder S; S.init(g.nM, g.nN, o_nb(), (o_bid() + 192) % o_nb());
      EpiHyT E{(bf16_t*)(ws + WS_Z), st};
      pg8::gemm_phase(shm, g, S, E); }
}
DI void phase_g23(const P& p, LAS unsigned char* shm) {
    unsigned char* ws = p.ws; float* st = (float*)(ws + WS_STATS);
    { pg8::Gemm g{(const bf16_t*)(ws + WS_Y), (const bf16_t*)(ws + WS_WUQ), QL, MLAW, 64, 3, 256, 64};
      pg8::StaticOrder S; S.init(g.nM, g.nN, o_nb(), o_bid());
      EpiQ E{(bf16_t*)((unsigned char*)p.out + 32 * MiB), st + MTOK};
      pg8::gemm_phase(shm, g, S, E); }
    { pg8::Gemm g{(const bf16_t*)(ws + WS_Y) + QL, (const bf16_t*)(ws + WS_WUKV), KVL, MLAW, 64, 2, 256, 64};
      pg8::StaticOrder S; S.init(g.nM, g.nN, o_nb(), (o_bid() + 64) % o_nb());
      EpiK E{(bf16_t*)(ws + WS_KRAW2), st + 2 * MTOK};
      pg8::gemm_phase(shm, g, S, E); }
    { pg8::Gemm g{(const bf16_t*)(ws + WS_WUKV) + (size_t)512 * KVL, (const bf16_t*)(ws + WS_Y) + QL, KVL, KVL, 2, 64, 256, 64, MLAW};
      pg8::StaticOrder S; S.init(g.nM, g.nN, o_nb(), (o_bid() + 192) % o_nb());
      EpiVT E{(bf16_t*)(ws + WS_V), st + 2 * MTOK};
      pg8::gemm_phase(shm, g, S, E); }
}
DI void phase_g4(const P& p, LAS unsigned char* shm, int dry) {
    unsigned char* ws = p.ws; float* st = (float*)(ws + WS_STATS);
    { pg8::Gemm g{(const bf16_t*)p.out, (const bf16_t*)(ws + WS_WOUT), DM, DM, 64, 4, 256, 64};
      pg8::StaticOrder S; S.init(g.nM, g.nN, o_nb(), o_bid());
      EpiOut E{(const bf16_t*)(ws + WS_X), (bf16_t*)(ws + WS_Y + 4096), st + 3 * MTOK, (const float*)(ws + WS_SSQAH), dry};
      pg8::gemm_phase(shm, g, S, E); }
    { pg8::Gemm g{(const bf16_t*)(ws + WS_PB), (const bf16_t*)(ws + WS_WPLE), PLE, PLE, 64, 4, 256, 64};
      pg8::StaticOrder S; S.init(g.nM, g.nN, o_nb(), o_bid());
      EpiPle E{(bf16_t*)(ws + WS_Z), st + 4 * MTOK, dry};
      pg8::gemm_phase(shm, g, S, E); }
}
DI void phase_g5(const P& p, LAS unsigned char* shm) {
    unsigned char* ws = p.ws; float* st = (float*)(ws + WS_STATS);
    pg8::Gemm g{(const bf16_t*)(ws + WS_Y + 4096) - DM, (const bf16_t*)(ws + WS_WUP), DM, DM, 67, 22, 248, 62, 0, 1};
    pg8::StaticOrder S; S.init(g.nM, g.nN, o_nb(), o_bid());
    EpiFfn E{(bf16_t*)(ws + WS_ACT), st + 3 * MTOK, p.fc_w, p.fc_b, (LAS float*)(shm + pg8::STAGE_BYTES)};
    pg8::gemm_phase(shm, g, S, E);
}
DI void phase_g6(const P& p, LAS unsigned char* shm, int dry) {
    unsigned char* ws = p.ws;
    pg8::Gemm g{(const bf16_t*)(ws + WS_ACT), (const bf16_t*)(ws + WS_WDOWN), DFF, DFF, 64, 4, 256, 64};
    pg8::StaticOrder S; S.init(g.nM, g.nN, o_nb(), o_bid());
    EpiDown E{(const bf16_t*)(ws + WS_Y + 4096), (bf16_t*)(ws + WS_X), dry};
    pg8::gemm_phase(shm, g, S, E);
}
DI void phase_g7(const P& p, LAS unsigned char* shm, int dry) {
    unsigned char* ws = p.ws; float* st = (float*)(ws + WS_STATS);
    pg8::Gemm g{(const bf16_t*)(ws + WS_X), (const bf16_t*)(ws + WS_WGATE), DM, DM, 64, 4, 256, 64};
    pg8::StaticOrder S; S.init(g.nM, g.nN, o_nb(), o_bid());
    EpiGate E{p.out, (const bf16_t*)(ws + WS_X), (const bf16_t*)(ws + WS_Z), st + 4 * MTOK, p.ple_norm, dry};
    pg8::gemm_phase(shm, g, S, E);
}

#define MFMA32(a, b, c) __builtin_amdgcn_mfma_f32_32x32x16_bf16((a), (b), (c), 0, 0, 0)
constexpr int AT_KRS = 208, AT_VRS = 136, AT_KBYTES = 64 * AT_KRS, AT_VBYTES = 64 * AT_VRS, AT_BUF = AT_KBYTES + AT_VBYTES;
DI void phase_attn(const P& p, LAS unsigned char* lds) {
    const int tid = o_tid(), lane = tid & 63, wid = tid >> 6, l31 = lane & 31, hl = lane >> 5;
    const int bid = o_bid(), nb = o_nb();
    const bf16_t* Qg = (const bf16_t*)(p.ws + WS_Q); const bf16_t* Kg = (const bf16_t*)(p.ws + WS_K); const bf16_t* Vg = (const bf16_t*)(p.ws + WS_V);
    bf16_t* Y = (bf16_t*)p.out;
    float* ssq_ah = (float*)(p.ws + WS_SSQAH);
    const int kl0 = (tid / 12) * AT_KRS + (tid % 12) * 16, kl1 = ((512 + tid) / 12) * AT_KRS + ((512 + tid) % 12) * 16;
    const int vdv = tid >> 3, vpart = tid & 7, vl = vdv * AT_VRS + vpart * 16;
    for (int item = bid; item < 256; item += nb) {
        const int bh = item >> 2, q0 = (item & 3) * 512;
        bf16x8 Qf[2][6];
#pragma unroll
        for (int qb = 0; qb < 2; ++qb)
#pragma unroll
            for (int kk = 0; kk < 6; ++kk) Qf[qb][kk] = *(const bf16x8*)(Qg + ((size_t)bh * SEQ + q0 + 64 * wid + 32 * qb + l31) * QKD + 16 * kk + 8 * hl);
        f32x16 O[2][2];
#pragma unroll
        for (int a = 0; a < 2; ++a)
#pragma unroll
            for (int b = 0; b < 2; ++b)
#pragma unroll
                for (int i = 0; i < 16; ++i) O[a][b][i] = 0.f;
        float mrow[2] = {0.f, 0.f}, lsum[2] = {0.f, 0.f}; bool refs = false;
        const unsigned char* Kt = (const unsigned char*)(Kg + (size_t)bh * SEQ * QKD);
        const unsigned char* Vt = (const unsigned char*)(Vg + (size_t)bh * VD * SEQ) + (size_t)vdv * SEQ * 2 + vpart * 16;
        u32x4 kr0 = *(const u32x4*)(Kt + tid * 16), kr1 = (u32x4){0u, 0u, 0u, 0u}, vr = *(const u32x4*)(Vt);
        if (tid < 256) kr1 = *(const u32x4*)(Kt + (512 + tid) * 16);
        __syncthreads();
        *(LAS u32x4*)(lds + kl0) = kr0; if (tid < 256) *(LAS u32x4*)(lds + kl1) = kr1;
        *(LAS u32x2*)(lds + AT_KBYTES + vl) = (u32x2){vr.x, vr.y}; *(LAS u32x2*)(lds + AT_KBYTES + vl + 8) = (u32x2){vr.z, vr.w};
        __syncthreads();
#pragma unroll 1
        for (int it = 0; it < 32; ++it) {
            LAS unsigned char* kb_ = lds + (it & 1) * AT_BUF; LAS unsigned char* vb_ = kb_ + AT_KBYTES;
            if (it + 1 < 32) {
                kr0 = *(const u32x4*)(Kt + (size_t)(it + 1) * 12288 + tid * 16); if (tid < 256) kr1 = *(const u32x4*)(Kt + (size_t)(it + 1) * 12288 + (512 + tid) * 16);
                vr = *(const u32x4*)(Vt + (size_t)(it + 1) * 128); }
            f32x16 S[2][2];
#pragma unroll
            for (int a = 0; a < 2; ++a)
#pragma unroll
                for (int b = 0; b < 2; ++b)
#pragma unroll
                    for (int i = 0; i < 16; ++i) S[a][b][i] = 0.f;
#pragma unroll
            for (int kb = 0; kb < 2; ++kb)
#pragma unroll
                for (int kk = 0; kk < 6; ++kk) {
                    const bf16x8 a = *(const LAS bf16x8*)(kb_ + (32 * kb + l31) * AT_KRS + 32 * kk + 16 * hl);
                    S[kb][0] = MFMA32(a, Qf[0][kk], S[kb][0]); S[kb][1] = MFMA32(a, Qf[1][kk], S[kb][1]); }
#pragma unroll
            for (int qb = 0; qb < 2; ++qb) {
                float mx = S[0][qb][0];
#pragma unroll
                for (int i = 1; i < 16; ++i) mx = fmaxf(mx, S[0][qb][i]);
#pragma unroll
                for (int i = 0; i < 16; ++i) mx = fmaxf(mx, S[1][qb][i]);
                { float mx2 = mx; asm volatile("" : "+v"(mx2));
                  const auto r = __builtin_amdgcn_permlane32_swap(__builtin_bit_cast(unsigned, mx), __builtin_bit_cast(unsigned, mx2), false, false);
                  mx = fmaxf(__builtin_bit_cast(float, r[0]), __builtin_bit_cast(float, r[1])); }
                { const float rel = mx - mrow[qb]; const bool need = (it == 0) ? (fabsf(rel) > 8.0f) : (rel > 8.0f);
                  if (__builtin_amdgcn_ballot_w64(need) != 0ull) {
                      const float d = need ? rel : 0.f, alpha = (it == 0) ? 1.0f : __builtin_amdgcn_exp2f(-d);
                      mrow[qb] += d; lsum[qb] *= alpha; refs = true;
#pragma unroll
                      for (int dvb = 0; dvb < 2; ++dvb)
#pragma unroll
                          for (int i = 0; i < 16; ++i) O[dvb][qb][i] *= alpha;
                  } }
                if (refs) {
                    const float mm = mrow[qb];
#pragma unroll
                    for (int kb = 0; kb < 2; ++kb)
#pragma unroll
                        for (int i = 0; i < 16; ++i) S[kb][qb][i] -= mm;
                }
                float ps = 0.f;
#pragma unroll
                for (int kb = 0; kb < 2; ++kb)
#pragma unroll
                    for (int i = 0; i < 16; ++i) { const float e = __builtin_amdgcn_exp2f(S[kb][qb][i]); S[kb][qb][i] = e; ps += e; }
                lsum[qb] += ps;
            }
#pragma unroll
            for (int c = 0; c < 4; ++c) {
                const int kb = c >> 1, s8 = (c & 1) * 8;
                bf16x8 pf[2];
#pragma unroll
                for (int qb = 0; qb < 2; ++qb) { u32x4 w; w.x = pkbf(S[kb][qb][s8 + 0], S[kb][qb][s8 + 1]); w.y = pkbf(S[kb][qb][s8 + 2], S[kb][qb][s8 + 3]);
                    w.z = pkbf(S[kb][qb][s8 + 4], S[kb][qb][s8 + 5]); w.w = pkbf(S[kb][qb][s8 + 6], S[kb][qb][s8 + 7]); pf[qb] = __builtin_bit_cast(bf16x8, w); }
#pragma unroll
                for (int dvb = 0; dvb < 2; ++dvb) {
                    const LAS unsigned char* va = vb_ + (32 * dvb + l31) * AT_VRS + (16 * c + 4 * hl) * 2;
                    const u32x2 lo = *(const LAS u32x2*)va, hi = *(const LAS u32x2*)(va + 16);
                    const bf16x8 a = __builtin_bit_cast(bf16x8, (u32x4){lo.x, lo.y, hi.x, hi.y});
                    O[dvb][0] = MFMA32(a, pf[0], O[dvb][0]); O[dvb][1] = MFMA32(a, pf[1], O[dvb][1]); }
            }
            if (it + 1 < 32) {
                LAS unsigned char* kn = lds + ((it + 1) & 1) * AT_BUF;
                *(LAS u32x4*)(kn + kl0) = kr0; if (tid < 256) *(LAS u32x4*)(kn + kl1) = kr1;
                *(LAS u32x2*)(kn + AT_KBYTES + vl) = (u32x2){vr.x, vr.y}; *(LAS u32x2*)(kn + AT_KBYTES + vl + 8) = (u32x2){vr.z, vr.w}; }
            __syncthreads();
        }
        const int b = bh >> 3, h = bh & 7;
#pragma unroll
        for (int qb = 0; qb < 2; ++qb) {
            const float lt = lsum[qb] + __shfl_xor(lsum[qb], 32), inv = 1.0f / lt;
            const int orow = b * SEQ + q0 + 64 * wid + 32 * qb + l31;
            bf16_t* dst = Y + (size_t)orow * DM + h * VD;
            { float ss = 0.f;
#pragma unroll
              for (int dvb = 0; dvb < 2; ++dvb)
#pragma unroll
                  for (int i = 0; i < 16; ++i) { const float v = O[dvb][qb][i] * inv; ss += v * v; }
              ss += __shfl_xor(ss, 32);
              if (hl == 0) ssq_ah[(size_t)orow * NH + h] = ss; }
#pragma unroll
            for (int dvb = 0; dvb < 2; ++dvb)
#pragma unroll
                for (int g = 0; g < 4; g += 2) {
                    const unsigned a0 = pkbf(O[dvb][qb][4 * g] * inv, O[dvb][qb][4 * g + 1] * inv), a1 = pkbf(O[dvb][qb][4 * g + 2] * inv, O[dvb][qb][4 * g + 3] * inv);
                    const unsigned b0 = pkbf(O[dvb][qb][4 * g + 4] * inv, O[dvb][qb][4 * g + 5] * inv), b1 = pkbf(O[dvb][qb][4 * g + 6] * inv, O[dvb][qb][4 * g + 7] * inv);
                    const auto s0 = __builtin_amdgcn_permlane32_swap(a0, b0, false, false), s1 = __builtin_amdgcn_permlane32_swap(a1, b1, false, false);
                    u32x4 w; w.x = s0[0]; w.y = s1[0]; w.z = s0[1]; w.w = s1[1];
                    *(u32x4*)(dst + 32 * dvb + 8 * (g + hl)) = w; }
        }
    }
}

constexpr int HY_CS = 8224, HY_URS = 4880, HY_UP = 8 * HY_CS, HY_X0 = HY_UP + 8 * HY_URS, HY_END = HY_X0 + 8 * 2048 * 2;
static_assert(HY_END <= LDS_BYTES, "hyena LDS");
DI void phase_hyena(const P& p, LAS unsigned char* lds) {
    const int tid = o_tid(), lane = tid & 63, wid = tid >> 6, l31 = lane & 31, hl = lane >> 5;
    const int bid = o_bid(), nb = o_nb();
    const bf16_t* uhT = (const bf16_t*)(p.ws + WS_Z); const bf16_t* kfil = (const bf16_t*)(p.ws + WS_KFIL); bf16_t* yhT = (bf16_t*)(p.ws + WS_YHT);
    for (int c = bid; c < HYW; c += nb) {
        __syncthreads();
        { const bf16_t* kr = kfil + (size_t)c * 4096; const int q = tid;
          const u32x4 A = *(const u32x4*)(kr + 8 * q); const u32x4 B = (q < 511) ? *(const u32x4*)(kr + 8 * q + 8) : (u32x4){0u, 0u, 0u, 0u};
          const unsigned d[8] = {A.x, A.y, A.z, A.w, B.x, B.y, B.z, B.w};
#pragma unroll
          for (int r = 0; r < 8; ++r) { const int e = r >> 1; u32x4 o;
              if ((r & 1) == 0) { o.x = d[e]; o.y = d[e + 1]; o.z = d[e + 2]; o.w = d[e + 3]; }
              else { o.x = __builtin_amdgcn_alignbit(d[e + 1], d[e], 16); o.y = __builtin_amdgcn_alignbit(d[e + 2], d[e + 1], 16); o.z = __builtin_amdgcn_alignbit(d[e + 3], d[e + 2], 16); o.w = __builtin_amdgcn_alignbit(d[e + 4], d[e + 3], 16); }
              *(LAS u32x4*)(lds + r * HY_CS + 16 * q) = o; } }
        if (tid < 384) { const int b = tid / 48, k = tid % 48; LAS unsigned char* row = lds + HY_UP + b * HY_URS; const int off = (k < 24) ? k * 16 : (2240 * 2 + (k - 24) * 16); *(LAS u32x4*)(row + off) = (u32x4){0u, 0u, 0u, 0u}; }
        { float w0[3], w1[3], w2[3], bb[3];
#pragma unroll
          for (int a = 0; a < 3; ++a) { const int ch = a * HYW + c; w0[a] = p.sc_w[ch]; w1[a] = p.sc_w[1536 + ch]; w2[a] = p.sc_w[3072 + ch]; bb[a] = p.sc_b[ch]; }
#pragma unroll 2
          for (int i = 0; i < 4; ++i) {
              const int ch = tid + 512 * i, b = ch >> 8, t0 = (ch & 255) * 8, m0 = b * SEQ + t0;
              float r[3][8];
#pragma unroll
              for (int a = 0; a < 3; ++a) {
                  const bf16_t* row = uhT + (size_t)(a * HYW + c) * MTOK + m0;
                  const u32x4 v = *(const u32x4*)row; const float pv = t0 > 0 ? bf2f(row[-1]) : 0.f, nv = t0 < SEQ - 8 ? bf2f(row[8]) : 0.f;
                  const float x[10] = {pv, lo2f(v.x), hi2f(v.x), lo2f(v.y), hi2f(v.y), lo2f(v.z), hi2f(v.z), lo2f(v.w), hi2f(v.w), nv};
#pragma unroll
                  for (int k = 0; k < 8; ++k) r[a][k] = w0[a] * x[k] + w1[a] * x[k + 1] + w2[a] * x[k + 2] + bb[a];
              }
              u32x4 uo, xo;
              uo.x = pkbf(r[1][0] * r[2][0], r[1][1] * r[2][1]); uo.y = pkbf(r[1][2] * r[2][2], r[1][3] * r[2][3]); uo.z = pkbf(r[1][4] * r[2][4], r[1][5] * r[2][5]); uo.w = pkbf(r[1][6] * r[2][6], r[1][7] * r[2][7]);
              xo.x = pkbf(r[0][0], r[0][1]); xo.y = pkbf(r[0][2], r[0][3]); xo.z = pkbf(r[0][4], r[0][5]); xo.w = pkbf(r[0][6], r[0][7]);
              *(LAS u32x4*)(lds + HY_UP + b * HY_URS + (192 + t0) * 2) = uo; *(LAS u32x4*)(lds + HY_X0 + (b * SEQ + t0) * 2) = xo;
          } }
        __syncthreads();
        const int T0 = 256 * wid, rho = (-l31) & 7, bcol = l31 & 7, mcol = l31 >> 3;
        const LAS unsigned char* ap = lds + rho * HY_CS + 2 * (1856 - T0 + 8 * hl - l31 - rho);
        const LAS unsigned char* bp = lds + HY_UP + bcol * HY_URS + (64 * mcol + 8 * hl) * 2;
        f32x16 C0, C1;
#pragma unroll
        for (int i = 0; i < 16; ++i) { C0[i] = 0.f; C1[i] = 0.f; }
        bf16x8 am2 = *(const LAS bf16x8*)(ap - 64), am1 = *(const LAS bf16x8*)(ap - 32);
#pragma unroll 4
        for (int e = 0; e < 140; ++e) {
            const bf16x8 ac = *(const LAS bf16x8*)(ap + 32 * e); const bf16x8 bf = *(const LAS bf16x8*)(bp + 32 * e);
            C0 = MFMA32(ac, bf, C0); C1 = MFMA32(am2, bf, C1);
            am2 = am1; am1 = ac;
        }
        { const float bias = p.hy_bias[c];
#pragma unroll
          for (int rb = 0; rb < 2; ++rb)
#pragma unroll
              for (int g = 0; g < 4; g += 2) {
                  unsigned pw[2][2];
#pragma unroll
                  for (int gg = 0; gg < 2; ++gg) {
                      const int t0 = T0 + 64 * mcol + 32 * rb + 8 * (g + gg) + 4 * hl;
                      const u32x2 uw = *(const LAS u32x2*)(lds + HY_UP + bcol * HY_URS + (192 + t0) * 2), xw = *(const LAS u32x2*)(lds + HY_X0 + (bcol * SEQ + t0) * 2);
                      const float uu[4] = {lo2f(uw.x), hi2f(uw.x), lo2f(uw.y), hi2f(uw.y)}, xx[4] = {lo2f(xw.x), hi2f(xw.x), lo2f(xw.y), hi2f(xw.y)};
                      float y[4];
#pragma unroll
                      for (int j = 0; j < 4; ++j) { const float cv = rb == 0 ? C0[4 * (g + gg) + j] : C1[4 * (g + gg) + j]; y[j] = xx[j] * (cv + bias * uu[j]); }
                      pw[gg][0] = pkbf(y[0], y[1]); pw[gg][1] = pkbf(y[2], y[3]); }
                  const auto s0 = __builtin_amdgcn_permlane32_swap(pw[0][0], pw[1][0], false, false), s1 = __builtin_amdgcn_permlane32_swap(pw[0][1], pw[1][1], false, false);
                  u32x4 w; w.x = s0[0]; w.y = s1[0]; w.z = s0[1]; w.w = s1[1];
                  *(u32x4*)(yhT + (size_t)c * MTOK + bcol * SEQ + T0 + 64 * mcol + 32 * rb + 8 * (g + hl)) = w; } }
    }
}

DI void phase_attn_naive(const P& p) {
    const int lane = o_tid() & 63, wid = o_tid() >> 6;
    for (int vb = o_bid() * 8 + wid; vb < 64 * 32; vb += o_nb() * 8) {
    const int bh = vb >> 5, q = (vb & 31) * 64 + lane;
    const bf16_t* Q = (const bf16_t*)(p.ws + WS_Q) + ((size_t)bh * SEQ + q) * QKD;
    const bf16_t* K = (const bf16_t*)(p.ws + WS_K) + (size_t)bh * SEQ * QKD;
    const bf16_t* V = (const bf16_t*)(p.ws + WS_V) + (size_t)bh * VD * SEQ;
    float qv[QKD];
#pragma unroll
    for (int i = 0; i < QKD; ++i) qv[i] = bf2f(Q[i]);
    float o[VD];
#pragma unroll
    for (int i = 0; i < VD; ++i) o[i] = 0.f;
    float mx = -1e30f, l = 0.f;
    for (int k = 0; k < SEQ; ++k) {
        float s = 0.f;
#pragma unroll
        for (int i = 0; i < QKD; ++i) s += qv[i] * bf2f(K[(size_t)k * QKD + i]);
        const float mn = fmaxf(mx, s), al = exp2f(mx - mn), pr = exp2f(s - mn); mx = mn; l = l * al + pr;
#pragma unroll
        for (int i = 0; i < VD; ++i) o[i] = o[i] * al + pr * bf2f(V[(size_t)i * SEQ + k]);
    }
    const int b = bh >> 3, h = bh & 7; bf16_t* dst = (bf16_t*)(p.ws + WS_YATT) + ((size_t)(b * SEQ + q)) * 512 + h * VD;
#pragma unroll
    for (int i = 0; i < VD; ++i) dst[i] = f2bf(o[i] / l);
    }
}
DI void phase_hy_prep_naive(const P& p) {
    for (size_t idx = (size_t)o_bid() * NTHREADS + o_tid(); idx < (size_t)512 * MTOK; idx += (size_t)o_nb() * NTHREADS) {
    const int c = idx / MTOK, m = idx % MTOK, t = m & 2047;
    const bf16_t* uhT = (const bf16_t*)(p.ws + WS_Z);
    float r[3];
#pragma unroll
    for (int part = 0; part < 3; ++part) { const int ch = part * 512 + c; const bf16_t* row = uhT + (size_t)ch * MTOK + m;
        const float a = t > 0 ? bf2f(row[-1]) : 0.f, b = bf2f(row[0]), d = t < 2047 ? bf2f(row[1]) : 0.f;
        r[part] = a * p.sc_w[ch] + b * p.sc_w[1536 + ch] + d * p.sc_w[2 * 1536 + ch] + p.sc_b[ch]; }
    bf16_t* U = (bf16_t*)p.out; bf16_t* X0 = U + (size_t)512 * MTOK;
    U[idx] = f2bf(r[1] * r[2]); X0[idx] = f2bf(r[0]);
    }
}
DI void phase_hy_conv_naive(const P& p) {
    for (size_t idx = (size_t)o_bid() * NTHREADS + o_tid(); idx < (size_t)512 * MTOK; idx += (size_t)o_nb() * NTHREADS) {
    const int c = idx / MTOK, m = idx % MTOK, t = m & 2047, b = m >> 11;
    const bf16_t* U = (const bf16_t*)p.out + (size_t)c * MTOK + (size_t)b * SEQ; const bf16_t* X0 = (const bf16_t*)p.out + (size_t)512 * MTOK;
    const bf16_t* kr = (const bf16_t*)(p.ws + WS_KFIL) + (size_t)c * 4096;
    float acc = 0.f;
    for (int s = 0; s < SEQ; ++s) acc += bf2f(kr[2048 - t + s]) * bf2f(U[s]);
    const float y = bf2f(X0[idx]) * (acc + p.hy_bias[c] * bf2f(U[t]));
    ((bf16_t*)(p.ws + WS_YHT))[idx] = f2bf(y);
    }
}

#define XB_TMO      128
#define XB_XCNT(j)  (256  + 64 * (j))
#define XB_XSUB(j)  (1280 + 64 * (j))
#define XB_XGEN(j)  (2304 + 64 * (j))
#define XB_TOP      3328
#define XB_TOPGEN   3392
#define XCD_BAR_WORDS 3456
#define XB_SPIN_CAP (1u << 18)
DI unsigned xb_ld(unsigned* p)              { return __hip_atomic_load(p, __ATOMIC_RELAXED, __HIP_MEMORY_SCOPE_AGENT); }
DI unsigned xb_add(unsigned* p, unsigned v) { return __hip_atomic_fetch_add(p, v, __ATOMIC_RELAXED, __HIP_MEMORY_SCOPE_AGENT); }
DI unsigned xb_xcc_id() { return (unsigned)__builtin_amdgcn_s_getreg((3 << 11) | 20) & 0xFu; }
#define XB_SPIN(cond, bar) do { unsigned _sp = 0; while (cond) { __builtin_amdgcn_s_sleep(1); \
    if ((++_sp & 255u) == 0u) { if (xb_ld(&(bar)[XB_TMO])) break; if (_sp > XB_SPIN_CAP) { atomicAdd(&(bar)[XB_TMO], 1u); break; } } } } while (0)
struct XcdBarrier { unsigned* bar; unsigned x; volatile LAS unsigned* st; };
DI XcdBarrier xcd_barrier_post(unsigned* bar, volatile LAS unsigned* st) {
    XcdBarrier b; b.bar = bar; b.x = xb_xcc_id(); b.st = st;
    if (threadIdx.x == 0) (void)xb_add(&bar[XB_XCNT(b.x)], 1u);
    return b;
}
DI void xcd_barrier_complete(unsigned* bar, unsigned x, unsigned& nloc, unsigned& nx) {
    const unsigned G = gridDim.x * gridDim.y * gridDim.z;
    unsigned sum, cnt, mine, sp = 0u;
    for (;;) {
        sum = 0u; cnt = 0u; mine = 0u;
#pragma unroll
        for (unsigned j = 0; j < 16; ++j) { const unsigned c = xb_ld(&bar[XB_XCNT(j)]); sum += c; cnt += (c > 0u) ? 1u : 0u; mine = (j == x) ? c : mine; }
        if (sum == G) break;
        __builtin_amdgcn_s_sleep(1);
        if ((++sp & 255u) == 0u) { if (xb_ld(&bar[XB_TMO])) break; if (sp > XB_SPIN_CAP) { atomicAdd(&bar[XB_TMO], 1u); break; } }
    }
    nloc = mine > 0u ? mine : 1u; nx = cnt > 0u ? cnt : 1u;
}
DI void xcd_barrier(const XcdBarrier& b) {
    asm volatile("s_waitcnt vmcnt(0)" ::: "memory");
    __syncthreads();
    if (threadIdx.x == 0) {
        unsigned* bar = b.bar;
        __builtin_amdgcn_s_waitcnt(0);
        unsigned nloc = b.st[0], nx = b.st[1];
        if (nloc == 0u) { xcd_barrier_complete(bar, b.x, nloc, nx); b.st[0] = nloc; b.st[1] = nx; }
        const unsigned old = xb_add(&bar[XB_XSUB(b.x)], 1u);
        const unsigned gen = old / nloc;
        if (old + 1u == (gen + 1u) * nloc) {
            __builtin_amdgcn_fence(__ATOMIC_RELEASE, "agent");
            asm volatile("s_waitcnt vmcnt(0)" ::: "memory");
            const unsigned og = xb_add(&bar[XB_TOP], 1u);
            const unsigned tg = og / nx;
            if (og + 1u == (tg + 1u) * nx) xb_add(&bar[XB_TOPGEN], 1u);
            else XB_SPIN(xb_ld(&bar[XB_TOPGEN]) == tg, bar);
            __builtin_amdgcn_fence(__ATOMIC_ACQUIRE, "agent");
            xb_add(&bar[XB_XGEN(b.x)], 1u);
            asm volatile("s_waitcnt vmcnt(0)" ::: "memory");
        } else {
            XB_SPIN(xb_ld(&bar[XB_XGEN(b.x)]) == gen, bar);
            __builtin_amdgcn_fence(__ATOMIC_ACQUIRE, "agent");
            asm volatile("s_waitcnt vmcnt(0)" ::: "memory");
        }
    }
    __syncthreads();
}

enum { PH_PREP = 0, PH_G1, PH_G23, PH_HYP, PH_HYC, PH_QKPREP, PH_ATTN, PH_MIX, PH_G4, PH_G5, PH_G6, PH_G7, PH_COUNT };
DI void run_phase(const P& p, int ph, int dry = 0) {
    extern __shared__ __attribute__((aligned(16))) unsigned char shm[];
    switch (ph) {
        case PH_PREP: phase_prep(p, (LAS unsigned char*)shm); break;
        case PH_G1: phase_g1(p, (LAS unsigned char*)shm, dry); break;
#if NAIVE_HYENA
        case PH_G23: phase_g23(p, (LAS unsigned char*)shm); break;
#else
        case PH_G23: phase_g23(p, (LAS unsigned char*)shm); phase_hyena(p, (LAS unsigned char*)shm); break;
#endif
        case PH_QKPREP: phase_qkprep(p); phase_mixprep(p, shm); break;
        case PH_HYP: phase_hy_prep_naive(p); break;
        case PH_HYC: phase_hy_conv_naive(p); break;
#if NAIVE_ATTN
        case PH_ATTN: phase_attn_naive(p); break;
#else
        case PH_ATTN: phase_attn(p, (LAS unsigned char*)shm); break;
#endif
        case PH_MIX: break;
        case PH_G4: phase_g4(p, (LAS unsigned char*)shm, dry); break;
        case PH_G5: phase_g5(p, (LAS unsigned char*)shm); break;
        case PH_G6: phase_g6(p, (LAS unsigned char*)shm, dry); break;
        case PH_G7: phase_g7(p, (LAS unsigned char*)shm, dry); break;
    }
}
template <int PH> __global__ void __launch_bounds__(NTHREADS, 2) k_multi(P p) {
    run_phase(p, PH);
}
template <int PH> static void launch_phase(const P& p, int grid, hipStream_t stream) {
    static bool attr = false;
    if (!attr) { hipFuncSetAttribute((const void*)k_multi<PH>, hipFuncAttributeMaxDynamicSharedMemorySize, LDS_BYTES); attr = true; }
    hipLaunchKernelGGL(k_multi<PH>, dim3(grid), dim3(NTHREADS), LDS_BYTES, stream, p);
}
__global__ void __launch_bounds__(NTHREADS, 2) k_mega(P p) {
    cg::grid_group grid = cg::this_grid();
    extern __shared__ __attribute__((aligned(16))) unsigned char shm_top[];
    volatile LAS unsigned* st = (volatile LAS unsigned*)((LAS unsigned char*)shm_top + LDS_BYTES - 16);
    if (threadIdx.x == 0) { st[0] = 0u; st[1] = 0u; }
    __syncthreads();
    const XcdBarrier bar = xcd_barrier_post((unsigned*)(p.ws + WS_BAR), st);
#define GSYNC() xcd_barrier(bar)
#define RUNP(ph) do { run_phase(p, ph, 0); if (PROBE_REP == (ph)) { GSYNC(); run_phase(p, ph, 1); } } while (0)
    if (p.ws == nullptr) grid.sync();
    RUNP(PH_PREP); GSYNC();
    RUNP(PH_G1); GSYNC();
    RUNP(PH_G23); GSYNC();
    if (PROBE_REP == 100) { extern __shared__ __attribute__((aligned(16))) unsigned char shm_h[]; phase_hyena(p, (LAS unsigned char*)shm_h); GSYNC(); }
#if NAIVE_HYENA
    run_phase(p, PH_HYP); GSYNC();
    run_phase(p, PH_HYC); GSYNC();
#endif
    RUNP(PH_QKPREP); GSYNC();
    RUNP(PH_ATTN); GSYNC();
    RUNP(PH_G4); GSYNC();
    RUNP(PH_G5); GSYNC();
    RUNP(PH_G6); GSYNC();
    RUNP(PH_G7);
}

extern "C" void kernel_launch(void* const* d_in, const int* in_sizes, int n_in, void* d_out, int out_size, void* d_ws, size_t ws_size, hipStream_t stream) {
    static int grid = 0;
    if (grid == 0) {
        int dev = 0, cus = 0, per_cu = 0;
        hipGetDevice(&dev); hipDeviceGetAttribute(&cus, hipDeviceAttributeMultiprocessorCount, dev);
        if (cus <= 0) cus = 256;
        grid = cus;
#if N_LAUNCH_MODE == 1
        hipFuncSetAttribute((const void*)k_mega, hipFuncAttributeMaxDynamicSharedMemorySize, LDS_BYTES);
        hipOccupancyMaxActiveBlocksPerMultiprocessor(&per_cu, (const void*)k_mega, NTHREADS, LDS_BYTES);
        if (per_cu < 1) { fprintf(stderr, "kernel_launch: occupancy query says %d blocks/CU\n", per_cu); per_cu = 1; }
        grid = cus;
#endif
        if (ws_size < 256 * MiB) fprintf(stderr, "kernel_launch: workspace too small: %zu\n", ws_size);
    }
    P p{};
    const float** pp = (const float**)&p;
    for (int i = 0; i < 32; ++i) pp[i] = (const float*)d_in[i];
    p.out = (float*)d_out; p.ws = (unsigned char*)d_ws;
#if N_LAUNCH_MODE == 1
    hipMemsetAsync((unsigned char*)d_ws + WS_BAR, 0, XCD_BAR_WORDS * 4, stream);
    void* args[] = {&p};
    hipError_t e = hipLaunchCooperativeKernel((const void*)k_mega, dim3(grid), dim3(NTHREADS), args, LDS_BYTES, stream);
    if (e != hipSuccess) fprintf(stderr, "cooperative launch failed: %s (grid %d)\n", hipGetErrorString(e), grid);
#else
    launch_phase<PH_PREP>(p, grid, stream);
    launch_phase<PH_G1>(p, grid, stream);
    launch_phase<PH_G23>(p, grid, stream);
    launch_phase<PH_HYP>(p, grid, stream);
    launch_phase<PH_HYC>(p, grid, stream);
    launch_phase<PH_QKPREP>(p, grid, stream);
    launch_phase<PH_ATTN>(p, grid, stream);
    launch_phase<PH_MIX>(p, grid, stream);
    launch_phase<PH_G4>(p, grid, stream);
    launch_phase<PH_G5>(p, grid, stream);
    launch_phase<PH_G6>(p, grid, stream);
    launch_phase<PH_G7>(p, grid, stream);
#endif
}
```

```cpp
#include <hip/hip_runtime.h>
#include <hip/hip_cooperative_groups.h>
#include <cstdio>
namespace cg = cooperative_groups;

#ifndef N_LAUNCH_MODE
#define N_LAUNCH_MODE 1
#endif
#ifndef PROBE_REP
#define PROBE_REP -1
#endif
#ifndef NAIVE_ATTN
#define NAIVE_ATTN 0
#endif
#ifndef NAIVE_HYENA
#define NAIVE_HYENA 0
#endif

typedef unsigned short bf16_t;
typedef short bf16x8 __attribute__((ext_vector_type(8)));
typedef float f32x4 __attribute__((ext_vector_type(4)));
typedef float f32x16 __attribute__((ext_vector_type(16)));
typedef unsigned u32x4 __attribute__((ext_vector_type(4)));
typedef unsigned u32x2 __attribute__((ext_vector_type(2)));
#define LAS __attribute__((address_space(3)))
#define DI __device__ __forceinline__

constexpr int MTOK = 16384, SEQ = 2048, NB = 8, DM = 1024, PLE = 256;
constexpr int NH = 8, QKD = 96, NOPE = 64, ROPE = 32, VD = 64, QL = 768, KVL = 256;
constexpr int HYW = 512, INW = 2592, INWP = 2816, MLAW = 1056, DFF = 2816;
constexpr float EPS = 1e-6f;
constexpr int NTHREADS = 512;
constexpr int LDS_BYTES = 160 * 1024 - 4096;

constexpr size_t MiB = 1024 * 1024;
constexpr size_t WS_WIN = 0;
constexpr size_t WS_WUQ = WS_WIN + (size_t)INWP * DM * 2;
constexpr size_t WS_WUKV = WS_WUQ + (size_t)QL * QL * 2;
constexpr size_t WS_WOUT = WS_WUKV + (size_t)1024 * KVL * 2;
constexpr size_t WS_WUP = WS_WOUT + (size_t)DM * DM * 2;
constexpr size_t WS_WDOWN = WS_WUP + (size_t)2 * DFF * DM * 2;
constexpr size_t WS_WPLE = WS_WDOWN + (size_t)DM * DFF * 2;
constexpr size_t WS_WGATE = WS_WPLE + (size_t)DM * PLE * 2;
constexpr size_t WS_WEND = WS_WGATE + (size_t)DM * DM * 2;
static_assert(WS_WEND <= 29 * MiB, "weights");
constexpr size_t WS_STATS = 29 * MiB;
constexpr size_t WS_BAR = 29 * MiB + 512 * 1024;
constexpr size_t WS_KFIL = 30 * MiB;
constexpr size_t WS_PB = 34 * MiB;
constexpr size_t WS_X = 42 * MiB;
constexpr size_t WS_Y = 75 * MiB;
constexpr size_t WS_Z = 109 * MiB;
constexpr size_t WS_Q = 157 * MiB;
constexpr size_t WS_K = 181 * MiB;
constexpr size_t WS_V = 205 * MiB;
constexpr size_t WS_YHT = 221 * MiB;
constexpr size_t WS_YATT = 237 * MiB;
constexpr size_t WS_SSQAH = 253 * MiB;
constexpr size_t WS_ACT = 141 * MiB;
constexpr size_t WS_KRAW2 = WS_YATT;

struct P {
    const float *x, *p, *norm_mix, *w_in, *sc_w, *sc_b, *q_norm, *w_uq, *kv_norm, *w_ukv, *qk_nq, *qk_nk,
        *f_w1, *f_b1, *f_w2, *f_b2, *f_w3, *f_b3, *f_wout, *f_freq, *hy_bias, *on_attn, *on_hy, *w_out,
        *norm_ffn, *w_up, *fc_w, *fc_b, *w_down, *w_ple, *w_gate, *ple_norm;
    float* out; unsigned char* ws;
};

DI int o_tid() { int t = threadIdx.x; asm volatile("" : "+v"(t)); return t; }
DI int o_bid() { int t = blockIdx.x; asm volatile("" : "+s"(t)); return t; }
DI int o_nb() { int t = gridDim.x; asm volatile("" : "+s"(t)); return t; }
DI bf16_t f2bf(float f) { unsigned u = __float_as_uint(f); u += 0x7FFFu + ((u >> 16) & 1u); return (bf16_t)(u >> 16); }
DI float bf2f(bf16_t b) { return __uint_as_float(((unsigned)b) << 16); }
typedef __bf16 bf16x2_t __attribute__((ext_vector_type(2)));
typedef float f32x2_t __attribute__((ext_vector_type(2)));
DI unsigned pkbf(float a, float b) { f32x2_t f = {a, b}; bf16x2_t h = __builtin_convertvector(f, bf16x2_t); return __builtin_bit_cast(unsigned, h); }
DI unsigned pk2(float lo, float hi) { return (unsigned)f2bf(lo) | ((unsigned)f2bf(hi) << 16); }
DI float lo2f(unsigned w) { return __uint_as_float(w << 16); }
DI float hi2f(unsigned w) { return __uint_as_float(w & 0xffff0000u); }

namespace pg8 {
constexpr int BM = 256, BK = 64, HALF = 128, HTB = HALF * BK * 2, STAGE_BYTES = 8 * HTB, NXCD = 8, WGM = 8;
__host__ __device__ __forceinline__ int lds_byte(int r, int c) { const int st = (r >> 4) * 2 + (c >> 5), rr = r & 15, cc = c & 31, ob = rr * 64 + cc * 2; return st * 1024 + (ob ^ (((ob >> 9) & 1) << 5)); }
__host__ __device__ __forceinline__ void stage_rc(int b, int& R, int& C) { const int st = b / 1024, sb = b % 1024, swz = sb ^ (((sb >> 9) & 1) << 5); R = (st >> 1) * 16 + swz / 64; C = (st & 1) * 32 + (swz % 64) / 2; }
__host__ __device__ __forceinline__ int perm32(int rho) { const int n = rho >> 4, i = rho & 15; return 8 * (i >> 2) + 4 * n + (i & 3); }
struct Unit { int pm, pn; };
struct Gemm { const bf16_t* A; const bf16_t* Bt; int K, lda, nM, nN, TS, GS; int ldb = 0; int rperm = 0; int permB = 1; };
struct StaticOrder {
    int nM, nN, nwg, G, c;
    __host__ __device__ void init(int nM_, int nN_, int G_, int c_) { nM = nM_; nN = nN_; nwg = nM * nN; G = G_; c = c_; }
    __host__ __device__ bool next(int i, Unit& u) const {
        const long L = (long)i * G + c; if (L >= nwg) return false;
        int wgid = (int)L; { const int q = nwg / NXCD, r = nwg % NXCD, xcd = wgid % NXCD, off = wgid / NXCD; wgid = (xcd < r ? xcd * (q + 1) : r * (q + 1) + (xcd - r) * q) + off; }
        const int nig = WGM * nN, gid = wgid / nig, fm = gid * WGM, gsz = (nM - fm) < WGM ? (nM - fm) : WGM;
        u.pm = fm + ((wgid % nig) % gsz); u.pn = (wgid % nig) / gsz; return true;
    }
};
DI unsigned cvt_pk_bf16(float lo, float hi) { unsigned r; asm volatile("v_cvt_pk_bf16_f32 %0, %1, %2" : "=v"(r) : "v"(lo), "v"(hi)); return r; }

template <class Epi>
__device__ __forceinline__ void gemm_phase(LAS unsigned char* lds, const Gemm g, const StaticOrder& S, const Epi& E) {
    const int tid = o_tid(), wid = __builtin_amdgcn_readfirstlane(tid >> 6), lane = tid & 63, wr = wid >> 2, wc = wid & 3, fr = lane & 15, fq = lane >> 4;
    const int K = g.K, nt = K / BK, ldb = g.ldb ? g.ldb : K;
    unsigned voffA[2], voffB[2];
#pragma unroll
    for (int i = 0; i < 2; ++i) { int R, C; stage_rc(tid * 16 + i * 8192, R, C);
        const int rs = g.rperm ? (4 * (R & 15) + ((R >> 4) & 3)) : (R & 63);
        voffA[i] = (unsigned)(((R >> 6) * g.GS + rs) * g.lda + C) * 2u; const int Rb = g.permB ? ((R & ~31) + perm32(R & 31)) : R; voffB[i] = (unsigned)(Rb * ldb + C) * 2u; }
    const size_t kstep = (size_t)(BK * 2);
    const size_t hstepA = (size_t)(2 * g.GS) * g.lda * 2, tstepA = (size_t)g.TS * g.lda * 2;
    const size_t hstepB = (size_t)HALF * ldb * 2, tstepB = 2 * hstepB;
    const unsigned ldsw = (unsigned)wid * 1024u;
    const int aoff = lds_byte(wr * 64 + fr, fq * 8), boff = lds_byte(wc * 32 + fr, fq * 8);
#define PG8_SA(b, h) (((b) * 2 + (h)) * HTB)
#define PG8_SB(b, h) ((4 + (b) * 2 + (h)) * HTB)
#define PG8_STAGE(bufoff, gbase, voff) do { _Pragma("unroll") for (int _i = 0; _i < 2; ++_i) \
        __builtin_amdgcn_global_load_lds((const unsigned*)((const char*)(gbase) + (voff)[_i]), (LAS unsigned*)(lds + (bufoff) + ldsw + _i * 8192), 16, 0, 0); } while (0)
#define PG8_LDA(dst, b, h) do { _Pragma("unroll") for (int m = 0; m < 4; ++m) _Pragma("unroll") for (int k = 0; k < 2; ++k) dst[m][k] = *(const LAS bf16x8*)(lds + PG8_SA(b, h) + aoff + m * 2048 + k * 1024); } while (0)
#define PG8_LDB(dst, b, h) do { _Pragma("unroll") for (int n = 0; n < 2; ++n) _Pragma("unroll") for (int k = 0; k < 2; ++k) dst[n][k] = *(const LAS bf16x8*)(lds + PG8_SB(b, h) + boff + n * 2048 + k * 1024); } while (0)
#define PG8_MMA(ai, bj, At, Bt) do { __builtin_amdgcn_s_setprio(1); _Pragma("unroll") for (int m = 0; m < 4; ++m) _Pragma("unroll") for (int n = 0; n < 2; ++n) _Pragma("unroll") for (int k = 0; k < 2; ++k) \
        acc[ai][bj][m][n] = __builtin_amdgcn_mfma_f32_16x16x32_bf16(Bt[n][k], At[m][k], acc[ai][bj][m][n], 0, 0, 0); __builtin_amdgcn_s_setprio(0); } while (0)
#define PG8_WAIT_V(n) asm volatile("s_waitcnt vmcnt(" #n ")" ::: "memory")
#define PG8_WAIT_L(n) asm volatile("s_waitcnt lgkmcnt(" #n ")" ::: "memory")
#define PG8_BAR __builtin_amdgcn_s_barrier()
#define PG8_SCHED __builtin_amdgcn_sched_barrier(0)
    Unit cur, nxt; int ui = 0;
    if (!S.next(0, cur)) return;
    f32x4 acc[2][2][4][2];
    if constexpr (Epi::PREFETCH) E.prefetch(cur, wr, wc, lane);
    if constexpr (Epi::INIT) E.init(acc, cur, wr, wc, fr, fq);
    else {
#pragma unroll
    for (int a = 0; a < 2; ++a)
#pragma unroll
        for (int b = 0; b < 2; ++b)
#pragma unroll
            for (int m = 0; m < 4; ++m)
#pragma unroll
                for (int n = 0; n < 2; ++n) acc[a][b][m][n] = (f32x4){0.f, 0.f, 0.f, 0.f};
    }
    bf16x8 At[4][2], B0[2][2], B1[2][2];
    const char* cA = (const char*)g.A + (size_t)cur.pm * tstepA; const char* cB = (const char*)g.Bt + (size_t)cur.pn * tstepB;
    PG8_STAGE(PG8_SB(0, 0), cB, voffB); PG8_STAGE(PG8_SA(0, 0), cA, voffA); PG8_STAGE(PG8_SB(0, 1), cB + hstepB, voffB); PG8_STAGE(PG8_SA(0, 1), cA + hstepA, voffA);
    if (wr == 1) PG8_BAR;
    PG8_WAIT_V(4); PG8_BAR;
    PG8_STAGE(PG8_SB(1, 0), cB + kstep, voffB); PG8_STAGE(PG8_SA(1, 0), cA + kstep, voffA); PG8_STAGE(PG8_SB(1, 1), cB + hstepB + kstep, voffB);
    PG8_WAIT_V(6); PG8_BAR;
    for (;;) {
        const bool has_next = S.next(ui + 1, nxt);
        const char* nA = has_next ? (const char*)g.A + (size_t)nxt.pm * tstepA : cA; const char* nB = has_next ? (const char*)g.Bt + (size_t)nxt.pn * tstepB : cB;
        for (int t = 0; t < nt; t += 2) {
            const bool last = (t == nt - 2);
            if constexpr (Epi::MIDSCALE) { if (t == Epi::MID_T) E.mid(acc, cur, wr, wc, fr, fq); }
            const char* a1 = cA + (size_t)(t + 1) * kstep;
            const char* a2 = last ? nA : cA + (size_t)(t + 2) * kstep; const char* b2 = last ? nB : cB + (size_t)(t + 2) * kstep;
            const char* a3 = a2 + kstep; const char* b3 = b2 + kstep;
            PG8_LDB(B0, 0, 0); PG8_SCHED; PG8_LDA(At, 0, 0); PG8_STAGE(PG8_SA(1, 1), a1 + hstepA, voffA);
            PG8_WAIT_L(8); PG8_BAR; PG8_WAIT_L(0); PG8_MMA(0, 0, At, B0); PG8_BAR; PG8_SCHED;
            PG8_LDB(B1, 0, 1); PG8_STAGE(PG8_SB(0, 0), b2, voffB);
            PG8_BAR; PG8_WAIT_L(0); PG8_MMA(0, 1, At, B1); PG8_BAR;
            PG8_LDA(At, 0, 1); PG8_STAGE(PG8_SA(0, 0), a2, voffA);
            PG8_BAR; PG8_WAIT_L(0); PG8_MMA(1, 0, At, B0); PG8_BAR; PG8_SCHED;
            PG8_STAGE(PG8_SB(0, 1), b2 + hstepB, voffB);
            PG8_WAIT_V(6); PG8_BAR; PG8_MMA(1, 1, At, B1); PG8_BAR;
            PG8_LDB(B0, 1, 0); PG8_SCHED; PG8_LDA(At, 1, 0); PG8_STAGE(PG8_SA(0, 1), a2 + hstepA, voffA);
            PG8_WAIT_L(8); PG8_BAR; PG8_WAIT_L(0); PG8_MMA(0, 0, At, B0); PG8_BAR; PG8_SCHED;
            PG8_LDB(B1, 1, 1); PG8_STAGE(PG8_SB(1, 0), b3, voffB);
            PG8_BAR; PG8_WAIT_L(0); PG8_MMA(0, 1, At, B1); PG8_BAR;
            PG8_LDA(At, 1, 1); PG8_STAGE(PG8_SA(1, 0), a3, voffA);
            PG8_BAR; PG8_WAIT_L(0); PG8_MMA(1, 0, At, B0); PG8_BAR; PG8_SCHED;
            PG8_STAGE(PG8_SB(1, 1), b3 + hstepB, voffB);
            PG8_WAIT_V(6); PG8_BAR; PG8_MMA(1, 1, At, B1); PG8_BAR;
        }
        E(acc, cur, wr, wc, fr, fq);
        if (!has_next) break;
        if constexpr (Epi::PREFETCH) E.prefetch(nxt, wr, wc, lane);
        if constexpr (Epi::INIT) E.init(acc, nxt, wr, wc, fr, fq);
        else {
#pragma unroll
        for (int a = 0; a < 2; ++a)
#pragma unroll
            for (int b = 0; b < 2; ++b)
#pragma unroll
                for (int m = 0; m < 4; ++m)
#pragma unroll
                    for (int n = 0; n < 2; ++n) acc[a][b][m][n] = (f32x4){0.f, 0.f, 0.f, 0.f};
        }
        cur = nxt; cA = nA; cB = nB; ++ui;
    }
    PG8_WAIT_V(0);
    if (wr == 0) PG8_BAR;
    PG8_BAR;
#undef PG8_SA
#undef PG8_SB
#undef PG8_STAGE
#undef PG8_LDA
#undef PG8_LDB
#undef PG8_MMA
#undef PG8_WAIT_V
#undef PG8_WAIT_L
#undef PG8_BAR
#undef PG8_SCHED
}
}
typedef f32x4 Acc[2][2][4][2];

struct EpiProj {
    static constexpr bool MIDSCALE = false;
    static constexpr bool PREFETCH = false;
    static constexpr bool INIT = false;
    bf16_t* projm; const float* rs1; float* ssq_q; float* ssq_kv; int dry;
    DI void operator()(const Acc& acc, const pg8::Unit& u, int wr, int wc, int fr, int fq) const {
        asm volatile("" : "+v"(fr), "+v"(fq));
        float rsv[2][4];
#pragma unroll
        for (int ai = 0; ai < 2; ++ai)
#pragma unroll
            for (int m = 0; m < 4; ++m) rsv[ai][m] = rs1[u.pm * 256 + ai * 128 + wr * 64 + m * 16 + fr];
#pragma unroll
        for (int ai = 0; ai < 2; ++ai)
#pragma unroll
            for (int m = 0; m < 4; ++m) {
                const int row = u.pm * 256 + ai * 128 + wr * 64 + m * 16 + fr; const float rs = rsv[ai][m]; float ss = 0.f;
#pragma unroll
                for (int bj = 0; bj < 2; ++bj)
                    { const int c0 = u.pn * 256 + bj * 128 + wc * 32 + 8 * fq; const f32x4 v0 = acc[ai][bj][m][0] * rs, v1 = acc[ai][bj][m][1] * rs;
                        if (c0 < MLAW) { u32x4 w; w.x = pkbf(v0[0], v0[1]); w.y = pkbf(v0[2], v0[3]); w.z = pkbf(v1[0], v1[1]); w.w = pkbf(v1[2], v1[3]); *(u32x4*)(projm + (size_t)row * MLAW + c0) = w;
                            ss += v0[0] * v0[0] + v0[1] * v0[1] + v0[2] * v0[2] + v0[3] * v0[3] + v1[0] * v1[0] + v1[1] * v1[1] + v1[2] * v1[2] + v1[3] * v1[3]; }
                    }
                if (u.pn <= 3 && !dry) { ss += __shfl_xor(ss, 16); ss += __shfl_xor(ss, 32); if (fq == 0) atomicAdd((u.pn < 3 ? ssq_q : ssq_kv) + row, ss); }
            }
    }
};
struct EpiHyT {
    static constexpr bool MIDSCALE = false;
    static constexpr bool PREFETCH = false;
    static constexpr bool INIT = false;
    bf16_t* uhT; const float* rs1;
    DI void operator()(const Acc& acc, const pg8::Unit& u, int wr, int wc, int fr, int fq) const {
        asm volatile("" : "+v"(fr), "+v"(fq));
        f32x4 rsv[2][2];
#pragma unroll
        for (int bj = 0; bj < 2; ++bj)
#pragma unroll
            for (int n = 0; n < 2; ++n) rsv[bj][n] = *(const f32x4*)(rs1 + u.pn * 256 + bj * 128 + wc * 32 + 8 * fq + 4 * n);
#pragma unroll
        for (int ai = 0; ai < 2; ++ai)
#pragma unroll
            for (int m = 0; m < 4; ++m) {
                const int ch = u.pm * 256 + ai * 128 + wr * 64 + m * 16 + fr;
#pragma unroll
                for (int bj = 0; bj < 2; ++bj)
                    { const int c0 = u.pn * 256 + bj * 128 + wc * 32 + 8 * fq; const f32x4 v0 = acc[ai][bj][m][0] * rsv[bj][0], v1 = acc[ai][bj][m][1] * rsv[bj][1];
                        u32x4 w; w.x = pkbf(v0[0], v0[1]); w.y = pkbf(v0[2], v0[3]); w.z = pkbf(v1[0], v1[1]); w.w = pkbf(v1[2], v1[3]); *(u32x4*)(uhT + (size_t)ch * MTOK + c0) = w; }
            }
    }
};
struct EpiQ {
    static constexpr bool MIDSCALE = false;
    static constexpr bool PREFETCH = false;
    static constexpr bool INIT = false;
    bf16_t* qraw; const float* ssq_q;
    DI void operator()(const Acc& acc, const pg8::Unit& u, int wr, int wc, int fr, int fq) const {
        asm volatile("" : "+v"(fr), "+v"(fq));
        float rsv[2][4];
#pragma unroll
        for (int ai = 0; ai < 2; ++ai)
#pragma unroll
            for (int m = 0; m < 4; ++m) rsv[ai][m] = ssq_q[u.pm * 256 + ai * 128 + wr * 64 + m * 16 + fr];
#pragma unroll
        for (int ai = 0; ai < 2; ++ai)
#pragma unroll
            for (int m = 0; m < 4; ++m) {
                const int row = u.pm * 256 + ai * 128 + wr * 64 + m * 16 + fr; const float rs = rsqrtf(rsv[ai][m] * (1.0f / QL) + EPS);
#pragma unroll
                for (int bj = 0; bj < 2; ++bj)
                    { const int c0 = u.pn * 256 + bj * 128 + wc * 32 + 8 * fq; const f32x4 v0 = acc[ai][bj][m][0] * rs, v1 = acc[ai][bj][m][1] * rs;
                        u32x4 w; w.x = pkbf(v0[0], v0[1]); w.y = pkbf(v0[2], v0[3]); w.z = pkbf(v1[0], v1[1]); w.w = pkbf(v1[2], v1[3]); *(u32x4*)(qraw + (size_t)row * QL + c0) = w; }
                asm volatile("" ::: "memory");
            }
    }
};
struct EpiK {
    static constexpr bool MIDSCALE = false;
    static constexpr bool PREFETCH = false;
    static constexpr bool INIT = false;
    bf16_t* kraw; const float* ssq_kv;
    DI void operator()(const Acc& acc, const pg8::Unit& u, int wr, int wc, int fr, int fq) const {
        asm volatile("" : "+v"(fr), "+v"(fq));
        float rsv[2][4];
#pragma unroll
        for (int ai = 0; ai < 2; ++ai)
#pragma unroll
            for (int m = 0; m < 4; ++m) rsv[ai][m] = ssq_kv[u.pm * 256 + ai * 128 + wr * 64 + m * 16 + fr];
#pragma unroll
        for (int ai = 0; ai < 2; ++ai)
#pragma unroll
            for (int m = 0; m < 4; ++m) {
                const int row = u.pm * 256 + ai * 128 + wr * 64 + m * 16 + fr; const float rs = rsqrtf(rsv[ai][m] * (1.0f / KVL) + EPS);
#pragma unroll
                for (int bj = 0; bj < 2; ++bj)
                    { const int c0 = u.pn * 256 + bj * 128 + wc * 32 + 8 * fq; const f32x4 v0 = acc[ai][bj][m][0] * rs, v1 = acc[ai][bj][m][1] * rs;
                        u32x4 w; w.x = pkbf(v0[0], v0[1]); w.y = pkbf(v0[2], v0[3]); w.z = pkbf(v1[0], v1[1]); w.w = pkbf(v1[2], v1[3]); *(u32x4*)(kraw + (size_t)row * 512 + c0) = w; }
            }
    }
};
struct EpiVT {
    static constexpr bool MIDSCALE = false;
    static constexpr bool PREFETCH = false;
    static constexpr bool INIT = false;
    bf16_t* vt; const float* ssq_kv;
    DI void operator()(const Acc& acc, const pg8::Unit& u, int wr, int wc, int fr, int fq) const {
        asm volatile("" : "+v"(fr), "+v"(fq));
        f32x4 rsv[2][2];
#pragma unroll
        for (int bj = 0; bj < 2; ++bj)
#pragma unroll
            for (int n = 0; n < 2; ++n) { const f32x4 q = *(const f32x4*)(ssq_kv + u.pn * 256 + bj * 128 + wc * 32 + 8 * fq + 4 * n);
#pragma unroll
                for (int j = 0; j < 4; ++j) rsv[bj][n][j] = rsqrtf(q[j] * (1.0f / KVL) + EPS); }
#pragma unroll
        for (int ai = 0; ai < 2; ++ai)
#pragma unroll
            for (int m = 0; m < 4; ++m) {
                const int ch = u.pm * 256 + ai * 128 + wr * 64 + m * 16 + fr;
#pragma unroll
                for (int bj = 0; bj < 2; ++bj)
                    { const int c0 = u.pn * 256 + bj * 128 + wc * 32 + 8 * fq, b = c0 >> 11, s0 = c0 & 2047; const f32x4 v0 = acc[ai][bj][m][0] * rsv[bj][0], v1 = acc[ai][bj][m][1] * rsv[bj][1];
                        u32x4 w; w.x = pkbf(v0[0], v0[1]); w.y = pkbf(v0[2], v0[3]); w.z = pkbf(v1[0], v1[1]); w.w = pkbf(v1[2], v1[3]); *(u32x4*)(vt + ((size_t)b * 512 + ch) * SEQ + s0) = w; }
            }
    }
};
struct EpiOut {
    static constexpr bool MIDSCALE = true;
    static constexpr bool PREFETCH = false;
    static constexpr bool INIT = true;
    static constexpr int MID_T = 8;
    const bf16_t* xb; bf16_t* x1b; float* ssq2; const float* ssq_a; int dry;
    DI void mid(Acc& acc, const pg8::Unit& u, int wr, int wc, int fr, int fq) const {
        asm volatile("" : "+v"(fr), "+v"(fq));
#pragma unroll
        for (int ai = 0; ai < 2; ++ai)
#pragma unroll
            for (int m = 0; m < 4; ++m) { const f32x4* q = (const f32x4*)(ssq_a + (size_t)(u.pm * 256 + ai * 128 + wr * 64 + m * 16 + fr) * NH); const f32x4 q0 = q[0], q1 = q[1];
                const float rs = rsqrtf(((q0[0] + q0[1]) + (q0[2] + q0[3]) + (q1[0] + q1[1]) + (q1[2] + q1[3])) * (1.0f / 512) + EPS);
#pragma unroll
                for (int bj = 0; bj < 2; ++bj)
#pragma unroll
                    for (int n = 0; n < 2; ++n) acc[ai][bj][m][n] *= rs; }
    }
    DI void init(Acc& acc, const pg8::Unit& u, int wr, int wc, int fr, int fq) const {
        asm volatile("" : "+v"(fr), "+v"(fq));
#pragma unroll
        for (int ai = 0; ai < 2; ++ai)
#pragma unroll
            for (int m = 0; m < 4; ++m) { const int row = u.pm * 256 + ai * 128 + wr * 64 + m * 16 + fr; const f32x4* q = (const f32x4*)(ssq_a + (size_t)row * NH); const f32x4 q0 = q[0], q1 = q[1];
                const float ir = sqrtf(((q0[0] + q0[1]) + (q0[2] + q0[3]) + (q1[0] + q1[1]) + (q1[2] + q1[3])) * (1.0f / 512) + EPS);
#pragma unroll
                for (int bj = 0; bj < 2; ++bj)
                    { const u32x4 w = *(const u32x4*)(xb + (size_t)row * DM + u.pn * 256 + bj * 128 + wc * 32 + 8 * fq);
                        acc[ai][bj][m][0] = (f32x4){lo2f(w.x), hi2f(w.x), lo2f(w.y), hi2f(w.y)} * ir; acc[ai][bj][m][1] = (f32x4){lo2f(w.z), hi2f(w.z), lo2f(w.w), hi2f(w.w)} * ir; } }
    }
    DI void operator()(const Acc& acc, const pg8::Unit& u, int wr, int wc, int fr, int fq) const {
        asm volatile("" : "+v"(fr), "+v"(fq));
#pragma unroll
        for (int ai = 0; ai < 2; ++ai)
#pragma unroll
            for (int m = 0; m < 4; ++m) {
                const int row = u.pm * 256 + ai * 128 + wr * 64 + m * 16 + fr; float ss = 0.f;
#pragma unroll
                for (int bj = 0; bj < 2; ++bj)
                    { const int c0 = u.pn * 256 + bj * 128 + wc * 32 + 8 * fq; const size_t o = (size_t)row * DM + c0;
                        const f32x4 v0 = acc[ai][bj][m][0], v1 = acc[ai][bj][m][1];
                        u32x4 w; w.x = pkbf(v0[0], v0[1]); w.y = pkbf(v0[2], v0[3]); w.z = pkbf(v1[0], v1[1]); w.w = pkbf(v1[2], v1[3]); *(u32x4*)(x1b + o) = w;
                        ss += v0[0] * v0[0] + v0[1] * v0[1] + v0[2] * v0[2] + v0[3] * v0[3] + v1[0] * v1[0] + v1[1] * v1[1] + v1[2] * v1[2] + v1[3] * v1[3]; }
                ss += __shfl_xor(ss, 16); ss += __shfl_xor(ss, 32); if (fq == 0 && !dry) atomicAdd(ssq2 + row, ss);
            }
    }
};
struct EpiPle {
    static constexpr bool MIDSCALE = false;
    static constexpr bool PREFETCH = false;
    static constexpr bool INIT = false;
    bf16_t* eraw; float* ssq_e; int dry;
    DI void operator()(const Acc& acc, const pg8::Unit& u, int wr, int wc, int fr, int fq) const {
        asm volatile("" : "+v"(fr), "+v"(fq));
#pragma unroll
        for (int ai = 0; ai < 2; ++ai)
#pragma unroll
            for (int m = 0; m < 4; ++m) {
                const int row = u.pm * 256 + ai * 128 + wr * 64 + m * 16 + fr; float ss = 0.f;
#pragma unroll
                for (int bj = 0; bj < 2; ++bj)
                    { const int c0 = u.pn * 256 + bj * 128 + wc * 32 + 8 * fq; const f32x4 v0 = acc[ai][bj][m][0], v1 = acc[ai][bj][m][1];
                        u32x4 w; w.x = pkbf(v0[0], v0[1]); w.y = pkbf(v0[2], v0[3]); w.z = pkbf(v1[0], v1[1]); w.w = pkbf(v1[2], v1[3]); *(u32x4*)(eraw + (size_t)row * DM + c0) = w;
                        ss += v0[0] * v0[0] + v0[1] * v0[1] + v0[2] * v0[2] + v0[3] * v0[3] + v1[0] * v1[0] + v1[1] * v1[1] + v1[2] * v1[2] + v1[3] * v1[3]; }
                ss += __shfl_xor(ss, 16); ss += __shfl_xor(ss, 32); if (fq == 0 && !dry) atomicAdd(ssq_e + row, ss);                asm volatile("" ::: "memory");
            }
    }
};
DI float dpp_prev16(float v) { return __builtin_bit_cast(float, __builtin_amdgcn_update_dpp(0, __builtin_bit_cast(int, v), 0x121, 0xf, 0xf, false)); }
DI float dpp_next16(float v) { return __builtin_bit_cast(float, __builtin_amdgcn_update_dpp(0, __builtin_bit_cast(int, v), 0x12f, 0xf, 0xf, false)); }
struct EpiFfn {
    static constexpr bool MIDSCALE = false;
    static constexpr bool PREFETCH = true;
    static constexpr bool INIT = false;
    bf16_t* act; const float* ssq2; const float* cw; const float* cb; LAS float* slots;
    DI void prefetch(const pg8::Unit& u, int wr, int wc, int lane) const {
        asm volatile("" : "+v"(lane) :: "memory");
        LAS float* sl = slots + (wr * 4 + wc) * 384;
        const int pi = lane >> 3, fg = lane & 7, fb = u.pn * 128 + wc * 32 + 4 * fg;
        const float* src = ((pi & 3) == 3) ? (cb + (pi >> 2) * DFF + fb) : (cw + (pi & 3) * (2 * DFF) + (pi >> 2) * DFF + fb);
        __builtin_amdgcn_global_load_lds((const unsigned*)src, (LAS unsigned*)sl, 16, 0, 0);
#pragma unroll
        for (int ai = 0; ai < 2; ++ai) { const int tk = u.pm * 248 - 1 + (2 * ai + wr) * 62 + lane; const int tc = tk < 0 ? 0 : (tk >= MTOK ? MTOK - 1 : tk);
            __builtin_amdgcn_global_load_lds((const unsigned*)(ssq2 + tc), (LAS unsigned*)(sl + 256 + ai * 64), 4, 0, 0); }
    }
    DI void operator()(const Acc& acc, const pg8::Unit& u, int wr, int wc, int fr, int fq) const {
        asm volatile("" : "+v"(fr), "+v"(fq));
        LAS float* sl = slots + (wr * 4 + wc) * 384;
        f32x4 rsa[2];
#pragma unroll
        for (int ai = 0; ai < 2; ++ai) rsa[ai] = *(const LAS f32x4*)(sl + 256 + ai * 64 + 4 * fr);
#pragma unroll
        for (int ai = 0; ai < 2; ++ai) {
            const int tok0 = u.pm * 248 - 1 + (2 * ai + wr) * 62 + 4 * fr;
            float rsv[4], sP[4], sN[4];
#pragma unroll
            for (int m = 0; m < 4; ++m) { rsv[m] = rsqrtf(rsa[ai][m] * (1.0f / DM) + EPS); const int t = (tok0 + m) & 2047; sP[m] = (t == 2047) ? 0.f : rsv[m]; sN[m] = (t == 0) ? 0.f : rsv[m]; }
#pragma unroll
            for (int n = 0; n < 2; ++n) {
                const int f0 = u.pn * 128 + wc * 32 + 8 * fq + 4 * n;
                unsigned pk[2][4];
#pragma unroll
                for (int jp = 0; jp < 2; ++jp) {
                    float r[2][4];
#pragma unroll
                    for (int jj = 0; jj < 2; ++jj) {
                        const int j = 2 * jp + jj;
                        float gc[4];
#pragma unroll
                        for (int half = 0; half < 2; ++half) {
                            const LAS float* pp = sl + (4 * half) * 32 + 8 * fq + 4 * n + j; const float w0 = pp[0], w1 = pp[32], w2 = pp[64], bb = pp[96];
                            float x[4], xp[4], xn[4];
#pragma unroll
                            for (int m = 0; m < 4; ++m) { const float a = acc[ai][half][m][n][j]; x[m] = a * rsv[m]; xp[m] = a * sP[m]; xn[m] = a * sN[m]; }
                            const float pe = __builtin_bit_cast(float, __builtin_amdgcn_update_dpp(0, __builtin_bit_cast(int, xp[3]), 0x111, 0xf, 0xf, true));
                            const float ne = __builtin_bit_cast(float, __builtin_amdgcn_update_dpp(0, __builtin_bit_cast(int, xn[0]), 0x101, 0xf, 0xf, true));
#pragma unroll
                            for (int m = 0; m < 4; ++m) {
                                const float pv = (m == 0) ? pe : xp[m > 0 ? m - 1 : 0], nv = (m == 3) ? ne : xn[m < 3 ? m + 1 : 3];
                                const float cv = w0 * pv + w1 * x[m] + w2 * nv + bb;
                                if (half == 0) gc[m] = cv; else r[jj][m] = gc[m] * __builtin_amdgcn_rcpf(1.0f + __builtin_amdgcn_exp2f(-1.4426950408889634f * gc[m])) * cv; }
                        }
                    }
#pragma unroll
                    for (int m = 0; m < 4; ++m) pk[jp][m] = pkbf(r[0][m], r[1][m]);
                    __builtin_amdgcn_sched_barrier(0);
                }
#pragma unroll
                for (int m = 0; m < 4; ++m) {
                    const int L = 4 * fr + m, tk = tok0 + m;
                    if (L >= 1 && L <= 62 && tk >= 0 && tk < MTOK) { u32x2 w; w.x = pk[0][m]; w.y = pk[1][m]; *(u32x2*)(act + (size_t)tk * DFF + f0) = w; }
                }
            }
        }
    }
};
struct EpiDown {
    static constexpr bool MIDSCALE = false;
    static constexpr bool PREFETCH = false;
    static constexpr bool INIT = true;
    const bf16_t* x1b; bf16_t* x2b; int dry;
    DI void init(Acc& acc, const pg8::Unit& u, int wr, int wc, int fr, int fq) const {
        asm volatile("" : "+v"(fr), "+v"(fq));
#pragma unroll
        for (int ai = 0; ai < 2; ++ai)
#pragma unroll
            for (int m = 0; m < 4; ++m) { const int row = u.pm * 256 + ai * 128 + wr * 64 + m * 16 + fr;
#pragma unroll
                for (int bj = 0; bj < 2; ++bj)
                    { const u32x4 w = *(const u32x4*)(x1b + (size_t)row * DM + u.pn * 256 + bj * 128 + wc * 32 + 8 * fq);
                        acc[ai][bj][m][0] = (f32x4){lo2f(w.x), hi2f(w.x), lo2f(w.y), hi2f(w.y)}; acc[ai][bj][m][1] = (f32x4){lo2f(w.z), hi2f(w.z), lo2f(w.w), hi2f(w.w)}; } }
    }
    DI void operator()(const Acc& acc, const pg8::Unit& u, int wr, int wc, int fr, int fq) const {
        asm volatile("" : "+v"(fr), "+v"(fq));
        if (dry) return;
#pragma unroll
        for (int ai = 0; ai < 2; ++ai)
#pragma unroll
            for (int m = 0; m < 4; ++m) {
                const int row = u.pm * 256 + ai * 128 + wr * 64 + m * 16 + fr;
#pragma unroll
                for (int bj = 0; bj < 2; ++bj)
                    { const int c0 = u.pn * 256 + bj * 128 + wc * 32 + 8 * fq; const size_t o = (size_t)row * DM + c0;
                        const f32x4 v0 = acc[ai][bj][m][0], v1 = acc[ai][bj][m][1];
                        u32x4 w; w.x = pkbf(v0[0], v0[1]); w.y = pkbf(v0[2], v0[3]); w.z = pkbf(v1[0], v1[1]); w.w = pkbf(v1[2], v1[3]); *(u32x4*)(x2b + o) = w; }
            }
    }
};
struct EpiGate {
    static constexpr bool MIDSCALE = false;
    static constexpr bool PREFETCH = false;
    static constexpr bool INIT = false;
    float* out; const bf16_t* x2b; const bf16_t* eraw; const float* ssq_e; const float* gn; int dry;
    DI void operator()(const Acc& acc, const pg8::Unit& u, int wr, int wc, int fr, int fq) const {
        asm volatile("" : "+v"(fr), "+v"(fq));
        float rsv[2][4];
#pragma unroll
        for (int ai = 0; ai < 2; ++ai)
#pragma unroll
            for (int m = 0; m < 4; ++m) rsv[ai][m] = ssq_e[u.pm * 256 + ai * 128 + wr * 64 + m * 16 + fr];
#pragma unroll
        for (int ai = 0; ai < 2; ++ai)
#pragma unroll
            for (int m = 0; m < 4; ++m) {
                const int row = u.pm * 256 + ai * 128 + wr * 64 + m * 16 + fr; const float rs = rsqrtf(rsv[ai][m] * (1.0f / DM) + EPS);
#pragma unroll
                for (int bj = 0; bj < 2; ++bj)
#pragma unroll
                    for (int n = 0; n < 2; ++n) {
                        const int c0 = u.pn * 256 + bj * 128 + wc * 32 + 8 * fq + 4 * n; const size_t o = (size_t)row * DM + c0;
                        const u32x2 ew = *(const u32x2*)(eraw + o); const f32x4 g4 = *(const f32x4*)(gn + c0); const f32x4 a = acc[ai][bj][m][n];
                        f32x4 e; e[0] = lo2f(ew.x); e[1] = hi2f(ew.x); e[2] = lo2f(ew.y); e[3] = hi2f(ew.y);
                        const u32x2 xw = *(const u32x2*)(x2b + o); f32x4 v = (f32x4){lo2f(xw.x), hi2f(xw.x), lo2f(xw.y), hi2f(xw.y)};
#pragma unroll
                        for (int j = 0; j < 4; ++j) v[j] += __builtin_amdgcn_rcpf(1.0f + __builtin_amdgcn_exp2f(-1.4426950408889634f * a[j])) * e[j] * rs * g4[j];
                        if (!dry) *(f32x4*)(out + o) = v; }
                if (m & 1) asm volatile("" ::: "memory");
            }
    }
};

DI float wt_gain(const P& p, int mode, int k) {
    switch (mode) { case 1: return p.norm_mix[k]; case 2: return p.q_norm[k]; case 3: return p.kv_norm[k]; case 4: return k < 512 ? p.on_attn[k] : p.on_hy[k - 512]; case 5: return p.norm_ffn[k]; default: return 1.0f; }
}
DI void wt_tile_wave(const P& p, const float* __restrict__ src, bf16_t* __restrict__ dst, int K, int N, int tk, int tn, int mode, LAS float* lw, int lane) {
    const int k0 = tk * 64, n0 = tn * 64;
#pragma unroll
    for (int i = 0; i < 16; ++i) { const int idx = lane + 64 * i, kk = idx >> 4, c4 = idx & 15, n = n0 + 4 * c4;
        f32x4 v = (f32x4){0.f, 0.f, 0.f, 0.f}; if (n < N) v = *(const f32x4*)(src + (size_t)(k0 + kk) * N + n);
        lw[kk * 65 + 4 * c4] = v[0]; lw[kk * 65 + 4 * c4 + 1] = v[1]; lw[kk * 65 + 4 * c4 + 2] = v[2]; lw[kk * 65 + 4 * c4 + 3] = v[3]; }
#pragma unroll
    for (int i = 0; i < 8; ++i) { const int idx = lane + 64 * i, nn = idx >> 3, k8 = idx & 7, n = n0 + nn, k = k0 + 8 * k8;
        float v[8];
#pragma unroll
        for (int j = 0; j < 8; ++j) v[j] = lw[(8 * k8 + j) * 65 + nn] * wt_gain(p, mode, k + j);
        if (n < N) { int dr = n; if (mode == 5) { dr = (n < DFF) ? ((n >> 7) * 256 + (n & 127)) : (((n - DFF) >> 7) * 256 + 128 + ((n - DFF) & 127)); }
            if (mode == 3) { dr = ((n & 127) < 64) ? ((n >> 7) * 64 + (n & 63)) : (512 + (n >> 7) * 64 + (n & 63)); }
            u32x4 w; w.x = pkbf(v[0], v[1]); w.y = pkbf(v[2], v[3]); w.z = pkbf(v[4], v[5]); w.w = pkbf(v[6], v[7]);
            *(u32x4*)(dst + (size_t)dr * K + k) = w; } }
}
DI void phase_prep(const P& p, LAS unsigned char* lds) {
    const int bid = o_bid(), nb = o_nb(), tid = o_tid(), lane = tid & 63, wid = tid >> 6;
    unsigned char* ws = p.ws;
    { LAS float* lw = (LAS float*)(lds + wid * (64 * 65 * 4));
      const int gw = bid * 8 + wid, nw = nb * 8;
      int base = 0;
#define WT_JOB(SRC, DST, KK, NN, MODE) do { const int tK = (KK) / 64, tN = ((NN) + 63) / 64, nt = tK * tN; \
          for (int t = ((gw - base) % nw + nw) % nw; t < nt; t += nw) wt_tile_wave(p, (SRC), (bf16_t*)(ws + (DST)), (KK), (NN), t % tK, t / tK, (MODE), lw, lane); \
          base += nt; } while (0)
      WT_JOB(p.w_up, WS_WUP, DM, 2 * DFF, 5);
      WT_JOB(p.w_down, WS_WDOWN, DFF, DM, 0);
      WT_JOB(p.w_in, WS_WIN, DM, INW, 1);
      WT_JOB(p.w_out, WS_WOUT, DM, DM, 4);
      WT_JOB(p.w_gate, WS_WGATE, DM, DM, 0);
      WT_JOB(p.w_uq, WS_WUQ, QL, QL, 2);
      WT_JOB(p.w_ukv, WS_WUKV, KVL, 1024, 3);
      WT_JOB(p.w_ple, WS_WPLE, PLE, DM, 0);
#undef WT_JOB
    }
    { u32x4* z = (u32x4*)(ws + WS_WIN + (size_t)INW * DM * 2); const int n16 = (INWP - INW) * DM * 2 / 16;
      for (int i = bid * NTHREADS + tid; i < n16; i += nb * NTHREADS) z[i] = (u32x4){0u, 0u, 0u, 0u}; }
    { float* st = (float*)(ws + WS_STATS) + MTOK; for (int i = bid * NTHREADS + tid; i < 5 * MTOK; i += nb * NTHREADS) st[i] = 0.f; }
    { bf16_t* xb = (bf16_t*)(ws + WS_X); float* rs1 = (float*)(ws + WS_STATS);
      for (int row0 = (bid * 8 + wid) * 4; row0 < MTOK; row0 += nb * 32) {
          f32x4 v[4][4];
#pragma unroll
          for (int r = 0; r < 4; ++r)
#pragma unroll
              for (int i = 0; i < 4; ++i) v[r][i] = ((const f32x4*)(p.x + (size_t)(row0 + r) * DM))[lane + 64 * i];
#pragma unroll
          for (int r = 0; r < 4; ++r) { float ss = 0.f;
#pragma unroll
              for (int i = 0; i < 4; ++i) { const f32x4 t = v[r][i]; ss += t[0] * t[0] + t[1] * t[1] + t[2] * t[2] + t[3] * t[3];
                  u32x2 w; w.x = pkbf(t[0], t[1]); w.y = pkbf(t[2], t[3]); ((u32x2*)(xb + (size_t)(row0 + r) * DM))[lane + 64 * i] = w; }
#pragma unroll
              for (int o = 32; o >= 1; o >>= 1) ss += __shfl_xor(ss, o);
              if (lane == 0) rs1[row0 + r] = rsqrtf(ss * (1.0f / DM) + EPS); }
      } }
    { const f32x4* ps = (const f32x4*)p.p; u32x2* pd = (u32x2*)(ws + WS_PB);
      for (int i0 = bid * NTHREADS + tid; i0 < MTOK * PLE / 4; i0 += 8 * nb * NTHREADS) {
          f32x4 v[8];
#pragma unroll
          for (int k = 0; k < 8; ++k) { const int i = i0 + k * nb * NTHREADS; v[k] = (i < MTOK * PLE / 4) ? ps[i] : (f32x4){0.f, 0.f, 0.f, 0.f}; }
#pragma unroll
          for (int k = 0; k < 8; ++k) { const int i = i0 + k * nb * NTHREADS; if (i < MTOK * PLE / 4) { u32x2 w; w.x = pkbf(v[k][0], v[k][1]); w.y = pkbf(v[k][2], v[k][3]); pd[i] = w; } } } }
    { bf16_t* kfil = (bf16_t*)(ws + WS_KFIL);
      LAS float* h3s = (LAS float*)(lds + 8 * 64 * 65 * 4);
      for (int lg = bid; lg < SEQ / 8; lg += nb) {
          const int l = lg * 8 + wid;
          const float t = (float)l / (float)(SEQ - 1);
          const float w = 6.283185307179586f * (float)l / (float)SEQ;
          float z = 0.f;
          if (lane == 0) z = t;
          else if (lane <= 16) { const float fb = 1e-4f + (float)(lane - 1) * ((15.0f - 1e-4f) / 15.0f); z = cosf(w * fb); }
          else if (lane <= 32) { const float fb = 1e-4f + (float)(lane - 17) * ((15.0f - 1e-4f) / 15.0f); z = -sinf(w * fb); }
          const float fr = p.f_freq[lane];
          float a = p.f_b1[lane];
          for (int i = 0; i < 33; ++i) a += __shfl(z, i) * p.f_w1[i * 64 + lane];
          float h = sinf(fr * a);
          a = p.f_b2[lane];
          for (int i = 0; i < 64; ++i) a += __shfl(h, i) * p.f_w2[i * 64 + lane];
          h = sinf(fr * a);
          a = p.f_b3[lane];
          for (int i = 0; i < 64; ++i) a += __shfl(h, i) * p.f_w3[i * 64 + lane];
          h = sinf(fr * a);
          __syncthreads();
          h3s[wid * 64 + lane] = h;
          __syncthreads();
          float o[8][2];
#pragma unroll
          for (int q = 0; q < 8; ++q) { o[q][0] = 0.f; o[q][1] = 0.f; }
#pragma unroll 1
          for (int jb = 0; jb < 64; jb += 16) {
              float w0[16], w1[16];
              const float* wp = p.f_wout + (size_t)jb * 1024 + tid;
#pragma unroll
              for (int j = 0; j < 16; ++j) { w0[j] = wp[j * 1024]; w1[j] = wp[j * 1024 + 512]; }
#pragma unroll
              for (int j4 = 0; j4 < 4; ++j4) {
#pragma unroll
                  for (int q = 0; q < 8; ++q) { const f32x4 hv = *(const LAS f32x4*)(h3s + q * 64 + jb + 4 * j4);
#pragma unroll
                      for (int k = 0; k < 4; ++k) { o[q][0] += hv[k] * w0[4 * j4 + k]; o[q][1] += hv[k] * w1[4 * j4 + k]; } }
                  __builtin_amdgcn_sched_barrier(0); } }
          const float mind = logf(1e-2f) / 0.3f, maxd = logf(1e-2f) / 1.5f;
          const int c = tid; const float delta = fabsf(mind + (float)c * ((maxd - mind) / 511.0f));
          float ff[8], fb[8];
#pragma unroll
          for (int q = 0; q < 8; ++q) { const int lq = lg * 8 + q; const float tq = (float)lq / (float)(SEQ - 1); const float dec = expf(-tq * delta); ff[q] = o[q][0] * dec; fb[q] = o[q][1] * dec; }
          { bf16_t* row = kfil + (size_t)c * 4096;
            u32x4 w; w.x = pkbf(lg == 0 ? ff[0] : fb[0], fb[1]); w.y = pkbf(fb[2], fb[3]); w.z = pkbf(fb[4], fb[5]); w.w = pkbf(fb[6], fb[7]);
            *(u32x4*)(row + 2048 + 8 * lg) = w;
            bf16_t* f0 = row + 2041 - 8 * lg;
            f0[0] = f2bf(ff[7]); *(unsigned*)(f0 + 1) = pkbf(ff[6], ff[5]); *(unsigned*)(f0 + 3) = pkbf(ff[4], ff[3]); *(unsigned*)(f0 + 5) = pkbf(ff[2], ff[1]);
            if (lg != 0) f0[7] = f2bf(ff[0]); }
          if (lg == 0) kfil[(size_t)c * 4096] = 0;
      } }
}

DI void phase_qkprep(const P& p) {
    const int bid = o_bid(), nb = o_nb(), lane = o_tid() & 63, wid = o_tid() >> 6;
    unsigned char* ws = p.ws;
    const bf16_t* qraw = (const bf16_t*)((const unsigned char*)p.out + 32 * MiB); const bf16_t* kraw = (const bf16_t*)(ws + WS_KRAW2); const bf16_t* projm = (const bf16_t*)(ws + WS_Y);
    bf16_t* Qh = (bf16_t*)(ws + WS_Q); bf16_t* Kh = (bf16_t*)(ws + WS_K);
    const int h = lane >> 3, sub = lane & 7;
    const float qscale = 0.10206207261596575f * 1.4426950408889634f;
    float gq[12], gk[12];
#pragma unroll
    for (int i = 0; i < 8; ++i) { gq[i] = p.qk_nq[8 * sub + i]; gk[i] = p.qk_nk[8 * sub + i]; }
#pragma unroll
    for (int e = 0; e < 2; ++e) { gq[8 + e] = p.qk_nq[64 + 2 * sub + e]; gq[10 + e] = p.qk_nq[80 + 2 * sub + e]; gk[8 + e] = p.qk_nk[64 + 2 * sub + e]; gk[10 + e] = p.qk_nk[80 + 2 * sub + e]; }
    float invf[2];
#pragma unroll
    for (int e = 0; e < 2; ++e) invf[e] = powf(10000.0f, -(float)(2 * sub + e) / 16.0f);
    for (int row0 = (bid * 8 + wid) * 2; row0 < MTOK; row0 += nb * 16) {
        u32x4 la[2][2]; unsigned l1[2][2], l2[2][2];
#pragma unroll
        for (int tt = 0; tt < 2; ++tt) {
            const int row = row0 + tt;
            const bf16_t* q = qraw + (size_t)row * QL + h * QKD; const bf16_t* k = kraw + (size_t)row * 512 + h * 64; const bf16_t* pe = projm + (size_t)row * MLAW + 1024;
            la[tt][0] = *(const u32x4*)(q + 8 * sub); l1[tt][0] = *(const unsigned*)(q + 64 + 2 * sub); l2[tt][0] = *(const unsigned*)(q + 80 + 2 * sub);
            la[tt][1] = *(const u32x4*)(k + 8 * sub); l1[tt][1] = *(const unsigned*)(pe + 2 * sub); l2[tt][1] = *(const unsigned*)(pe + 16 + 2 * sub);
        }
#pragma unroll
        for (int tt = 0; tt < 2; ++tt) {
        const int row = row0 + tt;
        const int b = row >> 11, s = row & 2047;
        float cs[2], sn[2];
#pragma unroll
        for (int e = 0; e < 2; ++e) { const float ang = (float)s * invf[e]; sn[e] = sinf(ang); cs[e] = cosf(ang); }
#pragma unroll
        for (int which = 0; which < 2; ++which) {
            float v[12];
            { const u32x4 a = la[tt][which]; const unsigned r1 = l1[tt][which], r2 = l2[tt][which];
              v[0] = lo2f(a.x); v[1] = hi2f(a.x); v[2] = lo2f(a.y); v[3] = hi2f(a.y); v[4] = lo2f(a.z); v[5] = hi2f(a.z); v[6] = lo2f(a.w); v[7] = hi2f(a.w);
              v[8] = lo2f(r1); v[9] = hi2f(r1); v[10] = lo2f(r2); v[11] = hi2f(r2); }
            float ss = 0.f;
#pragma unroll
            for (int i = 0; i < 12; ++i) ss += v[i] * v[i];
            ss += __shfl_xor(ss, 1); ss += __shfl_xor(ss, 2); ss += __shfl_xor(ss, 4);
            const float rs = rsqrtf(ss * (1.0f / QKD) + EPS) * (which == 0 ? qscale : 1.0f);
#pragma unroll
            for (int i = 0; i < 12; ++i) v[i] *= rs * (which == 0 ? gq[i] : gk[i]);
            float r[4];
#pragma unroll
            for (int e = 0; e < 2; ++e) { r[e] = v[8 + e] * cs[e] - v[10 + e] * sn[e]; r[2 + e] = v[10 + e] * cs[e] + v[8 + e] * sn[e]; }
            bf16_t* dst = (which == 0 ? Qh : Kh) + ((size_t)(b * NH + h) * SEQ + s) * QKD;
            u32x4 w; w.x = pkbf(v[0], v[1]); w.y = pkbf(v[2], v[3]); w.z = pkbf(v[4], v[5]); w.w = pkbf(v[6], v[7]);
            *(u32x4*)(dst + 8 * sub) = w; *(unsigned*)(dst + 64 + 2 * sub) = pkbf(r[0], r[1]); *(unsigned*)(dst + 80 + 2 * sub) = pkbf(r[2], r[3]);
        }
        }
    }
}

DI void phase_mixprep(const P& p, unsigned char* shm) {
    const int bid = o_bid(), nb = o_nb(), tid = o_tid(), lane = tid & 63, wid = tid >> 6;
    unsigned char* ws = p.ws;
    const bf16_t* yhT = (const bf16_t*)(ws + WS_YHT); bf16_t* ymix = (bf16_t*)p.out;
    bf16_t* tile = (bf16_t*)shm;
    float* part = (float*)(shm + 512 * 66 * 2);
    for (int t0 = bid; t0 < MTOK / 64; t0 += nb) {
        const int m0 = t0 * 64;
        u32x4 hr[8];
#pragma unroll
        for (int i = 0; i < 8; ++i) { const int idx = tid + NTHREADS * i, c = idx >> 3, q = idx & 7; hr[i] = *(const u32x4*)(yhT + (size_t)c * MTOK + m0 + q * 8); }
#pragma unroll
        for (int i = 0; i < 8; ++i) { const int idx = tid + NTHREADS * i, c = idx >> 3, q = idx & 7; const u32x4 a = hr[i];
            unsigned* d = (unsigned*)(tile + c * 66 + q * 8); d[0] = a.x; d[1] = a.y; d[2] = a.z; d[3] = a.w; }
        __syncthreads();
        { const int tok = lane, part_i = wid; float ss = 0.f;
          for (int c = part_i * 64; c < part_i * 64 + 64; ++c) { const float v = bf2f(tile[c * 66 + tok]); ss += v * v; }
          part[part_i * 64 + tok] = ss; }
        __syncthreads();
        { const int tok = lane, part_i = wid; float ss = 0.f;
#pragma unroll
          for (int i = 0; i < 8; ++i) ss += part[i * 64 + tok];
          const float rs = rsqrtf(ss * (1.0f / 512) + EPS);
          bf16_t* dst = ymix + (size_t)(m0 + tok) * DM + 512 + part_i * 64;
#pragma unroll
          for (int g = 0; g < 8; ++g) { float v[8];
#pragma unroll
              for (int i = 0; i < 8; ++i) v[i] = bf2f(tile[(part_i * 64 + g * 8 + i) * 66 + tok]) * rs;
              u32x4 w; w.x = pkbf(v[0], v[1]); w.y = pkbf(v[2], v[3]); w.z = pkbf(v[4], v[5]); w.w = pkbf(v[6], v[7]); *(u32x4*)(dst + g * 8) = w; } }
        __syncthreads();
    }
}

DI void phase_g1(const P& p, LAS unsigned char* shm, int dry) {
    unsigned char* ws = p.ws; float* st = (float*)(ws + WS_STATS);
    { pg8::Gemm g{(const bf16_t*)(ws + WS_X), (const bf16_t*)(ws + WS_WIN), DM, DM, 64, 5, 256, 64};
      pg8::StaticOrder S; S.init(g.nM, g.nN, o_nb(), o_bid());
      EpiProj E{(bf16_t*)(ws + WS_Y), st, st + MTOK, st + 2 * MTOK, dry};
      pg8::gemm_phase(shm, g, S, E); }
    { pg8::Gemm g{(const bf16_t*)(ws + WS_WIN) + (size_t)MLAW * DM, (const bf16_t*)(ws + WS_X), DM, DM, 6, 64, 256, 64};
      pg8::StaticOrder S; S.init(g.nM, g.nN, o_nb(), (o_bid() + 192) % o_nb());
      EpiHyT E{(bf16_t*)(ws + WS_Z), st};
      pg8::gemm_phase(shm, g, S, E); }
}
DI void phase_g23(const P& p, LAS unsigned char* shm) {
    unsigned char* ws = p.ws; float* st = (float*)(ws + WS_STATS);
    { pg8::Gemm g{(const bf16_t*)(ws + WS_Y), (const bf16_t*)(ws + WS_WUQ), QL, MLAW, 64, 3, 256, 64};
      pg8::StaticOrder S; S.init(g.nM, g.nN, o_nb(), o_bid());
      EpiQ E{(bf16_t*)((unsigned char*)p.out + 32 * MiB), st + MTOK};
      pg8::gemm_phase(shm, g, S, E); }
    { pg8::Gemm g{(const bf16_t*)(ws + WS_Y) + QL, (const bf16_t*)(ws + WS_WUKV), KVL, MLAW, 64, 2, 256, 64};
      pg8::StaticOrder S; S.init(g.nM, g.nN, o_nb(), (o_bid() + 64) % o_nb());
      EpiK E{(bf16_t*)(ws + WS_KRAW2), st + 2 * MTOK};
      pg8::gemm_phase(shm, g, S, E); }
    { pg8::Gemm g{(const bf16_t*)(ws + WS_WUKV) + (size_t)512 * KVL, (const bf16_t*)(ws + WS_Y) + QL, KVL, KVL, 2, 64, 256, 64, MLAW};
      pg8::StaticOrder S; S.init(g.nM, g.nN, o_nb(), (o_bid() + 192) % o_nb());
      EpiVT E{(bf16_t*)(ws + WS_V), st + 2 * MTOK};
      pg8::gemm_phase(shm, g, S, E); }
}
DI void phase_g4(const P& p, LAS unsigned char* shm, int dry) {
    unsigned char* ws = p.ws; float* st = (float*)(ws + WS_STATS);
    { pg8::Gemm g{(const bf16_t*)p.out, (const bf16_t*)(ws + WS_WOUT), DM, DM, 64, 4, 256, 64};
      pg8::StaticOrder S; S.init(g.nM, g.nN, o_nb(), o_bid());
      EpiOut E{(const bf16_t*)(ws + WS_X), (bf16_t*)(ws + WS_Y + 4096), st + 3 * MTOK, (const float*)(ws + WS_SSQAH), dry};
      pg8::gemm_phase(shm, g, S, E); }
    { pg8::Gemm g{(const bf16_t*)(ws + WS_PB), (const bf16_t*)(ws + WS_WPLE), PLE, PLE, 64, 4, 256, 64};
      pg8::StaticOrder S; S.init(g.nM, g.nN, o_nb(), o_bid());
      EpiPle E{(bf16_t*)(ws + WS_Z), st + 4 * MTOK, dry};
      pg8::gemm_phase(shm, g, S, E); }
}
DI void phase_g5(const P& p, LAS unsigned char* shm) {
    unsigned char* ws = p.ws; float* st = (float*)(ws + WS_STATS);
    pg8::Gemm g{(const bf16_t*)(ws + WS_Y + 4096) - DM, (const bf16_t*)(ws + WS_WUP), DM, DM, 67, 22, 248, 62, 0, 1};
    pg8::StaticOrder S; S.init(g.nM, g.nN, o_nb(), o_bid());
    EpiFfn E{(bf16_t*)(ws + WS_ACT), st + 3 * MTOK, p.fc_w, p.fc_b, (LAS float*)(shm + pg8::STAGE_BYTES)};
    pg8::gemm_phase(shm, g, S, E);
}
DI void phase_g6(const P& p, LAS unsigned char* shm, int dry) {
    unsigned char* ws = p.ws;
    pg8::Gemm g{(const bf16_t*)(ws + WS_ACT), (const bf16_t*)(ws + WS_WDOWN), DFF, DFF, 64, 4, 256, 64};
    pg8::StaticOrder S; S.init(g.nM, g.nN, o_nb(), o_bid());
    EpiDown E{(const bf16_t*)(ws + WS_Y + 4096), (bf16_t*)(ws + WS_X), dry};
    pg8::gemm_phase(shm, g, S, E);
}
DI void phase_g7(const P& p, LAS unsigned char* shm, int dry) {
    unsigned char* ws = p.ws; float* st = (float*)(ws + WS_STATS);
    pg8::Gemm g{(const bf16_t*)(ws + WS_X), (const bf16_t*)(ws + WS_WGATE), DM, DM, 64, 4, 256, 64};
    pg8::StaticOrder S; S.init(g.nM, g.nN, o_nb(), o_bid());
    EpiGate E{p.out, (const bf16_t*)(ws + WS_X), (const bf16_t*)(ws + WS_Z), st + 4 * MTOK, p.ple_norm, dry};
    pg8::gemm_phase(shm, g, S, E);
}

#define MFMA32(a, b, c) __builtin_amdgcn_mfma_f32_32x32x16_bf16((a), (b), (c), 0, 0, 0)
constexpr int AT_KRS = 208, AT_VRS = 136, AT_KBYTES = 64 * AT_KRS, AT_VBYTES = 64 * AT_VRS, AT_BUF = AT_KBYTES + AT_VBYTES;
DI void phase_attn(const P& p, LAS unsigned char* lds) {
    const int tid = o_tid(), lane = tid & 63, wid = tid >> 6, l31 = lane & 31, hl = lane >> 5;
    const int bid = o_bid(), nb = o_nb();
    const bf16_t* Qg = (const bf16_t*)(p.ws + WS_Q); const bf16_t* Kg = (const bf16_t*)(p.ws + WS_K); const bf16_t* Vg = (const bf16_t*)(p.ws + WS_V);
    bf16_t* Y = (bf16_t*)p.out;
    float* ssq_ah = (float*)(p.ws + WS_SSQAH);
    const int kl0 = (tid / 12) * AT_KRS + (tid % 12) * 16, kl1 = ((512 + tid) / 12) * AT_KRS + ((512 + tid) % 12) * 16;
    const int vdv = tid >> 3, vpart = tid & 7, vl = vdv * AT_VRS + vpart * 16;
    for (int it0 = bid; it0 < 256; it0 += nb) {
        const int item = ((it0 & 7) * 8 + ((it0 >> 3) >> 2)) * 4 + ((it0 >> 3) & 3);
        const int bh = item >> 2, q0 = (item & 3) * 512;
        bf16x8 Qf[2][6];
#pragma unroll
        for (int qb = 0; qb < 2; ++qb)
#pragma unroll
            for (int kk = 0; kk < 6; ++kk) Qf[qb][kk] = *(const bf16x8*)(Qg + ((size_t)bh * SEQ + q0 + 64 * wid + 32 * qb + l31) * QKD + 16 * kk + 8 * hl);
        f32x16 O[2][2];
#pragma unroll
        for (int a = 0; a < 2; ++a)
#pragma unroll
            for (int b = 0; b < 2; ++b)
#pragma unroll
                for (int i = 0; i < 16; ++i) O[a][b][i] = 0.f;
        float mrow[2] = {0.f, 0.f}, lsum[2] = {0.f, 0.f}; bool refs = false;
        const unsigned char* Kt = (const unsigned char*)(Kg + (size_t)bh * SEQ * QKD);
        const unsigned char* Vt = (const unsigned char*)(Vg + (size_t)bh * VD * SEQ) + (size_t)vdv * SEQ * 2 + vpart * 16;
        u32x4 kr0 = *(const u32x4*)(Kt + tid * 16), kr1 = (u32x4){0u, 0u, 0u, 0u}, vr = *(const u32x4*)(Vt);
        if (tid < 256) kr1 = *(const u32x4*)(Kt + (512 + tid) * 16);
        __syncthreads();
        *(LAS u32x4*)(lds + kl0) = kr0; if (tid < 256) *(LAS u32x4*)(lds + kl1) = kr1;
        *(LAS u32x2*)(lds + AT_KBYTES + vl) = (u32x2){vr.x, vr.y}; *(LAS u32x2*)(lds + AT_KBYTES + vl + 8) = (u32x2){vr.z, vr.w};
        __syncthreads();
#pragma unroll 1
        for (int it = 0; it < 32; ++it) {
            LAS unsigned char* kb_ = lds + (it & 1) * AT_BUF; LAS unsigned char* vb_ = kb_ + AT_KBYTES;
            if (it + 1 < 32) {
                kr0 = *(const u32x4*)(Kt + (size_t)(it + 1) * 12288 + tid * 16); if (tid < 256) kr1 = *(const u32x4*)(Kt + (size_t)(it + 1) * 12288 + (512 + tid) * 16);
                vr = *(const u32x4*)(Vt + (size_t)(it + 1) * 128); }
            f32x16 S[2][2];
#pragma unroll
            for (int a = 0; a < 2; ++a)
#pragma unroll
                for (int b = 0; b < 2; ++b)
#pragma unroll
                    for (int i = 0; i < 16; ++i) S[a][b][i] = 0.f;
#pragma unroll
            for (int kb = 0; kb < 2; ++kb)
#pragma unroll
                for (int kk = 0; kk < 6; ++kk) {
                    const bf16x8 a = *(const LAS bf16x8*)(kb_ + (32 * kb + l31) * AT_KRS + 32 * kk + 16 * hl);
                    S[kb][0] = MFMA32(a, Qf[0][kk], S[kb][0]); S[kb][1] = MFMA32(a, Qf[1][kk], S[kb][1]); }
#pragma unroll
            for (int qb = 0; qb < 2; ++qb) {
                float mx = S[0][qb][0];
#pragma unroll
                for (int i = 1; i < 16; ++i) mx = fmaxf(mx, S[0][qb][i]);
#pragma unroll
                for (int i = 0; i < 16; ++i) mx = fmaxf(mx, S[1][qb][i]);
                { float mx2 = mx; asm volatile("" : "+v"(mx2));
                  const auto r = __builtin_amdgcn_permlane32_swap(__builtin_bit_cast(unsigned, mx), __builtin_bit_cast(unsigned, mx2), false, false);
                  mx = fmaxf(__builtin_bit_cast(float, r[0]), __builtin_bit_cast(float, r[1])); }
                { const float rel = mx - mrow[qb]; const bool need = (it == 0) ? (fabsf(rel) > 8.0f) : (rel > 8.0f);
                  if (__builtin_amdgcn_ballot_w64(need) != 0ull) {
                      const float d = need ? rel : 0.f, alpha = (it == 0) ? 1.0f : __builtin_amdgcn_exp2f(-d);
                      mrow[qb] += d; lsum[qb] *= alpha; refs = true;
#pragma unroll
                      for (int dvb = 0; dvb < 2; ++dvb)
#pragma unroll
                          for (int i = 0; i < 16; ++i) O[dvb][qb][i] *= alpha;
                  } }
                if (refs) {
                    const float mm = mrow[qb];
#pragma unroll
                    for (int kb = 0; kb < 2; ++kb)
#pragma unroll
                        for (int i = 0; i < 16; ++i) S[kb][qb][i] -= mm;
                }
                float ps = 0.f;
#pragma unroll
                for (int kb = 0; kb < 2; ++kb)
#pragma unroll
                    for (int i = 0; i < 16; ++i) { const float e = __builtin_amdgcn_exp2f(S[kb][qb][i]); S[kb][qb][i] = e; ps += e; }
                lsum[qb] += ps;
            }
#pragma unroll
            for (int c = 0; c < 4; ++c) {
                const int kb = c >> 1, s8 = (c & 1) * 8;
                bf16x8 pf[2];
#pragma unroll
                for (int qb = 0; qb < 2; ++qb) { u32x4 w; w.x = pkbf(S[kb][qb][s8 + 0], S[kb][qb][s8 + 1]); w.y = pkbf(S[kb][qb][s8 + 2], S[kb][qb][s8 + 3]);
                    w.z = pkbf(S[kb][qb][s8 + 4], S[kb][qb][s8 + 5]); w.w = pkbf(S[kb][qb][s8 + 6], S[kb][qb][s8 + 7]); pf[qb] = __builtin_bit_cast(bf16x8, w); }
#pragma unroll
                for (int dvb = 0; dvb < 2; ++dvb) {
                    const LAS unsigned char* va = vb_ + (32 * dvb + l31) * AT_VRS + (16 * c + 4 * hl) * 2;
                    const u32x2 lo = *(const LAS u32x2*)va, hi = *(const LAS u32x2*)(va + 16);
                    const bf16x8 a = __builtin_bit_cast(bf16x8, (u32x4){lo.x, lo.y, hi.x, hi.y});
                    O[dvb][0] = MFMA32(a, pf[0], O[dvb][0]); O[dvb][1] = MFMA32(a, pf[1], O[dvb][1]); }
            }
            if (it + 1 < 32) {
                LAS unsigned char* kn = lds + ((it + 1) & 1) * AT_BUF;
                *(LAS u32x4*)(kn + kl0) = kr0; if (tid < 256) *(LAS u32x4*)(kn + kl1) = kr1;
                *(LAS u32x2*)(kn + AT_KBYTES + vl) = (u32x2){vr.x, vr.y}; *(LAS u32x2*)(kn + AT_KBYTES + vl + 8) = (u32x2){vr.z, vr.w}; }
            __syncthreads();
        }
        const int b = bh >> 3, h = bh & 7;
#pragma unroll
        for (int qb = 0; qb < 2; ++qb) {
            const float lt = lsum[qb] + __shfl_xor(lsum[qb], 32), inv = 1.0f / lt;
            const int orow = b * SEQ + q0 + 64 * wid + 32 * qb + l31;
            bf16_t* dst = Y + (size_t)orow * DM + h * VD;
            { float ss = 0.f;
#pragma unroll
              for (int dvb = 0; dvb < 2; ++dvb)
#pragma unroll
                  for (int i = 0; i < 16; ++i) { const float v = O[dvb][qb][i] * inv; ss += v * v; }
              ss += __shfl_xor(ss, 32);
              if (hl == 0) ssq_ah[(size_t)orow * NH + h] = ss; }
#pragma unroll
            for (int dvb = 0; dvb < 2; ++dvb)
#pragma unroll
                for (int g = 0; g < 4; g += 2) {
                    const unsigned a0 = pkbf(O[dvb][qb][4 * g] * inv, O[dvb][qb][4 * g + 1] * inv), a1 = pkbf(O[dvb][qb][4 * g + 2] * inv, O[dvb][qb][4 * g + 3] * inv);
                    const unsigned b0 = pkbf(O[dvb][qb][4 * g + 4] * inv, O[dvb][qb][4 * g + 5] * inv), b1 = pkbf(O[dvb][qb][4 * g + 6] * inv, O[dvb][qb][4 * g + 7] * inv);
                    const auto s0 = __builtin_amdgcn_permlane32_swap(a0, b0, false, false), s1 = __builtin_amdgcn_permlane32_swap(a1, b1, false, false);
                    u32x4 w; w.x = s0[0]; w.y = s1[0]; w.z = s0[1]; w.w = s1[1];
                    *(u32x4*)(dst + 32 * dvb + 8 * (g + hl)) = w; }
        }
    }
}

constexpr int HY_CS = 8224, HY_URS = 4880, HY_UP = 8 * HY_CS, HY_X0 = HY_UP + 8 * HY_URS, HY_END = HY_X0 + 8 * 2048 * 2;
static_assert(HY_END <= LDS_BYTES, "hyena LDS");
DI void phase_hyena(const P& p, LAS unsigned char* lds) {
    const int tid = o_tid(), lane = tid & 63, wid = tid >> 6, l31 = lane & 31, hl = lane >> 5;
    const int bid = o_bid(), nb = o_nb();
    const bf16_t* uhT = (const bf16_t*)(p.ws + WS_Z); const bf16_t* kfil = (const bf16_t*)(p.ws + WS_KFIL); bf16_t* yhT = (bf16_t*)(p.ws + WS_YHT);
    for (int c = bid; c < HYW; c += nb) {
        __syncthreads();
        { const bf16_t* kr = kfil + (size_t)c * 4096; const int q = tid;
          const u32x4 A = *(const u32x4*)(kr + 8 * q); const u32x4 B = (q < 511) ? *(const u32x4*)(kr + 8 * q + 8) : (u32x4){0u, 0u, 0u, 0u};
          const unsigned d[8] = {A.x, A.y, A.z, A.w, B.x, B.y, B.z, B.w};
#pragma unroll
          for (int r = 0; r < 8; ++r) { const int e = r >> 1; u32x4 o;
              if ((r & 1) == 0) { o.x = d[e]; o.y = d[e + 1]; o.z = d[e + 2]; o.w = d[e + 3]; }
              else { o.x = __builtin_amdgcn_alignbit(d[e + 1], d[e], 16); o.y = __builtin_amdgcn_alignbit(d[e + 2], d[e + 1], 16); o.z = __builtin_amdgcn_alignbit(d[e + 3], d[e + 2], 16); o.w = __builtin_amdgcn_alignbit(d[e + 4], d[e + 3], 16); }
              *(LAS u32x4*)(lds + r * HY_CS + 16 * q) = o; } }
        if (tid < 384) { const int b = tid / 48, k = tid % 48; LAS unsigned char* row = lds + HY_UP + b * HY_URS; const int off = (k < 24) ? k * 16 : (2240 * 2 + (k - 24) * 16); *(LAS u32x4*)(row + off) = (u32x4){0u, 0u, 0u, 0u}; }
        { float w0[3], w1[3], w2[3], bb[3];
#pragma unroll
          for (int a = 0; a < 3; ++a) { const int ch = a * HYW + c; w0[a] = p.sc_w[ch]; w1[a] = p.sc_w[1536 + ch]; w2[a] = p.sc_w[3072 + ch]; bb[a] = p.sc_b[ch]; }
#pragma unroll 2
          for (int i = 0; i < 4; ++i) {
              const int ch = tid + 512 * i, b = ch >> 8, t0 = (ch & 255) * 8, m0 = b * SEQ + t0;
              float r[3][8];
#pragma unroll
              for (int a = 0; a < 3; ++a) {
                  const bf16_t* row = uhT + (size_t)(a * HYW + c) * MTOK + m0;
                  const u32x4 v = *(const u32x4*)row; const float pv = t0 > 0 ? bf2f(row[-1]) : 0.f, nv = t0 < SEQ - 8 ? bf2f(row[8]) : 0.f;
                  const float x[10] = {pv, lo2f(v.x), hi2f(v.x), lo2f(v.y), hi2f(v.y), lo2f(v.z), hi2f(v.z), lo2f(v.w), hi2f(v.w), nv};
#pragma unroll
                  for (int k = 0; k < 8; ++k) r[a][k] = w0[a] * x[k] + w1[a] * x[k + 1] + w2[a] * x[k + 2] + bb[a];
              }
              u32x4 uo, xo;
              uo.x = pkbf(r[1][0] * r[2][0], r[1][1] * r[2][1]); uo.y = pkbf(r[1][2] * r[2][2], r[1][3] * r[2][3]); uo.z = pkbf(r[1][4] * r[2][4], r[1][5] * r[2][5]); uo.w = pkbf(r[1][6] * r[2][6], r[1][7] * r[2][7]);
              xo.x = pkbf(r[0][0], r[0][1]); xo.y = pkbf(r[0][2], r[0][3]); xo.z = pkbf(r[0][4], r[0][5]); xo.w = pkbf(r[0][6], r[0][7]);
              *(LAS u32x4*)(lds + HY_UP + b * HY_URS + (192 + t0) * 2) = uo; *(LAS u32x4*)(lds + HY_X0 + (b * SEQ + t0) * 2) = xo;
          } }
        __syncthreads();
        const int T0 = 256 * wid, rho = (-l31) & 7, bcol = l31 & 7, mcol = l31 >> 3;
        const LAS unsigned char* ap = lds + rho * HY_CS + 2 * (1856 - T0 + 8 * hl - l31 - rho);
        const LAS unsigned char* bp = lds + HY_UP + bcol * HY_URS + (64 * mcol + 8 * hl) * 2;
        f32x16 C0, C1;
#pragma unroll
        for (int i = 0; i < 16; ++i) { C0[i] = 0.f; C1[i] = 0.f; }
        bf16x8 am2 = *(const LAS bf16x8*)(ap - 64), am1 = *(const LAS bf16x8*)(ap - 32);
#pragma unroll 4
        for (int e = 0; e < 140; ++e) {
            const bf16x8 ac = *(const LAS bf16x8*)(ap + 32 * e); const bf16x8 bf = *(const LAS bf16x8*)(bp + 32 * e);
            C0 = MFMA32(ac, bf, C0); C1 = MFMA32(am2, bf, C1);
            am2 = am1; am1 = ac;
        }
        { const float bias = p.hy_bias[c];
#pragma unroll
          for (int rb = 0; rb < 2; ++rb)
#pragma unroll
              for (int g = 0; g < 4; g += 2) {
                  unsigned pw[2][2];
#pragma unroll
                  for (int gg = 0; gg < 2; ++gg) {
                      const int t0 = T0 + 64 * mcol + 32 * rb + 8 * (g + gg) + 4 * hl;
                      const u32x2 uw = *(const LAS u32x2*)(lds + HY_UP + bcol * HY_URS + (192 + t0) * 2), xw = *(const LAS u32x2*)(lds + HY_X0 + (bcol * SEQ + t0) * 2);
                      const float uu[4] = {lo2f(uw.x), hi2f(uw.x), lo2f(uw.y), hi2f(uw.y)}, xx[4] = {lo2f(xw.x), hi2f(xw.x), lo2f(xw.y), hi2f(xw.y)};
                      float y[4];
#pragma unroll
                      for (int j = 0; j < 4; ++j) { const float cv = rb == 0 ? C0[4 * (g + gg) + j] : C1[4 * (g + gg) + j]; y[j] = xx[j] * (cv + bias * uu[j]); }
                      pw[gg][0] = pkbf(y[0], y[1]); pw[gg][1] = pkbf(y[2], y[3]); }
                  const auto s0 = __builtin_amdgcn_permlane32_swap(pw[0][0], pw[1][0], false, false), s1 = __builtin_amdgcn_permlane32_swap(pw[0][1], pw[1][1], false, false);
                  u32x4 w; w.x = s0[0]; w.y = s1[0]; w.z = s0[1]; w.w = s1[1];
                  *(u32x4*)(yhT + (size_t)c * MTOK + bcol * SEQ + T0 + 64 * mcol + 32 * rb + 8 * (g + hl)) = w; } }
    }
}

DI void phase_attn_naive(const P& p) {
    const int lane = o_tid() & 63, wid = o_tid() >> 6;
    for (int vb = o_bid() * 8 + wid; vb < 64 * 32; vb += o_nb() * 8) {
    const int bh = vb >> 5, q = (vb & 31) * 64 + lane;
    const bf16_t* Q = (const bf16_t*)(p.ws + WS_Q) + ((size_t)bh * SEQ + q) * QKD;
    const bf16_t* K = (const bf16_t*)(p.ws + WS_K) + (size_t)bh * SEQ * QKD;
    const bf16_t* V = (const bf16_t*)(p.ws + WS_V) + (size_t)bh * VD * SEQ;
    float qv[QKD];
#pragma unroll
    for (int i = 0; i < QKD; ++i) qv[i] = bf2f(Q[i]);
    float o[VD];
#pragma unroll
    for (int i = 0; i < VD; ++i) o[i] = 0.f;
    float mx = -1e30f, l = 0.f;
    for (int k = 0; k < SEQ; ++k) {
        float s = 0.f;
#pragma unroll
        for (int i = 0; i < QKD; ++i) s += qv[i] * bf2f(K[(size_t)k * QKD + i]);
        const float mn = fmaxf(mx, s), al = exp2f(mx - mn), pr = exp2f(s - mn); mx = mn; l = l * al + pr;
#pragma unroll
        for (int i = 0; i < VD; ++i) o[i] = o[i] * al + pr * bf2f(V[(size_t)i * SEQ + k]);
    }
    const int b = bh >> 3, h = bh & 7; bf16_t* dst = (bf16_t*)(p.ws + WS_YATT) + ((size_t)(b * SEQ + q)) * 512 + h * VD;
#pragma unroll
    for (int i = 0; i < VD; ++i) dst[i] = f2bf(o[i] / l);
    }
}
DI void phase_hy_prep_naive(const P& p) {
    for (size_t idx = (size_t)o_bid() * NTHREADS + o_tid(); idx < (size_t)512 * MTOK; idx += (size_t)o_nb() * NTHREADS) {
    const int c = idx / MTOK, m = idx % MTOK, t = m & 2047;
    const bf16_t* uhT = (const bf16_t*)(p.ws + WS_Z);
    float r[3];
#pragma unroll
    for (int part = 0; part < 3; ++part) { const int ch = part * 512 + c; const bf16_t* row = uhT + (size_t)ch * MTOK + m;
        const float a = t > 0 ? bf2f(row[-1]) : 0.f, b = bf2f(row[0]), d = t < 2047 ? bf2f(row[1]) : 0.f;
        r[part] = a * p.sc_w[ch] + b * p.sc_w[1536 + ch] + d * p.sc_w[2 * 1536 + ch] + p.sc_b[ch]; }
    bf16_t* U = (bf16_t*)p.out; bf16_t* X0 = U + (size_t)512 * MTOK;
    U[idx] = f2bf(r[1] * r[2]); X0[idx] = f2bf(r[0]);
    }
}
DI void phase_hy_conv_naive(const P& p) {
    for (size_t idx = (size_t)o_bid() * NTHREADS + o_tid(); idx < (size_t)512 * MTOK; idx += (size_t)o_nb() * NTHREADS) {
    const int c = idx / MTOK, m = idx % MTOK, t = m & 2047, b = m >> 11;
    const bf16_t* U = (const bf16_t*)p.out + (size_t)c * MTOK + (size_t)b * SEQ; const bf16_t* X0 = (const bf16_t*)p.out + (size_t)512 * MTOK;
    const bf16_t* kr = (const bf16_t*)(p.ws + WS_KFIL) + (size_t)c * 4096;
    float acc = 0.f;
    for (int s = 0; s < SEQ; ++s) acc += bf2f(kr[2048 - t + s]) * bf2f(U[s]);
    const float y = bf2f(X0[idx]) * (acc + p.hy_bias[c] * bf2f(U[t]));
    ((bf16_t*)(p.ws + WS_YHT))[idx] = f2bf(y);
    }
}

#define XB_TMO      128
#define XB_XCNT(j)  (256  + 64 * (j))
#define XB_XSUB(j)  (1280 + 64 * (j))
#define XB_XGEN(j)  (2304 + 64 * (j))
#define XB_TOP      3328
#define XB_TOPGEN   3392
#define XCD_BAR_WORDS 3456
#define XB_SPIN_CAP (1u << 18)
DI unsigned xb_ld(unsigned* p)              { return __hip_atomic_load(p, __ATOMIC_RELAXED, __HIP_MEMORY_SCOPE_AGENT); }
DI unsigned xb_add(unsigned* p, unsigned v) { return __hip_atomic_fetch_add(p, v, __ATOMIC_RELAXED, __HIP_MEMORY_SCOPE_AGENT); }
DI unsigned xb_xcc_id() { return (unsigned)__builtin_amdgcn_s_getreg((3 << 11) | 20) & 0xFu; }
#define XB_SPIN(cond, bar) do { unsigned _sp = 0; while (cond) { __builtin_amdgcn_s_sleep(1); \
    if ((++_sp & 255u) == 0u) { if (xb_ld(&(bar)[XB_TMO])) break; if (_sp > XB_SPIN_CAP) { atomicAdd(&(bar)[XB_TMO], 1u); break; } } } } while (0)
struct XcdBarrier { unsigned* bar; unsigned x; volatile LAS unsigned* st; };
DI XcdBarrier xcd_barrier_post(unsigned* bar, volatile LAS unsigned* st) {
    XcdBarrier b; b.bar = bar; b.x = xb_xcc_id(); b.st = st;
    if (threadIdx.x == 0) (void)xb_add(&bar[XB_XCNT(b.x)], 1u);
    return b;
}
DI void xcd_barrier_complete(unsigned* bar, unsigned x, unsigned& nloc, unsigned& nx) {
    const unsigned G = gridDim.x * gridDim.y * gridDim.z;
    unsigned sum, cnt, mine, sp = 0u;
    for (;;) {
        sum = 0u; cnt = 0u; mine = 0u;
#pragma unroll
        for (unsigned j = 0; j < 16; ++j) { const unsigned c = xb_ld(&bar[XB_XCNT(j)]); sum += c; cnt += (c > 0u) ? 1u : 0u; mine = (j == x) ? c : mine; }
        if (sum == G) break;
        __builtin_amdgcn_s_sleep(1);
        if ((++sp & 255u) == 0u) { if (xb_ld(&bar[XB_TMO])) break; if (sp > XB_SPIN_CAP) { atomicAdd(&bar[XB_TMO], 1u); break; } }
    }
    nloc = mine > 0u ? mine : 1u; nx = cnt > 0u ? cnt : 1u;
}
DI void xcd_barrier(const XcdBarrier& b) {
    asm volatile("s_waitcnt vmcnt(0)" ::: "memory");
    __syncthreads();
    if (threadIdx.x == 0) {
        unsigned* bar = b.bar;
        __builtin_amdgcn_s_waitcnt(0);
        unsigned nloc = b.st[0], nx = b.st[1];
        if (nloc == 0u) { xcd_barrier_complete(bar, b.x, nloc, nx); b.st[0] = nloc; b.st[1] = nx; }
        const unsigned old = xb_add(&bar[XB_XSUB(b.x)], 1u);
        const unsigned gen = old / nloc;
        if (old + 1u == (gen + 1u) * nloc) {
            __builtin_amdgcn_fence(__ATOMIC_RELEASE, "agent");
            asm volatile("s_waitcnt vmcnt(0)" ::: "memory");
            const unsigned og = xb_add(&bar[XB_TOP], 1u);
            const unsigned tg = og / nx;
            if (og + 1u == (tg + 1u) * nx) xb_add(&bar[XB_TOPGEN], 1u);
            else XB_SPIN(xb_ld(&bar[XB_TOPGEN]) == tg, bar);
            __builtin_amdgcn_fence(__ATOMIC_ACQUIRE, "agent");
            xb_add(&bar[XB_XGEN(b.x)], 1u);
            asm volatile("s_waitcnt vmcnt(0)" ::: "memory");
        } else {
            XB_SPIN(xb_ld(&bar[XB_XGEN(b.x)]) == gen, bar);
            __builtin_amdgcn_fence(__ATOMIC_ACQUIRE, "agent");
            asm volatile("s_waitcnt vmcnt(0)" ::: "memory");
        }
    }
    __syncthreads();
}

enum { PH_PREP = 0, PH_G1, PH_G23, PH_HYP, PH_HYC, PH_QKPREP, PH_ATTN, PH_MIX, PH_G4, PH_G5, PH_G6, PH_G7, PH_COUNT };
DI void run_phase(const P& p, int ph, int dry = 0) {
    extern __shared__ __attribute__((aligned(16))) unsigned char shm[];
    switch (ph) {
        case PH_PREP: phase_prep(p, (LAS unsigned char*)shm); break;
        case PH_G1: phase_g1(p, (LAS unsigned char*)shm, dry); break;
#if NAIVE_HYENA
        case PH_G23: phase_g23(p, (LAS unsigned char*)shm); break;
#else
        case PH_G23: phase_g23(p, (LAS unsigned char*)shm); phase_hyena(p, (LAS unsigned char*)shm); break;
#endif
        case PH_QKPREP: phase_qkprep(p); phase_mixprep(p, shm); break;
        case PH_HYP: phase_hy_prep_naive(p); break;
        case PH_HYC: phase_hy_conv_naive(p); break;
#if NAIVE_ATTN
        case PH_ATTN: phase_attn_naive(p); break;
#else
        case PH_ATTN: phase_attn(p, (LAS unsigned char*)shm); break;
#endif
        case PH_MIX: break;
        case PH_G4: phase_g4(p, (LAS unsigned char*)shm, dry); break;
        case PH_G5: phase_g5(p, (LAS unsigned char*)shm); break;
        case PH_G6: phase_g6(p, (LAS unsigned char*)shm, dry); break;
        case PH_G7: phase_g7(p, (LAS unsigned char*)shm, dry); break;
    }
}
template <int PH> __global__ void __launch_bounds__(NTHREADS, 2) k_multi(P p) {
    run_phase(p, PH);
}
template <int PH> static void launch_phase(const P& p, int grid, hipStream_t stream) {
    static bool attr = false;
    if (!attr) { hipFuncSetAttribute((const void*)k_multi<PH>, hipFuncAttributeMaxDynamicSharedMemorySize, LDS_BYTES); attr = true; }
    hipLaunchKernelGGL(k_multi<PH>, dim3(grid), dim3(NTHREADS), LDS_BYTES, stream, p);
}
__global__ void __launch_bounds__(NTHREADS, 2) k_mega(P p) {
    cg::grid_group grid = cg::this_grid();
    extern __shared__ __attribute__((aligned(16))) unsigned char shm_top[];
    volatile LAS unsigned* st = (volatile LAS unsigned*)((LAS unsigned char*)shm_top + LDS_BYTES - 16);
    if (threadIdx.x == 0) { st[0] = 0u; st[1] = 0u; }
    __syncthreads();
    const XcdBarrier bar = xcd_barrier_post((unsigned*)(p.ws + WS_BAR), st);
#define GSYNC() xcd_barrier(bar)
#define RUNP(ph) do { run_phase(p, ph, 0); if (PROBE_REP == (ph)) { GSYNC(); run_phase(p, ph, 1); } } while (0)
    if (p.ws == nullptr) grid.sync();
    RUNP(PH_PREP); GSYNC();
    RUNP(PH_G1); GSYNC();
    RUNP(PH_G23); GSYNC();
    if (PROBE_REP == 100) { extern __shared__ __attribute__((aligned(16))) unsigned char shm_h[]; phase_hyena(p, (LAS unsigned char*)shm_h); GSYNC(); }
#if NAIVE_HYENA
    run_phase(p, PH_HYP); GSYNC();
    run_phase(p, PH_HYC); GSYNC();
#endif
    RUNP(PH_QKPREP); GSYNC();
    RUNP(PH_ATTN); GSYNC();
    RUNP(PH_G4); GSYNC();
    RUNP(PH_G5); GSYNC();
    RUNP(PH_G6); GSYNC();
    RUNP(PH_G7);
}

extern "C" void kernel_launch(void* const* d_in, const int* in_sizes, int n_in, void* d_out, int out_size, void* d_ws, size_t ws_size, hipStream_t stream) {
    static int grid = 0;
    if (grid == 0) {
        int dev = 0, cus = 0, per_cu = 0;
        hipGetDevice(&dev); hipDeviceGetAttribute(&cus, hipDeviceAttributeMultiprocessorCount, dev);
        if (cus <= 0) cus = 256;
        grid = cus;
#if N_LAUNCH_MODE == 1
        hipFuncSetAttribute((const void*)k_mega, hipFuncAttributeMaxDynamicSharedMemorySize, LDS_BYTES);
        hipOccupancyMaxActiveBlocksPerMultiprocessor(&per_cu, (const void*)k_mega, NTHREADS, LDS_BYTES);
        if (per_cu < 1) { fprintf(stderr, "kernel_launch: occupancy query says %d blocks/CU\n", per_cu); per_cu = 1; }
        grid = cus;
#endif
        if (ws_size < 256 * MiB) fprintf(stderr, "kernel_launch: workspace too small: %zu\n", ws_size);
    }
    P p{};
    const float** pp = (const float**)&p;
    for (int i = 0; i < 32; ++i) pp[i] = (const float*)d_in[i];
    p.out = (float*)d_out; p.ws = (unsigned char*)d_ws;
#if N_LAUNCH_MODE == 1
    hipMemsetAsync((unsigned char*)d_ws + WS_BAR, 0, XCD_BAR_WORDS * 4, stream);
    void* args[] = {&p};
    hipError_t e = hipLaunchCooperativeKernel((const void*)k_mega, dim3(grid), dim3(NTHREADS), args, LDS_BYTES, stream);
    if (e != hipSuccess) fprintf(stderr, "cooperative launch failed: %s (grid %d)\n", hipGetErrorString(e), grid);
#else
    launch_phase<PH_PREP>(p, grid, stream);
    launch_phase<PH_G1>(p, grid, stream);
    launch_phase<PH_G23>(p, grid, stream);
    launch_phase<PH_HYP>(p, grid, stream);
    launch_phase<PH_HYC>(p, grid, stream);
    launch_phase<PH_QKPREP>(p, grid, stream);
    launch_phase<PH_ATTN>(p, grid, stream);
    launch_phase<PH_MIX>(p, grid, stream);
    launch_phase<PH_G4>(p, grid, stream);
    launch_phase<PH_G5>(p, grid, stream);
    launch_phase<PH_G6>(p, grid, stream);
    launch_phase<PH_G7>(p, grid, stream);
#endif
}
```

```cpp
#include <hip/hip_runtime.h>
#include <hip/hip_cooperative_groups.h>
#include <cstdio>
namespace cg = cooperative_groups;

#ifndef N_LAUNCH_MODE
#define N_LAUNCH_MODE 1
#endif
#ifndef PROBE_REP
#define PROBE_REP -1
#endif
#ifndef NAIVE_ATTN
#define NAIVE_ATTN 0
#endif
#ifndef NAIVE_HYENA
#define NAIVE_HYENA 0
#endif

typedef unsigned short bf16_t;
typedef short bf16x8 __attribute__((ext_vector_type(8)));
typedef float f32x4 __attribute__((ext_vector_type(4)));
typedef float f32x16 __attribute__((ext_vector_type(16)));
typedef unsigned u32x4 __attribute__((ext_vector_type(4)));
typedef unsigned u32x2 __attribute__((ext_vector_type(2)));
#define LAS __attribute__((address_space(3)))
#define DI __device__ __forceinline__

constexpr int MTOK = 16384, SEQ = 2048, NB = 8, DM = 1024, PLE = 256;
constexpr int NH = 8, QKD = 96, NOPE = 64, ROPE = 32, VD = 64, QL = 768, KVL = 256;
constexpr int HYW = 512, INW = 2592, INWP = 2816, MLAW = 1056, DFF = 2816;
constexpr float EPS = 1e-6f;
constexpr int NTHREADS = 512;
constexpr int LDS_BYTES = 160 * 1024 - 4096;

constexpr size_t MiB = 1024 * 1024;
constexpr size_t WS_WIN = 0;
constexpr size_t WS_WUQ = WS_WIN + (size_t)INWP * DM * 2;
constexpr size_t WS_WUKV = WS_WUQ + (size_t)QL * QL * 2;
constexpr size_t WS_WOUT = WS_WUKV + (size_t)1024 * KVL * 2;
constexpr size_t WS_WUP = WS_WOUT + (size_t)DM * DM * 2;
constexpr size_t WS_WDOWN = WS_WUP + (size_t)2 * DFF * DM * 2;
constexpr size_t WS_WPLE = WS_WDOWN + (size_t)DM * DFF * 2;
constexpr size_t WS_WGATE = WS_WPLE + (size_t)DM * PLE * 2;
constexpr size_t WS_WEND = WS_WGATE + (size_t)DM * DM * 2;
static_assert(WS_WEND <= 29 * MiB, "weights");
constexpr size_t WS_STATS = 29 * MiB;
constexpr size_t WS_BAR = 29 * MiB + 512 * 1024;
constexpr size_t WS_KFIL = 30 * MiB;
constexpr size_t WS_PB = 34 * MiB;
constexpr size_t WS_X = 42 * MiB;
constexpr size_t WS_Y = 75 * MiB;
constexpr size_t WS_Z = 109 * MiB;
constexpr size_t WS_Q = 157 * MiB;
constexpr size_t WS_K = 181 * MiB;
constexpr size_t WS_V = 205 * MiB;
constexpr size_t WS_YHT = 221 * MiB;
constexpr size_t WS_YATT = 237 * MiB;
constexpr size_t WS_SSQAH = 253 * MiB;
constexpr size_t WS_ACT = 141 * MiB;
constexpr size_t WS_KRAW2 = WS_YATT;

struct P {
    const float *x, *p, *norm_mix, *w_in, *sc_w, *sc_b, *q_norm, *w_uq, *kv_norm, *w_ukv, *qk_nq, *qk_nk,
        *f_w1, *f_b1, *f_w2, *f_b2, *f_w3, *f_b3, *f_wout, *f_freq, *hy_bias, *on_attn, *on_hy, *w_out,
        *norm_ffn, *w_up, *fc_w, *fc_b, *w_down, *w_ple, *w_gate, *ple_norm;
    float* out; unsigned char* ws;
};

DI int o_tid() { int t = threadIdx.x; asm volatile("" : "+v"(t)); return t; }
DI int o_bid() { int t = blockIdx.x; asm volatile("" : "+s"(t)); return t; }
DI int o_nb() { int t = gridDim.x; asm volatile("" : "+s"(t)); return t; }
DI bf16_t f2bf(float f) { unsigned u = __float_as_uint(f); u += 0x7FFFu + ((u >> 16) & 1u); return (bf16_t)(u >> 16); }
DI float bf2f(bf16_t b) { return __uint_as_float(((unsigned)b) << 16); }
typedef __bf16 bf16x2_t __attribute__((ext_vector_type(2)));
typedef float f32x2_t __attribute__((ext_vector_type(2)));
DI unsigned pkbf(float a, float b) { f32x2_t f = {a, b}; bf16x2_t h = __builtin_convertvector(f, bf16x2_t); return __builtin_bit_cast(unsigned, h); }
DI unsigned pk2(float lo, float hi) { return (unsigned)f2bf(lo) | ((unsigned)f2bf(hi) << 16); }
DI float lo2f(unsigned w) { return __uint_as_float(w << 16); }
DI float hi2f(unsigned w) { return __uint_as_float(w & 0xffff0000u); }

namespace pg8 {
constexpr int BM = 256, BK = 64, HALF = 128, HTB = HALF * BK * 2, STAGE_BYTES = 8 * HTB, NXCD = 8, WGM = 8;
__host__ __device__ __forceinline__ int lds_byte(int r, int c) { const int st = (r >> 4) * 2 + (c >> 5), rr = r & 15, cc = c & 31, ob = rr * 64 + cc * 2; return st * 1024 + (ob ^ (((ob >> 9) & 1) << 5)); }
__host__ __device__ __forceinline__ void stage_rc(int b, int& R, int& C) { const int st = b / 1024, sb = b % 1024, swz = sb ^ (((sb >> 9) & 1) << 5); R = (st >> 1) * 16 + swz / 64; C = (st & 1) * 32 + (swz % 64) / 2; }
__host__ __device__ __forceinline__ int perm32(int rho) { const int n = rho >> 4, i = rho & 15; return 8 * (i >> 2) + 4 * n + (i & 3); }
struct Unit { int pm, pn; };
struct Gemm { const bf16_t* A; const bf16_t* Bt; int K, lda, nM, nN, TS, GS; int ldb = 0; int rperm = 0; int permB = 1; };
struct StaticOrder {
    int nM, nN, nwg, G, c;
    __host__ __device__ void init(int nM_, int nN_, int G_, int c_) { nM = nM_; nN = nN_; nwg = nM * nN; G = G_; c = c_; }
    __host__ __device__ bool next(int i, Unit& u) const {
        const long L = (long)i * G + c; if (L >= nwg) return false;
        int wgid = (int)L; { const int q = nwg / NXCD, r = nwg % NXCD, xcd = wgid % NXCD, off = wgid / NXCD; wgid = (xcd < r ? xcd * (q + 1) : r * (q + 1) + (xcd - r) * q) + off; }
        const int nig = WGM * nN, gid = wgid / nig, fm = gid * WGM, gsz = (nM - fm) < WGM ? (nM - fm) : WGM;
        u.pm = fm + ((wgid % nig) % gsz); u.pn = (wgid % nig) / gsz; return true;
    }
};
DI unsigned cvt_pk_bf16(float lo, float hi) { unsigned r; asm volatile("v_cvt_pk_bf16_f32 %0, %1, %2" : "=v"(r) : "v"(lo), "v"(hi)); return r; }

template <class Epi>
__device__ __forceinline__ void gemm_phase(LAS unsigned char* lds, const Gemm g, const StaticOrder& S, const Epi& E) {
    const int tid = o_tid(), wid = __builtin_amdgcn_readfirstlane(tid >> 6), lane = tid & 63, wr = wid >> 2, wc = wid & 3, fr = lane & 15, fq = lane >> 4;
    const int K = g.K, nt = K / BK, ldb = g.ldb ? g.ldb : K;
    unsigned voffA[2], voffB[2];
#pragma unroll
    for (int i = 0; i < 2; ++i) { int R, C; stage_rc(tid * 16 + i * 8192, R, C);
        const int rs = g.rperm ? (4 * (R & 15) + ((R >> 4) & 3)) : (R & 63);
        voffA[i] = (unsigned)(((R >> 6) * g.GS + rs) * g.lda + C) * 2u; const int Rb = g.permB ? ((R & ~31) + perm32(R & 31)) : R; voffB[i] = (unsigned)(Rb * ldb + C) * 2u; }
    const size_t kstep = (size_t)(BK * 2);
    const size_t hstepA = (size_t)(2 * g.GS) * g.lda * 2, tstepA = (size_t)g.TS * g.lda * 2;
    const size_t hstepB = (size_t)HALF * ldb * 2, tstepB = 2 * hstepB;
    const unsigned ldsw = (unsigned)wid * 1024u;
    const int aoff = lds_byte(wr * 64 + fr, fq * 8), boff = lds_byte(wc * 32 + fr, fq * 8);
#define PG8_SA(b, h) (((b) * 2 + (h)) * HTB)
#define PG8_SB(b, h) ((4 + (b) * 2 + (h)) * HTB)
#define PG8_STAGE(bufoff, gbase, voff) do { _Pragma("unroll") for (int _i = 0; _i < 2; ++_i) \
        __builtin_amdgcn_global_load_lds((const unsigned*)((const char*)(gbase) + (voff)[_i]), (LAS unsigned*)(lds + (bufoff) + ldsw + _i * 8192), 16, 0, 0); } while (0)
#define PG8_LDA(dst, b, h) do { _Pragma("unroll") for (int m = 0; m < 4; ++m) _Pragma("unroll") for (int k = 0; k < 2; ++k) dst[m][k] = *(const LAS bf16x8*)(lds + PG8_SA(b, h) + aoff + m * 2048 + k * 1024); } while (0)
#define PG8_LDB(dst, b, h) do { _Pragma("unroll") for (int n = 0; n < 2; ++n) _Pragma("unroll") for (int k = 0; k < 2; ++k) dst[n][k] = *(const LAS bf16x8*)(lds + PG8_SB(b, h) + boff + n * 2048 + k * 1024); } while (0)
#define PG8_MMA(ai, bj, At, Bt) do { __builtin_amdgcn_s_setprio(1); _Pragma("unroll") for (int m = 0; m < 4; ++m) _Pragma("unroll") for (int n = 0; n < 2; ++n) _Pragma("unroll") for (int k = 0; k < 2; ++k) \
        acc[ai][bj][m][n] = __builtin_amdgcn_mfma_f32_16x16x32_bf16(Bt[n][k], At[m][k], acc[ai][bj][m][n], 0, 0, 0); __builtin_amdgcn_s_setprio(0); } while (0)
#define PG8_WAIT_V(n) asm volatile("s_waitcnt vmcnt(" #n ")" ::: "memory")
#define PG8_WAIT_L(n) asm volatile("s_waitcnt lgkmcnt(" #n ")" ::: "memory")
#define PG8_BAR __builtin_amdgcn_s_barrier()
#define PG8_SCHED __builtin_amdgcn_sched_barrier(0)
    Unit cur, nxt; int ui = 0;
    if (!S.next(0, cur)) return;
    f32x4 acc[2][2][4][2];
    if constexpr (Epi::PREFETCH) E.prefetch(cur, wr, wc, lane);
    if constexpr (Epi::INIT) E.init(acc, cur, wr, wc, fr, fq);
    else {
#pragma unroll
    for (int a = 0; a < 2; ++a)
#pragma unroll
        for (int b = 0; b < 2; ++b)
#pragma unroll
            for (int m = 0; m < 4; ++m)
#pragma unroll
                for (int n = 0; n < 2; ++n) acc[a][b][m][n] = (f32x4){0.f, 0.f, 0.f, 0.f};
    }
    bf16x8 At[4][2], B0[2][2], B1[2][2];
    const char* cA = (const char*)g.A + (size_t)cur.pm * tstepA; const char* cB = (const char*)g.Bt + (size_t)cur.pn * tstepB;
    PG8_STAGE(PG8_SB(0, 0), cB, voffB); PG8_STAGE(PG8_SA(0, 0), cA, voffA); PG8_STAGE(PG8_SB(0, 1), cB + hstepB, voffB); PG8_STAGE(PG8_SA(0, 1), cA + hstepA, voffA);
    if (wr == 1) PG8_BAR;
    PG8_WAIT_V(4); PG8_BAR;
    PG8_STAGE(PG8_SB(1, 0), cB + kstep, voffB); PG8_STAGE(PG8_SA(1, 0), cA + kstep, voffA); PG8_STAGE(PG8_SB(1, 1), cB + hstepB + kstep, voffB);
    PG8_WAIT_V(6); PG8_BAR;
    for (;;) {
        const bool has_next = S.next(ui + 1, nxt);
        const char* nA = has_next ? (const char*)g.A + (size_t)nxt.pm * tstepA : cA; const char* nB = has_next ? (const char*)g.Bt + (size_t)nxt.pn * tstepB : cB;
        for (int t = 0; t < nt; t += 2) {
            const bool last = (t == nt - 2);
            if constexpr (Epi::MIDSCALE) { if (t == Epi::MID_T) E.mid(acc, cur, wr, wc, fr, fq); }
            const char* a1 = cA + (size_t)(t + 1) * kstep;
            const char* a2 = last ? nA : cA + (size_t)(t + 2) * kstep; const char* b2 = last ? nB : cB + (size_t)(t + 2) * kstep;
            const char* a3 = a2 + kstep; const char* b3 = b2 + kstep;
            PG8_LDB(B0, 0, 0); PG8_SCHED; PG8_LDA(At, 0, 0); PG8_STAGE(PG8_SA(1, 1), a1 + hstepA, voffA);
            PG8_WAIT_L(8); PG8_BAR; PG8_WAIT_L(0); PG8_MMA(0, 0, At, B0); PG8_BAR; PG8_SCHED;
            PG8_LDB(B1, 0, 1); PG8_STAGE(PG8_SB(0, 0), b2, voffB);
            PG8_BAR; PG8_WAIT_L(0); PG8_MMA(0, 1, At, B1); PG8_BAR;
            PG8_LDA(At, 0, 1); PG8_STAGE(PG8_SA(0, 0), a2, voffA);
            PG8_BAR; PG8_WAIT_L(0); PG8_MMA(1, 0, At, B0); PG8_BAR; PG8_SCHED;
            PG8_STAGE(PG8_SB(0, 1), b2 + hstepB, voffB);
            PG8_WAIT_V(6); PG8_BAR; PG8_MMA(1, 1, At, B1); PG8_BAR;
            PG8_LDB(B0, 1, 0); PG8_SCHED; PG8_LDA(At, 1, 0); PG8_STAGE(PG8_SA(0, 1), a2 + hstepA, voffA);
            PG8_WAIT_L(8); PG8_BAR; PG8_WAIT_L(0); PG8_MMA(0, 0, At, B0); PG8_BAR; PG8_SCHED;
            PG8_LDB(B1, 1, 1); PG8_STAGE(PG8_SB(1, 0), b3, voffB);
            PG8_BAR; PG8_WAIT_L(0); PG8_MMA(0, 1, At, B1); PG8_BAR;
            PG8_LDA(At, 1, 1); PG8_STAGE(PG8_SA(1, 0), a3, voffA);
            PG8_BAR; PG8_WAIT_L(0); PG8_MMA(1, 0, At, B0); PG8_BAR; PG8_SCHED;
            PG8_STAGE(PG8_SB(1, 1), b3 + hstepB, voffB);
            PG8_WAIT_V(6); PG8_BAR; PG8_MMA(1, 1, At, B1); PG8_BAR;
        }
        E(acc, cur, wr, wc, fr, fq);
        if (!has_next) break;
        if constexpr (Epi::PREFETCH) E.prefetch(nxt, wr, wc, lane);
        if constexpr (Epi::INIT) E.init(acc, nxt, wr, wc, fr, fq);
        else {
#pragma unroll
        for (int a = 0; a < 2; ++a)
#pragma unroll
            for (int b = 0; b < 2; ++b)
#pragma unroll
                for (int m = 0; m < 4; ++m)
#pragma unroll
                    for (int n = 0; n < 2; ++n) acc[a][b][m][n] = (f32x4){0.f, 0.f, 0.f, 0.f};
        }
        cur = nxt; cA = nA; cB = nB; ++ui;
    }
    PG8_WAIT_V(0);
    if (wr == 0) PG8_BAR;
    PG8_BAR;
#undef PG8_SA
#undef PG8_SB
#undef PG8_STAGE
#undef PG8_LDA
#undef PG8_LDB
#undef PG8_MMA
#undef PG8_WAIT_V
#undef PG8_WAIT_L
#undef PG8_BAR
#undef PG8_SCHED
}
}
typedef f32x4 Acc[2][2][4][2];

struct EpiProj {
    static constexpr bool MIDSCALE = false;
    static constexpr bool PREFETCH = false;
    static constexpr bool INIT = false;
    bf16_t* projm; const float* rs1; float* ssq_q; float* ssq_kv; int dry;
    DI void operator()(const Acc& acc, const pg8::Unit& u, int wr, int wc, int fr, int fq) const {
        asm volatile("" : "+v"(fr), "+v"(fq));
        float rsv[2][4];
#pragma unroll
        for (int ai = 0; ai < 2; ++ai)
#pragma unroll
            for (int m = 0; m < 4; ++m) rsv[ai][m] = rs1[u.pm * 256 + ai * 128 + wr * 64 + m * 16 + fr];
#pragma unroll
        for (int ai = 0; ai < 2; ++ai)
#pragma unroll
            for (int m = 0; m < 4; ++m) {
                const int row = u.pm * 256 + ai * 128 + wr * 64 + m * 16 + fr; const float rs = rsv[ai][m]; float ss = 0.f;
#pragma unroll
                for (int bj = 0; bj < 2; ++bj)
                    { const int c0 = u.pn * 256 + bj * 128 + wc * 32 + 8 * fq; const f32x4 v0 = acc[ai][bj][m][0] * rs, v1 = acc[ai][bj][m][1] * rs;
                        if (c0 < MLAW) { u32x4 w; w.x = pkbf(v0[0], v0[1]); w.y = pkbf(v0[2], v0[3]); w.z = pkbf(v1[0], v1[1]); w.w = pkbf(v1[2], v1[3]); *(u32x4*)(projm + (size_t)row * MLAW + c0) = w;
                            ss += v0[0] * v0[0] + v0[1] * v0[1] + v0[2] * v0[2] + v0[3] * v0[3] + v1[0] * v1[0] + v1[1] * v1[1] + v1[2] * v1[2] + v1[3] * v1[3]; }
                    }
                if (u.pn <= 3 && !dry) { ss += __shfl_xor(ss, 16); ss += __shfl_xor(ss, 32); if (fq == 0) atomicAdd((u.pn < 3 ? ssq_q : ssq_kv) + row, ss); }
            }
    }
};
struct EpiHyT {
    static constexpr bool MIDSCALE = false;
    static constexpr bool PREFETCH = false;
    static constexpr bool INIT = false;
    bf16_t* uhT; const float* rs1;
    DI void operator()(const Acc& acc, const pg8::Unit& u, int wr, int wc, int fr, int fq) const {
        asm volatile("" : "+v"(fr), "+v"(fq));
        f32x4 rsv[2][2];
#pragma unroll
        for (int bj = 0; bj < 2; ++bj)
#pragma unroll
            for (int n = 0; n < 2; ++n) rsv[bj][n] = *(const f32x4*)(rs1 + u.pn * 256 + bj * 128 + wc * 32 + 8 * fq + 4 * n);
#pragma unroll
        for (int ai = 0; ai < 2; ++ai)
#pragma unroll
            for (int m = 0; m < 4; ++m) {
                const int ch = u.pm * 256 + ai * 128 + wr * 64 + m * 16 + fr;
#pragma unroll
                for (int bj = 0; bj < 2; ++bj)
                    { const int c0 = u.pn * 256 + bj * 128 + wc * 32 + 8 * fq; const f32x4 v0 = acc[ai][bj][m][0] * rsv[bj][0], v1 = acc[ai][bj][m][1] * rsv[bj][1];
                        u32x4 w; w.x = pkbf(v0[0], v0[1]); w.y = pkbf(v0[2], v0[3]); w.z = pkbf(v1[0], v1[1]); w.w = pkbf(v1[2], v1[3]); *(u32x4*)(uhT + (size_t)ch * MTOK + c0) = w; }
            }
    }
};
struct EpiQ {
    static constexpr bool MIDSCALE = false;
    static constexpr bool PREFETCH = false;
    static constexpr bool INIT = false;
    bf16_t* qraw; const float* ssq_q;
    DI void operator()(const Acc& acc, const pg8::Unit& u, int wr, int wc, int fr, int fq) const {
        asm volatile("" : "+v"(fr), "+v"(fq));
        float rsv[2][4];
#pragma unroll
        for (int ai = 0; ai < 2; ++ai)
#pragma unroll
            for (int m = 0; m < 4; ++m) rsv[ai][m] = ssq_q[u.pm * 256 + ai * 128 + wr * 64 + m * 16 + fr];
#pragma unroll
        for (int ai = 0; ai < 2; ++ai)
#pragma unroll
            for (int m = 0; m < 4; ++m) {
                const int row = u.pm * 256 + ai * 128 + wr * 64 + m * 16 + fr; const float rs = rsqrtf(rsv[ai][m] * (1.0f / QL) + EPS);
#pragma unroll
                for (int bj = 0; bj < 2; ++bj)
                    { const int c0 = u.pn * 256 + bj * 128 + wc * 32 + 8 * fq; const f32x4 v0 = acc[ai][bj][m][0] * rs, v1 = acc[ai][bj][m][1] * rs;
                        u32x4 w; w.x = pkbf(v0[0], v0[1]); w.y = pkbf(v0[2], v0[3]); w.z = pkbf(v1[0], v1[1]); w.w = pkbf(v1[2], v1[3]); *(u32x4*)(qraw + (size_t)row * QL + c0) = w; }
                asm volatile("" ::: "memory");
            }
    }
};
struct EpiK {
    static constexpr bool MIDSCALE = false;
    static constexpr bool PREFETCH = false;
    static constexpr bool INIT = false;
    bf16_t* kraw; const float* ssq_kv;
    DI void operator()(const Acc& acc, const pg8::Unit& u, int wr, int wc, int fr, int fq) const {
        asm volatile("" : "+v"(fr), "+v"(fq));
        float rsv[2][4];
#pragma unroll
        for (int ai = 0; ai < 2; ++ai)
#pragma unroll
            for (int m = 0; m < 4; ++m) rsv[ai][m] = ssq_kv[u.pm * 256 + ai * 128 + wr * 64 + m * 16 + fr];
#pragma unroll
        for (int ai = 0; ai < 2; ++ai)
#pragma unroll
            for (int m = 0; m < 4; ++m) {
                const int row = u.pm * 256 + ai * 128 + wr * 64 + m * 16 + fr; const float rs = rsqrtf(rsv[ai][m] * (1.0f / KVL) + EPS);
#pragma unroll
                for (int bj = 0; bj < 2; ++bj)
                    { const int c0 = u.pn * 256 + bj * 128 + wc * 32 + 8 * fq; const f32x4 v0 = acc[ai][bj][m][0] * rs, v1 = acc[ai][bj][m][1] * rs;
                        u32x4 w; w.x = pkbf(v0[0], v0[1]); w.y = pkbf(v0[2], v0[3]); w.z = pkbf(v1[0], v1[1]); w.w = pkbf(v1[2], v1[3]); *(u32x4*)(kraw + (size_t)row * 512 + c0) = w; }
            }
    }
};
struct EpiVT {
    static constexpr bool MIDSCALE = false;
    static constexpr bool PREFETCH = false;
    static constexpr bool INIT = false;
    bf16_t* vt; const float* ssq_kv;
    DI void operator()(const Acc& acc, const pg8::Unit& u, int wr, int wc, int fr, int fq) const {
        asm volatile("" : "+v"(fr), "+v"(fq));
        f32x4 rsv[2][2];
#pragma unroll
        for (int bj = 0; bj < 2; ++bj)
#pragma unroll
            for (int n = 0; n < 2; ++n) { const f32x4 q = *(const f32x4*)(ssq_kv + u.pn * 256 + bj * 128 + wc * 32 + 8 * fq + 4 * n);
#pragma unroll
                for (int j = 0; j < 4; ++j) rsv[bj][n][j] = rsqrtf(q[j] * (1.0f / KVL) + EPS); }
#pragma unroll
        for (int ai = 0; ai < 2; ++ai)
#pragma unroll
            for (int m = 0; m < 4; ++m) {
                const int ch = u.pm * 256 + ai * 128 + wr * 64 + m * 16 + fr;
#pragma unroll
                for (int bj = 0; bj < 2; ++bj)
                    { const int c0 = u.pn * 256 + bj * 128 + wc * 32 + 8 * fq, b = c0 >> 11, s0 = c0 & 2047; const f32x4 v0 = acc[ai][bj][m][0] * rsv[bj][0], v1 = acc[ai][bj][m][1] * rsv[bj][1];
                        u32x4 w; w.x = pkbf(v0[0], v0[1]); w.y = pkbf(v0[2], v0[3]); w.z = pkbf(v1[0], v1[1]); w.w = pkbf(v1[2], v1[3]); *(u32x4*)(vt + ((size_t)b * 512 + ch) * SEQ + s0) = w; }
            }
    }
};
struct EpiOut {
    static constexpr bool MIDSCALE = true;
    static constexpr bool PREFETCH = false;
    static constexpr bool INIT = true;
    static constexpr int MID_T = 8;
    const bf16_t* xb; bf16_t* x1b; float* ssq2; const float* ssq_a; int dry;
    DI void mid(Acc& acc, const pg8::Unit& u, int wr, int wc, int fr, int fq) const {
        asm volatile("" : "+v"(fr), "+v"(fq));
#pragma unroll
        for (int ai = 0; ai < 2; ++ai)
#pragma unroll
            for (int m = 0; m < 4; ++m) { const f32x4* q = (const f32x4*)(ssq_a + (size_t)(u.pm * 256 + ai * 128 + wr * 64 + m * 16 + fr) * NH); const f32x4 q0 = q[0], q1 = q[1];
                const float rs = rsqrtf(((q0[0] + q0[1]) + (q0[2] + q0[3]) + (q1[0] + q1[1]) + (q1[2] + q1[3])) * (1.0f / 512) + EPS);
#pragma unroll
                for (int bj = 0; bj < 2; ++bj)
#pragma unroll
                    for (int n = 0; n < 2; ++n) acc[ai][bj][m][n] *= rs; }
    }
    DI void init(Acc& acc, const pg8::Unit& u, int wr, int wc, int fr, int fq) const {
        asm volatile("" : "+v"(fr), "+v"(fq));
#pragma unroll
        for (int ai = 0; ai < 2; ++ai)
#pragma unroll
            for (int m = 0; m < 4; ++m) { const int row = u.pm * 256 + ai * 128 + wr * 64 + m * 16 + fr; const f32x4* q = (const f32x4*)(ssq_a + (size_t)row * NH); const f32x4 q0 = q[0], q1 = q[1];
                const float ir = sqrtf(((q0[0] + q0[1]) + (q0[2] + q0[3]) + (q1[0] + q1[1]) + (q1[2] + q1[3])) * (1.0f / 512) + EPS);
#pragma unroll
                for (int bj = 0; bj < 2; ++bj)
                    { const u32x4 w = *(const u32x4*)(xb + (size_t)row * DM + u.pn * 256 + bj * 128 + wc * 32 + 8 * fq);
                        acc[ai][bj][m][0] = (f32x4){lo2f(w.x), hi2f(w.x), lo2f(w.y), hi2f(w.y)} * ir; acc[ai][bj][m][1] = (f32x4){lo2f(w.z), hi2f(w.z), lo2f(w.w), hi2f(w.w)} * ir; } }
    }
    DI void operator()(const Acc& acc, const pg8::Unit& u, int wr, int wc, int fr, int fq) const {
        asm volatile("" : "+v"(fr), "+v"(fq));
#pragma unroll
        for (int ai = 0; ai < 2; ++ai)
#pragma unroll
            for (int m = 0; m < 4; ++m) {
                const int row = u.pm * 256 + ai * 128 + wr * 64 + m * 16 + fr; float ss = 0.f;
#pragma unroll
                for (int bj = 0; bj < 2; ++bj)
                    { const int c0 = u.pn * 256 + bj * 128 + wc * 32 + 8 * fq; const size_t o = (size_t)row * DM + c0;
                        const f32x4 v0 = acc[ai][bj][m][0], v1 = acc[ai][bj][m][1];
                        u32x4 w; w.x = pkbf(v0[0], v0[1]); w.y = pkbf(v0[2], v0[3]); w.z = pkbf(v1[0], v1[1]); w.w = pkbf(v1[2], v1[3]); *(u32x4*)(x1b + o) = w;
                        ss += v0[0] * v0[0] + v0[1] * v0[1] + v0[2] * v0[2] + v0[3] * v0[3] + v1[0] * v1[0] + v1[1] * v1[1] + v1[2] * v1[2] + v1[3] * v1[3]; }
                ss += __shfl_xor(ss, 16); ss += __shfl_xor(ss, 32); if (fq == 0 && !dry) atomicAdd(ssq2 + row, ss);
            }
    }
};
struct EpiPle {
    static constexpr bool MIDSCALE = false;
    static constexpr bool PREFETCH = false;
    static constexpr bool INIT = false;
    bf16_t* eraw; float* ssq_e; int dry;
    DI void operator()(const Acc& acc, const pg8::Unit& u, int wr, int wc, int fr, int fq) const {
        asm volatile("" : "+v"(fr), "+v"(fq));
#pragma unroll
        for (int ai = 0; ai < 2; ++ai)
#pragma unroll
            for (int m = 0; m < 4; ++m) {
                const int row = u.pm * 256 + ai * 128 + wr * 64 + m * 16 + fr; float ss = 0.f;
#pragma unroll
                for (int bj = 0; bj < 2; ++bj)
                    { const int c0 = u.pn * 256 + bj * 128 + wc * 32 + 8 * fq; const f32x4 v0 = acc[ai][bj][m][0], v1 = acc[ai][bj][m][1];
                        u32x4 w; w.x = pkbf(v0[0], v0[1]); w.y = pkbf(v0[2], v0[3]); w.z = pkbf(v1[0], v1[1]); w.w = pkbf(v1[2], v1[3]); *(u32x4*)(eraw + (size_t)row * DM + c0) = w;
                        ss += v0[0] * v0[0] + v0[1] * v0[1] + v0[2] * v0[2] + v0[3] * v0[3] + v1[0] * v1[0] + v1[1] * v1[1] + v1[2] * v1[2] + v1[3] * v1[3]; }
                ss += __shfl_xor(ss, 16); ss += __shfl_xor(ss, 32); if (fq == 0 && !dry) atomicAdd(ssq_e + row, ss);                asm volatile("" ::: "memory");
            }
    }
};
DI float dpp_prev16(float v) { return __builtin_bit_cast(float, __builtin_amdgcn_update_dpp(0, __builtin_bit_cast(int, v), 0x121, 0xf, 0xf, false)); }
DI float dpp_next16(float v) { return __builtin_bit_cast(float, __builtin_amdgcn_update_dpp(0, __builtin_bit_cast(int, v), 0x12f, 0xf, 0xf, false)); }
struct EpiFfn {
    static constexpr bool MIDSCALE = false;
    static constexpr bool PREFETCH = true;
    static constexpr bool INIT = false;
    bf16_t* act; const float* ssq2; const float* cw; const float* cb; LAS float* slots;
    DI void prefetch(const pg8::Unit& u, int wr, int wc, int lane) const {
        asm volatile("" : "+v"(lane) :: "memory");
        LAS float* sl = slots + (wr * 4 + wc) * 384;
        const int pi = lane >> 3, fg = lane & 7, fb = u.pn * 128 + wc * 32 + 4 * fg;
        const float* src = ((pi & 3) == 3) ? (cb + (pi >> 2) * DFF + fb) : (cw + (pi & 3) * (2 * DFF) + (pi >> 2) * DFF + fb);
        __builtin_amdgcn_global_load_lds((const unsigned*)src, (LAS unsigned*)sl, 16, 0, 0);
#pragma unroll
        for (int ai = 0; ai < 2; ++ai) { const int tk = u.pm * 248 - 1 + (2 * ai + wr) * 62 + lane; const int tc = tk < 0 ? 0 : (tk >= MTOK ? MTOK - 1 : tk);
            __builtin_amdgcn_global_load_lds((const unsigned*)(ssq2 + tc), (LAS unsigned*)(sl + 256 + ai * 64), 4, 0, 0); }
    }
    DI void operator()(const Acc& acc, const pg8::Unit& u, int wr, int wc, int fr, int fq) const {
        asm volatile("" : "+v"(fr), "+v"(fq));
        LAS float* sl = slots + (wr * 4 + wc) * 384;
        f32x4 rsa[2];
#pragma unroll
        for (int ai = 0; ai < 2; ++ai) rsa[ai] = *(const LAS f32x4*)(sl + 256 + ai * 64 + 4 * fr);
#pragma unroll
        for (int ai = 0; ai < 2; ++ai) {
            const int tok0 = u.pm * 248 - 1 + (2 * ai + wr) * 62 + 4 * fr;
            float rsv[4], sP[4], sN[4];
#pragma unroll
            for (int m = 0; m < 4; ++m) { rsv[m] = rsqrtf(rsa[ai][m] * (1.0f / DM) + EPS); const int t = (tok0 + m) & 2047; sP[m] = (t == 2047) ? 0.f : rsv[m]; sN[m] = (t == 0) ? 0.f : rsv[m]; }
#pragma unroll
            for (int n = 0; n < 2; ++n) {
                const int f0 = u.pn * 128 + wc * 32 + 8 * fq + 4 * n;
                unsigned pk[2][4];
#pragma unroll
                for (int jp = 0; jp < 2; ++jp) {
                    float r[2][4];
#pragma unroll
                    for (int jj = 0; jj < 2; ++jj) {
                        const int j = 2 * jp + jj;
                        float gc[4];
#pragma unroll
                        for (int half = 0; half < 2; ++half) {
                            const LAS float* pp = sl + (4 * half) * 32 + 8 * fq + 4 * n + j; const float w0 = pp[0], w1 = pp[32], w2 = pp[64], bb = pp[96];
                            float x[4], xp[4], xn[4];
#pragma unroll
                            for (int m = 0; m < 4; ++m) { const float a = acc[ai][half][m][n][j]; x[m] = a * rsv[m]; xp[m] = a * sP[m]; xn[m] = a * sN[m]; }
                            const float pe = __builtin_bit_cast(float, __builtin_amdgcn_update_dpp(0, __builtin_bit_cast(int, xp[3]), 0x111, 0xf, 0xf, true));
                            const float ne = __builtin_bit_cast(float, __builtin_amdgcn_update_dpp(0, __builtin_bit_cast(int, xn[0]), 0x101, 0xf, 0xf, true));
#pragma unroll
                            for (int m = 0; m < 4; ++m) {
                                const float pv = (m == 0) ? pe : xp[m > 0 ? m - 1 : 0], nv = (m == 3) ? ne : xn[m < 3 ? m + 1 : 3];
                                const float cv = w0 * pv + w1 * x[m] + w2 * nv + bb;
                                if (half == 0) gc[m] = cv; else r[jj][m] = gc[m] * __builtin_amdgcn_rcpf(1.0f + __builtin_amdgcn_exp2f(-1.4426950408889634f * gc[m])) * cv; }
                        }
                    }
#pragma unroll
                    for (int m = 0; m < 4; ++m) pk[jp][m] = pkbf(r[0][m], r[1][m]);
                    __builtin_amdgcn_sched_barrier(0);
                }
#pragma unroll
                for (int m = 0; m < 4; ++m) {
                    const int L = 4 * fr + m, tk = tok0 + m;
                    if (L >= 1 && L <= 62 && tk >= 0 && tk < MTOK) { u32x2 w; w.x = pk[0][m]; w.y = pk[1][m]; *(u32x2*)(act + (size_t)tk * DFF + f0) = w; }
                }
            }
        }
    }
};
struct EpiDown {
    static constexpr bool MIDSCALE = false;
    static constexpr bool PREFETCH = false;
    static constexpr bool INIT = true;
    const bf16_t* x1b; bf16_t* x2b; int dry;
    DI void init(Acc& acc, const pg8::Unit& u, int wr, int wc, int fr, int fq) const {
        asm volatile("" : "+v"(fr), "+v"(fq));
#pragma unroll
        for (int ai = 0; ai < 2; ++ai)
#pragma unroll
            for (int m = 0; m < 4; ++m) { const int row = u.pm * 256 + ai * 128 + wr * 64 + m * 16 + fr;
#pragma unroll
                for (int bj = 0; bj < 2; ++bj)
                    { const u32x4 w = *(const u32x4*)(x1b + (size_t)row * DM + u.pn * 256 + bj * 128 + wc * 32 + 8 * fq);
                        acc[ai][bj][m][0] = (f32x4){lo2f(w.x), hi2f(w.x), lo2f(w.y), hi2f(w.y)}; acc[ai][bj][m][1] = (f32x4){lo2f(w.z), hi2f(w.z), lo2f(w.w), hi2f(w.w)}; } }
    }
    DI void operator()(const Acc& acc, const pg8::Unit& u, int wr, int wc, int fr, int fq) const {
        asm volatile("" : "+v"(fr), "+v"(fq));
        if (dry) return;
#pragma unroll
        for (int ai = 0; ai < 2; ++ai)
#pragma unroll
            for (int m = 0; m < 4; ++m) {
                const int row = u.pm * 256 + ai * 128 + wr * 64 + m * 16 + fr;
#pragma unroll
                for (int bj = 0; bj < 2; ++bj)
                    { const int c0 = u.pn * 256 + bj * 128 + wc * 32 + 8 * fq; const size_t o = (size_t)row * DM + c0;
                        const f32x4 v0 = acc[ai][bj][m][0], v1 = acc[ai][bj][m][1];
                        u32x4 w; w.x = pkbf(v0[0], v0[1]); w.y = pkbf(v0[2], v0[3]); w.z = pkbf(v1[0], v1[1]); w.w = pkbf(v1[2], v1[3]); *(u32x4*)(x2b + o) = w; }
            }
    }
};
struct EpiGate {
    static constexpr bool MIDSCALE = false;
    static constexpr bool PREFETCH = false;
    static constexpr bool INIT = false;
    float* out; const bf16_t* x2b; const bf16_t* eraw; const float* ssq_e; const float* gn; int dry;
    DI void operator()(const Acc& acc, const pg8::Unit& u, int wr, int wc, int fr, int fq) const {
        asm volatile("" : "+v"(fr), "+v"(fq));
        float rsv[2][4];
#pragma unroll
        for (int ai = 0; ai < 2; ++ai)
#pragma unroll
            for (int m = 0; m < 4; ++m) rsv[ai][m] = ssq_e[u.pm * 256 + ai * 128 + wr * 64 + m * 16 + fr];
#pragma unroll
        for (int ai = 0; ai < 2; ++ai)
#pragma unroll
            for (int m = 0; m < 4; ++m) {
                const int row = u.pm * 256 + ai * 128 + wr * 64 + m * 16 + fr; const float rs = rsqrtf(rsv[ai][m] * (1.0f / DM) + EPS);
#pragma unroll
                for (int bj = 0; bj < 2; ++bj)
#pragma unroll
                    for (int n = 0; n < 2; ++n) {
                        const int c0 = u.pn * 256 + bj * 128 + wc * 32 + 8 * fq + 4 * n; const size_t o = (size_t)row * DM + c0;
                        const u32x2 ew = *(const u32x2*)(eraw + o); const f32x4 g4 = *(const f32x4*)(gn + c0); const f32x4 a = acc[ai][bj][m][n];
                        f32x4 e; e[0] = lo2f(ew.x); e[1] = hi2f(ew.x); e[2] = lo2f(ew.y); e[3] = hi2f(ew.y);
                        const u32x2 xw = *(const u32x2*)(x2b + o); f32x4 v = (f32x4){lo2f(xw.x), hi2f(xw.x), lo2f(xw.y), hi2f(xw.y)};
#pragma unroll
                        for (int j = 0; j < 4; ++j) v[j] += __builtin_amdgcn_rcpf(1.0f + __builtin_amdgcn_exp2f(-1.4426950408889634f * a[j])) * e[j] * rs * g4[j];
                        if (!dry) __builtin_nontemporal_store(v, (f32x4*)(out + o)); }
                if (m & 1) asm volatile("" ::: "memory");
            }
    }
};

DI float wt_gain(const P& p, int mode, int k) {
    switch (mode) { case 1: return p.norm_mix[k]; case 2: return p.q_norm[k]; case 3: return p.kv_norm[k]; case 4: return k < 512 ? p.on_attn[k] : p.on_hy[k - 512]; case 5: return p.norm_ffn[k]; default: return 1.0f; }
}
DI void wt_tile_wave(const P& p, const float* __restrict__ src, bf16_t* __restrict__ dst, int K, int N, int tk, int tn, int mode, LAS float* lw, int lane) {
    const int k0 = tk * 64, n0 = tn * 64;
#pragma unroll
    for (int i = 0; i < 16; ++i) { const int idx = lane + 64 * i, kk = idx >> 4, c4 = idx & 15, n = n0 + 4 * c4;
        f32x4 v = (f32x4){0.f, 0.f, 0.f, 0.f}; if (n < N) v = __builtin_nontemporal_load((const f32x4*)(src + (size_t)(k0 + kk) * N + n));
        lw[kk * 65 + 4 * c4] = v[0]; lw[kk * 65 + 4 * c4 + 1] = v[1]; lw[kk * 65 + 4 * c4 + 2] = v[2]; lw[kk * 65 + 4 * c4 + 3] = v[3]; }
#pragma unroll
    for (int i = 0; i < 8; ++i) { const int idx = lane + 64 * i, nn = idx >> 3, k8 = idx & 7, n = n0 + nn, k = k0 + 8 * k8;
        float v[8];
#pragma unroll
        for (int j = 0; j < 8; ++j) v[j] = lw[(8 * k8 + j) * 65 + nn] * wt_gain(p, mode, k + j);
        if (n < N) { int dr = n; if (mode == 5) { dr = (n < DFF) ? ((n >> 7) * 256 + (n & 127)) : (((n - DFF) >> 7) * 256 + 128 + ((n - DFF) & 127)); }
            if (mode == 3) { dr = ((n & 127) < 64) ? ((n >> 7) * 64 + (n & 63)) : (512 + (n >> 7) * 64 + (n & 63)); }
            u32x4 w; w.x = pkbf(v[0], v[1]); w.y = pkbf(v[2], v[3]); w.z = pkbf(v[4], v[5]); w.w = pkbf(v[6], v[7]);
            *(u32x4*)(dst + (size_t)dr * K + k) = w; } }
}
DI void phase_prep(const P& p, LAS unsigned char* lds) {
    const int bid = o_bid(), nb = o_nb(), tid = o_tid(), lane = tid & 63, wid = tid >> 6;
    unsigned char* ws = p.ws;
    { LAS float* lw = (LAS float*)(lds + wid * (64 * 65 * 4));
      const int gw = bid * 8 + wid, nw = nb * 8;
      int base = 0;
#define WT_JOB(SRC, DST, KK, NN, MODE) do { const int tK = (KK) / 64, tN = ((NN) + 63) / 64, nt = tK * tN; \
          for (int t = ((gw - base) % nw + nw) % nw; t < nt; t += nw) wt_tile_wave(p, (SRC), (bf16_t*)(ws + (DST)), (KK), (NN), t % tK, t / tK, (MODE), lw, lane); \
          base += nt; } while (0)
      WT_JOB(p.w_up, WS_WUP, DM, 2 * DFF, 5);
      WT_JOB(p.w_down, WS_WDOWN, DFF, DM, 0);
      WT_JOB(p.w_in, WS_WIN, DM, INW, 1);
      WT_JOB(p.w_out, WS_WOUT, DM, DM, 4);
      WT_JOB(p.w_gate, WS_WGATE, DM, DM, 0);
      WT_JOB(p.w_uq, WS_WUQ, QL, QL, 2);
      WT_JOB(p.w_ukv, WS_WUKV, KVL, 1024, 3);
      WT_JOB(p.w_ple, WS_WPLE, PLE, DM, 0);
#undef WT_JOB
    }
    { u32x4* z = (u32x4*)(ws + WS_WIN + (size_t)INW * DM * 2); const int n16 = (INWP - INW) * DM * 2 / 16;
      for (int i = bid * NTHREADS + tid; i < n16; i += nb * NTHREADS) z[i] = (u32x4){0u, 0u, 0u, 0u}; }
    { float* st = (float*)(ws + WS_STATS) + MTOK; for (int i = bid * NTHREADS + tid; i < 5 * MTOK; i += nb * NTHREADS) st[i] = 0.f; }
    { bf16_t* xb = (bf16_t*)(ws + WS_X); float* rs1 = (float*)(ws + WS_STATS);
      for (int row0 = (bid * 8 + wid) * 4; row0 < MTOK; row0 += nb * 32) {
          f32x4 v[4][4];
#pragma unroll
          for (int r = 0; r < 4; ++r)
#pragma unroll
              for (int i = 0; i < 4; ++i) v[r][i] = __builtin_nontemporal_load((const f32x4*)(p.x + (size_t)(row0 + r) * DM) + lane + 64 * i);
#pragma unroll
          for (int r = 0; r < 4; ++r) { float ss = 0.f;
#pragma unroll
              for (int i = 0; i < 4; ++i) { const f32x4 t = v[r][i]; ss += t[0] * t[0] + t[1] * t[1] + t[2] * t[2] + t[3] * t[3];
                  u32x2 w; w.x = pkbf(t[0], t[1]); w.y = pkbf(t[2], t[3]); ((u32x2*)(xb + (size_t)(row0 + r) * DM))[lane + 64 * i] = w; }
#pragma unroll
              for (int o = 32; o >= 1; o >>= 1) ss += __shfl_xor(ss, o);
              if (lane == 0) rs1[row0 + r] = rsqrtf(ss * (1.0f / DM) + EPS); }
      } }
    { const f32x4* ps = (const f32x4*)p.p; u32x2* pd = (u32x2*)(ws + WS_PB);
      for (int i0 = bid * NTHREADS + tid; i0 < MTOK * PLE / 4; i0 += 8 * nb * NTHREADS) {
          f32x4 v[8];
#pragma unroll
          for (int k = 0; k < 8; ++k) { const int i = i0 + k * nb * NTHREADS; v[k] = (i < MTOK * PLE / 4) ? __builtin_nontemporal_load(ps + i) : (f32x4){0.f, 0.f, 0.f, 0.f}; }
#pragma unroll
          for (int k = 0; k < 8; ++k) { const int i = i0 + k * nb * NTHREADS; if (i < MTOK * PLE / 4) { u32x2 w; w.x = pkbf(v[k][0], v[k][1]); w.y = pkbf(v[k][2], v[k][3]); pd[i] = w; } } } }
    { bf16_t* kfil = (bf16_t*)(ws + WS_KFIL);
      LAS float* h3s = (LAS float*)(lds + 8 * 64 * 65 * 4);
      for (int lg = bid; lg < SEQ / 8; lg += nb) {
          const int l = lg * 8 + wid;
          const float t = (float)l / (float)(SEQ - 1);
          const float w = 6.283185307179586f * (float)l / (float)SEQ;
          float z = 0.f;
          if (lane == 0) z = t;
          else if (lane <= 16) { const float fb = 1e-4f + (float)(lane - 1) * ((15.0f - 1e-4f) / 15.0f); z = cosf(w * fb); }
          else if (lane <= 32) { const float fb = 1e-4f + (float)(lane - 17) * ((15.0f - 1e-4f) / 15.0f); z = -sinf(w * fb); }
          const float fr = p.f_freq[lane];
          float a = p.f_b1[lane];
          for (int i = 0; i < 33; ++i) a += __shfl(z, i) * p.f_w1[i * 64 + lane];
          float h = sinf(fr * a);
          a = p.f_b2[lane];
          for (int i = 0; i < 64; ++i) a += __shfl(h, i) * p.f_w2[i * 64 + lane];
          h = sinf(fr * a);
          a = p.f_b3[lane];
          for (int i = 0; i < 64; ++i) a += __shfl(h, i) * p.f_w3[i * 64 + lane];
          h = sinf(fr * a);
          __syncthreads();
          h3s[wid * 64 + lane] = h;
          __syncthreads();
          float o[8][2];
#pragma unroll
          for (int q = 0; q < 8; ++q) { o[q][0] = 0.f; o[q][1] = 0.f; }
#pragma unroll 1
          for (int jb = 0; jb < 64; jb += 16) {
              float w0[16], w1[16];
              const float* wp = p.f_wout + (size_t)jb * 1024 + tid;
#pragma unroll
              for (int j = 0; j < 16; ++j) { w0[j] = wp[j * 1024]; w1[j] = wp[j * 1024 + 512]; }
#pragma unroll
              for (int j4 = 0; j4 < 4; ++j4) {
#pragma unroll
                  for (int q = 0; q < 8; ++q) { const f32x4 hv = *(const LAS f32x4*)(h3s + q * 64 + jb + 4 * j4);
#pragma unroll
                      for (int k = 0; k < 4; ++k) { o[q][0] += hv[k] * w0[4 * j4 + k]; o[q][1] += hv[k] * w1[4 * j4 + k]; } }
                  __builtin_amdgcn_sched_barrier(0); } }
          const float mind = logf(1e-2f) / 0.3f, maxd = logf(1e-2f) / 1.5f;
          const int c = tid; const float delta = fabsf(mind + (float)c * ((maxd - mind) / 511.0f));
          float ff[8], fb[8];
#pragma unroll
          for (int q = 0; q < 8; ++q) { const int lq = lg * 8 + q; const float tq = (float)lq / (float)(SEQ - 1); const float dec = expf(-tq * delta); ff[q] = o[q][0] * dec; fb[q] = o[q][1] * dec; }
          { bf16_t* row = kfil + (size_t)c * 4096;
            u32x4 w; w.x = pkbf(lg == 0 ? ff[0] : fb[0], fb[1]); w.y = pkbf(fb[2], fb[3]); w.z = pkbf(fb[4], fb[5]); w.w = pkbf(fb[6], fb[7]);
            *(u32x4*)(row + 2048 + 8 * lg) = w;
            bf16_t* f0 = row + 2041 - 8 * lg;
            f0[0] = f2bf(ff[7]); *(unsigned*)(f0 + 1) = pkbf(ff[6], ff[5]); *(unsigned*)(f0 + 3) = pkbf(ff[4], ff[3]); *(unsigned*)(f0 + 5) = pkbf(ff[2], ff[1]);
            if (lg != 0) f0[7] = f2bf(ff[0]); }
          if (lg == 0) kfil[(size_t)c * 4096] = 0;
      } }
}

DI void phase_qkprep(const P& p) {
    const int bid = o_bid(), nb = o_nb(), lane = o_tid() & 63, wid = o_tid() >> 6;
    unsigned char* ws = p.ws;
    const bf16_t* qraw = (const bf16_t*)((const unsigned char*)p.out + 32 * MiB); const bf16_t* kraw = (const bf16_t*)(ws + WS_KRAW2); const bf16_t* projm = (const bf16_t*)(ws + WS_Y);
    bf16_t* Qh = (bf16_t*)(ws + WS_Q); bf16_t* Kh = (bf16_t*)(ws + WS_K);
    const int h = lane >> 3, sub = lane & 7;
    const float qscale = 0.10206207261596575f * 1.4426950408889634f;
    float gq[12], gk[12];
#pragma unroll
    for (int i = 0; i < 8; ++i) { gq[i] = p.qk_nq[8 * sub + i]; gk[i] = p.qk_nk[8 * sub + i]; }
#pragma unroll
    for (int e = 0; e < 2; ++e) { gq[8 + e] = p.qk_nq[64 + 2 * sub + e]; gq[10 + e] = p.qk_nq[80 + 2 * sub + e]; gk[8 + e] = p.qk_nk[64 + 2 * sub + e]; gk[10 + e] = p.qk_nk[80 + 2 * sub + e]; }
    float invf[2];
#pragma unroll
    for (int e = 0; e < 2; ++e) invf[e] = powf(10000.0f, -(float)(2 * sub + e) / 16.0f);
    for (int row0 = (bid * 8 + wid) * 2; row0 < MTOK; row0 += nb * 16) {
        u32x4 la[2][2]; unsigned l1[2][2], l2[2][2];
#pragma unroll
        for (int tt = 0; tt < 2; ++tt) {
            const int row = row0 + tt;
            const bf16_t* q = qraw + (size_t)row * QL + h * QKD; const bf16_t* k = kraw + (size_t)row * 512 + h * 64; const bf16_t* pe = projm + (size_t)row * MLAW + 1024;
            la[tt][0] = *(const u32x4*)(q + 8 * sub); l1[tt][0] = *(const unsigned*)(q + 64 + 2 * sub); l2[tt][0] = *(const unsigned*)(q + 80 + 2 * sub);
            la[tt][1] = *(const u32x4*)(k + 8 * sub); l1[tt][1] = *(const unsigned*)(pe + 2 * sub); l2[tt][1] = *(const unsigned*)(pe + 16 + 2 * sub);
        }
#pragma unroll
        for (int tt = 0; tt < 2; ++tt) {
        const int row = row0 + tt;
        const int b = row >> 11, s = row & 2047;
        float cs[2], sn[2];
#pragma unroll
        for (int e = 0; e < 2; ++e) { const float ang = (float)s * invf[e]; sn[e] = sinf(ang); cs[e] = cosf(ang); }
#pragma unroll
        for (int which = 0; which < 2; ++which) {
            float v[12];
            { const u32x4 a = la[tt][which]; const unsigned r1 = l1[tt][which], r2 = l2[tt][which];
              v[0] = lo2f(a.x); v[1] = hi2f(a.x); v[2] = lo2f(a.y); v[3] = hi2f(a.y); v[4] = lo2f(a.z); v[5] = hi2f(a.z); v[6] = lo2f(a.w); v[7] = hi2f(a.w);
              v[8] = lo2f(r1); v[9] = hi2f(r1); v[10] = lo2f(r2); v[11] = hi2f(r2); }
            float ss = 0.f;
#pragma unroll
            for (int i = 0; i < 12; ++i) ss += v[i] * v[i];
            ss += __shfl_xor(ss, 1); ss += __shfl_xor(ss, 2); ss += __shfl_xor(ss, 4);
            const float rs = rsqrtf(ss * (1.0f / QKD) + EPS) * (which == 0 ? qscale : 1.0f);
#pragma unroll
            for (int i = 0; i < 12; ++i) v[i] *= rs * (which == 0 ? gq[i] : gk[i]);
            float r[4];
#pragma unroll
            for (int e = 0; e < 2; ++e) { r[e] = v[8 + e] * cs[e] - v[10 + e] * sn[e]; r[2 + e] = v[10 + e] * cs[e] + v[8 + e] * sn[e]; }
            bf16_t* dst = (which == 0 ? Qh : Kh) + ((size_t)(b * NH + h) * SEQ + s) * QKD;
            u32x4 w; w.x = pkbf(v[0], v[1]); w.y = pkbf(v[2], v[3]); w.z = pkbf(v[4], v[5]); w.w = pkbf(v[6], v[7]);
            *(u32x4*)(dst + 8 * sub) = w; *(unsigned*)(dst + 64 + 2 * sub) = pkbf(r[0], r[1]); *(unsigned*)(dst + 80 + 2 * sub) = pkbf(r[2], r[3]);
        }
        }
    }
}

DI void phase_mixprep(const P& p, unsigned char* shm) {
    const int bid = o_bid(), nb = o_nb(), tid = o_tid(), lane = tid & 63, wid = tid >> 6;
    unsigned char* ws = p.ws;
    const bf16_t* yhT = (const bf16_t*)(ws + WS_YHT); bf16_t* ymix = (bf16_t*)p.out;
    bf16_t* tile = (bf16_t*)shm;
    float* part = (float*)(shm + 512 * 66 * 2);
    for (int t0 = bid; t0 < MTOK / 64; t0 += nb) {
        const int m0 = t0 * 64;
        u32x4 hr[8];
#pragma unroll
        for (int i = 0; i < 8; ++i) { const int idx = tid + NTHREADS * i, c = idx >> 3, q = idx & 7; hr[i] = *(const u32x4*)(yhT + (size_t)c * MTOK + m0 + q * 8); }
#pragma unroll
        for (int i = 0; i < 8; ++i) { const int idx = tid + NTHREADS * i, c = idx >> 3, q = idx & 7; const u32x4 a = hr[i];
            unsigned* d = (unsigned*)(tile + c * 66 + q * 8); d[0] = a.x; d[1] = a.y; d[2] = a.z; d[3] = a.w; }
        __syncthreads();
        { const int tok = lane, part_i = wid; float ss = 0.f;
          for (int c = part_i * 64; c < part_i * 64 + 64; ++c) { const float v = bf2f(tile[c * 66 + tok]); ss += v * v; }
          part[part_i * 64 + tok] = ss; }
        __syncthreads();
        { const int tok = lane, part_i = wid; float ss = 0.f;
#pragma unroll
          for (int i = 0; i < 8; ++i) ss += part[i * 64 + tok];
          const float rs = rsqrtf(ss * (1.0f / 512) + EPS);
          bf16_t* dst = ymix + (size_t)(m0 + tok) * DM + 512 + part_i * 64;
#pragma unroll
          for (int g = 0; g < 8; ++g) { float v[8];
#pragma unroll
              for (int i = 0; i < 8; ++i) v[i] = bf2f(tile[(part_i * 64 + g * 8 + i) * 66 + tok]) * rs;
              u32x4 w; w.x = pkbf(v[0], v[1]); w.y = pkbf(v[2], v[3]); w.z = pkbf(v[4], v[5]); w.w = pkbf(v[6], v[7]); *(u32x4*)(dst + g * 8) = w; } }
        __syncthreads();
    }
}

DI void phase_g1(const P& p, LAS unsigned char* shm, int dry) {
    unsigned char* ws = p.ws; float* st = (float*)(ws + WS_STATS);
    { pg8::Gemm g{(const bf16_t*)(ws + WS_X), (const bf16_t*)(ws + WS_WIN), DM, DM, 64, 5, 256, 64};
      pg8::StaticOrder S; S.init(g.nM, g.nN, o_nb(), o_bid());
      EpiProj E{(bf16_t*)(ws + WS_Y), st, st + MTOK, st + 2 * MTOK, dry};
      pg8::gemm_phase(shm, g, S, E); }
    { pg8::Gemm g{(const bf16_t*)(ws + WS_WIN) + (size_t)MLAW * DM, (const bf16_t*)(ws + WS_X), DM, DM, 6, 64, 256, 64};
      pg8::StaticOrder S; S.init(g.nM, g.nN, o_nb(), (o_bid() + 192) % o_nb());
      EpiHyT E{(bf16_t*)(ws + WS_Z), st};
      pg8::gemm_phase(shm, g, S, E); }
}
DI void phase_g23(const P& p, LAS unsigned char* shm) {
    unsigned char* ws = p.ws; float* st = (float*)(ws + WS_STATS);
    { pg8::Gemm g{(const bf16_t*)(ws + WS_Y), (const bf16_t*)(ws + WS_WUQ), QL, MLAW, 64, 3, 256, 64};
      pg8::StaticOrder S; S.init(g.nM, g.nN, o_nb(), o_bid());
      EpiQ E{(bf16_t*)((unsigned char*)p.out + 32 * MiB), st + MTOK};
      pg8::gemm_phase(shm, g, S, E); }
    { pg8::Gemm g{(const bf16_t*)(ws + WS_Y) + QL, (const bf16_t*)(ws + WS_WUKV), KVL, MLAW, 64, 2, 256, 64};
      pg8::StaticOrder S; S.init(g.nM, g.nN, o_nb(), (o_bid() + 64) % o_nb());
      EpiK E{(bf16_t*)(ws + WS_KRAW2), st + 2 * MTOK};
      pg8::gemm_phase(shm, g, S, E); }
    { pg8::Gemm g{(const bf16_t*)(ws + WS_WUKV) + (size_t)512 * KVL, (const bf16_t*)(ws + WS_Y) + QL, KVL, KVL, 2, 64, 256, 64, MLAW};
      pg8::StaticOrder S; S.init(g.nM, g.nN, o_nb(), (o_bid() + 192) % o_nb());
      EpiVT E{(bf16_t*)(ws + WS_V), st + 2 * MTOK};
      pg8::gemm_phase(shm, g, S, E); }
}
DI void phase_g4(const P& p, LAS unsigned char* shm, int dry) {
    unsigned char* ws = p.ws; float* st = (float*)(ws + WS_STATS);
    { pg8::Gemm g{(const bf16_t*)p.out, (const bf16_t*)(ws + WS_WOUT), DM, DM, 64, 4, 256, 64};
      pg8::StaticOrder S; S.init(g.nM, g.nN, o_nb(), o_bid());
      EpiOut E{(const bf16_t*)(ws + WS_X), (bf16_t*)(ws + WS_Y + 4096), st + 3 * MTOK, (const float*)(ws + WS_SSQAH), dry};
      pg8::gemm_phase(shm, g, S, E); }
    { pg8::Gemm g{(const bf16_t*)(ws + WS_PB), (const bf16_t*)(ws + WS_WPLE), PLE, PLE, 64, 4, 256, 64};
      pg8::StaticOrder S; S.init(g.nM, g.nN, o_nb(), o_bid());
      EpiPle E{(bf16_t*)(ws + WS_Z), st + 4 * MTOK, dry};
      pg8::gemm_phase(shm, g, S, E); }
}
DI void phase_g5(const P& p, LAS unsigned char* shm) {
    unsigned char* ws = p.ws; float* st = (float*)(ws + WS_STATS);
    pg8::Gemm g{(const bf16_t*)(ws + WS_Y + 4096) - DM, (const bf16_t*)(ws + WS_WUP), DM, DM, 67, 22, 248, 62, 0, 1};
    pg8::StaticOrder S; S.init(g.nM, g.nN, o_nb(), o_bid());
    EpiFfn E{(bf16_t*)(ws + WS_ACT), st + 3 * MTOK, p.fc_w, p.fc_b, (LAS float*)(shm + pg8::STAGE_BYTES)};
    pg8::gemm_phase(shm, g, S, E);
}
DI void phase_g6(const P& p, LAS unsigned char* shm, int dry) {
    unsigned char* ws = p.ws;
    pg8::Gemm g{(const bf16_t*)(ws + WS_ACT), (const bf16_t*)(ws + WS_WDOWN), DFF, DFF, 64, 4, 256, 64};
    pg8::StaticOrder S; S.init(g.nM, g.nN, o_nb(), o_bid());
    EpiDown E{(const bf16_t*)(ws + WS_Y + 4096), (bf16_t*)(ws + WS_X), dry};
    pg8::gemm_phase(shm, g, S, E);
}
DI void phase_g7(const P& p, LAS unsigned char* shm, int dry) {
    unsigned char* ws = p.ws; float* st = (float*)(ws + WS_STATS);
    pg8::Gemm g{(const bf16_t*)(ws + WS_X), (const bf16_t*)(ws + WS_WGATE), DM, DM, 64, 4, 256, 64};
    pg8::StaticOrder S; S.init(g.nM, g.nN, o_nb(), o_bid());
    EpiGate E{p.out, (const bf16_t*)(ws + WS_X), (const bf16_t*)(ws + WS_Z), st + 4 * MTOK, p.ple_norm, dry};
    pg8::gemm_phase(shm, g, S, E);
}

#define MFMA32(a, b, c) __builtin_amdgcn_mfma_f32_32x32x16_bf16((a), (b), (c), 0, 0, 0)
constexpr int AT_KRS = 208, AT_VRS = 136, AT_KBYTES = 64 * AT_KRS, AT_VBYTES = 64 * AT_VRS, AT_BUF = AT_KBYTES + AT_VBYTES;
DI void phase_attn(const P& p, LAS unsigned char* lds) {
    const int tid = o_tid(), lane = tid & 63, wid = tid >> 6, l31 = lane & 31, hl = lane >> 5;
    const int bid = o_bid(), nb = o_nb();
    const bf16_t* Qg = (const bf16_t*)(p.ws + WS_Q); const bf16_t* Kg = (const bf16_t*)(p.ws + WS_K); const bf16_t* Vg = (const bf16_t*)(p.ws + WS_V);
    bf16_t* Y = (bf16_t*)p.out;
    float* ssq_ah = (float*)(p.ws + WS_SSQAH);
    const int kl0 = (tid / 12) * AT_KRS + (tid % 12) * 16, kl1 = ((512 + tid) / 12) * AT_KRS + ((512 + tid) % 12) * 16;
    const int vdv = tid >> 3, vpart = tid & 7, vl = vdv * AT_VRS + vpart * 16;
    for (int it0 = bid; it0 < 256; it0 += nb) {
        const int item = ((it0 & 7) * 8 + ((it0 >> 3) >> 2)) * 4 + ((it0 >> 3) & 3);
        const int bh = item >> 2, q0 = (item & 3) * 512;
        bf16x8 Qf[2][6];
#pragma unroll
        for (int qb = 0; qb < 2; ++qb)
#pragma unroll
            for (int kk = 0; kk < 6; ++kk) Qf[qb][kk] = *(const bf16x8*)(Qg + ((size_t)bh * SEQ + q0 + 64 * wid + 32 * qb + l31) * QKD + 16 * kk + 8 * hl);
        f32x16 O[2][2];
#pragma unroll
        for (int a = 0; a < 2; ++a)
#pragma unroll
            for (int b = 0; b < 2; ++b)
#pragma unroll
                for (int i = 0; i < 16; ++i) O[a][b][i] = 0.f;
        float mrow[2] = {0.f, 0.f}, lsum[2] = {0.f, 0.f}; bool refs = false;
        const unsigned char* Kt = (const unsigned char*)(Kg + (size_t)bh * SEQ * QKD);
        const unsigned char* Vt = (const unsigned char*)(Vg + (size_t)bh * VD * SEQ) + (size_t)vdv * SEQ * 2 + vpart * 16;
        u32x4 kr0 = *(const u32x4*)(Kt + tid * 16), kr1 = (u32x4){0u, 0u, 0u, 0u}, vr = *(const u32x4*)(Vt);
        if (tid < 256) kr1 = *(const u32x4*)(Kt + (512 + tid) * 16);
        __syncthreads();
        *(LAS u32x4*)(lds + kl0) = kr0; if (tid < 256) *(LAS u32x4*)(lds + kl1) = kr1;
        *(LAS u32x2*)(lds + AT_KBYTES + vl) = (u32x2){vr.x, vr.y}; *(LAS u32x2*)(lds + AT_KBYTES + vl + 8) = (u32x2){vr.z, vr.w};
        __syncthreads();
#pragma unroll 1
        for (int it = 0; it < 32; ++it) {
            LAS unsigned char* kb_ = lds + (it & 1) * AT_BUF; LAS unsigned char* vb_ = kb_ + AT_KBYTES;
            if (it + 1 < 32) {
                kr0 = *(const u32x4*)(Kt + (size_t)(it + 1) * 12288 + tid * 16); if (tid < 256) kr1 = *(const u32x4*)(Kt + (size_t)(it + 1) * 12288 + (512 + tid) * 16);
                vr = *(const u32x4*)(Vt + (size_t)(it + 1) * 128); }
            f32x16 S[2][2];
#pragma unroll
            for (int a = 0; a < 2; ++a)
#pragma unroll
                for (int b = 0; b < 2; ++b)
#pragma unroll
                    for (int i = 0; i < 16; ++i) S[a][b][i] = 0.f;
#pragma unroll
            for (int kb = 0; kb < 2; ++kb)
#pragma unroll
                for (int kk = 0; kk < 6; ++kk) {
                    const bf16x8 a = *(const LAS bf16x8*)(kb_ + (32 * kb + l31) * AT_KRS + 32 * kk + 16 * hl);
                    S[kb][0] = MFMA32(a, Qf[0][kk], S[kb][0]); S[kb][1] = MFMA32(a, Qf[1][kk], S[kb][1]); }
#pragma unroll
            for (int qb = 0; qb < 2; ++qb) {
                float mx = S[0][qb][0];
#pragma unroll
                for (int i = 1; i < 16; ++i) mx = fmaxf(mx, S[0][qb][i]);
#pragma unroll
                for (int i = 0; i < 16; ++i) mx = fmaxf(mx, S[1][qb][i]);
                { float mx2 = mx; asm volatile("" : "+v"(mx2));
                  const auto r = __builtin_amdgcn_permlane32_swap(__builtin_bit_cast(unsigned, mx), __builtin_bit_cast(unsigned, mx2), false, false);
                  mx = fmaxf(__builtin_bit_cast(float, r[0]), __builtin_bit_cast(float, r[1])); }
                { const float rel = mx - mrow[qb]; const bool need = (it == 0) ? (fabsf(rel) > 8.0f) : (rel > 8.0f);
                  if (__builtin_amdgcn_ballot_w64(need) != 0ull) {
                      const float d = need ? rel : 0.f, alpha = (it == 0) ? 1.0f : __builtin_amdgcn_exp2f(-d);
                      mrow[qb] += d; lsum[qb] *= alpha; refs = true;
#pragma unroll
                      for (int dvb = 0; dvb < 2; ++dvb)
#pragma unroll
                          for (int i = 0; i < 16; ++i) O[dvb][qb][i] *= alpha;
                  } }
                if (refs) {
                    const float mm = mrow[qb];
#pragma unroll
                    for (int kb = 0; kb < 2; ++kb)
#pragma unroll
                        for (int i = 0; i < 16; ++i) S[kb][qb][i] -= mm;
                }
                float ps = 0.f;
#pragma unroll
                for (int kb = 0; kb < 2; ++kb)
#pragma unroll
                    for (int i = 0; i < 16; ++i) { const float e = __builtin_amdgcn_exp2f(S[kb][qb][i]); S[kb][qb][i] = e; ps += e; }
                lsum[qb] += ps;
            }
#pragma unroll
            for (int c = 0; c < 4; ++c) {
                const int kb = c >> 1, s8 = (c & 1) * 8;
                bf16x8 pf[2];
#pragma unroll
                for (int qb = 0; qb < 2; ++qb) { u32x4 w; w.x = pkbf(S[kb][qb][s8 + 0], S[kb][qb][s8 + 1]); w.y = pkbf(S[kb][qb][s8 + 2], S[kb][qb][s8 + 3]);
                    w.z = pkbf(S[kb][qb][s8 + 4], S[kb][qb][s8 + 5]); w.w = pkbf(S[kb][qb][s8 + 6], S[kb][qb][s8 + 7]); pf[qb] = __builtin_bit_cast(bf16x8, w); }
#pragma unroll
                for (int dvb = 0; dvb < 2; ++dvb) {
                    const LAS unsigned char* va = vb_ + (32 * dvb + l31) * AT_VRS + (16 * c + 4 * hl) * 2;
                    const u32x2 lo = *(const LAS u32x2*)va, hi = *(const LAS u32x2*)(va + 16);
                    const bf16x8 a = __builtin_bit_cast(bf16x8, (u32x4){lo.x, lo.y, hi.x, hi.y});
                    O[dvb][0] = MFMA32(a, pf[0], O[dvb][0]); O[dvb][1] = MFMA32(a, pf[1], O[dvb][1]); }
            }
            if (it + 1 < 32) {
                LAS unsigned char* kn = lds + ((it + 1) & 1) * AT_BUF;
                *(LAS u32x4*)(kn + kl0) = kr0; if (tid < 256) *(LAS u32x4*)(kn + kl1) = kr1;
                *(LAS u32x2*)(kn + AT_KBYTES + vl) = (u32x2){vr.x, vr.y}; *(LAS u32x2*)(kn + AT_KBYTES + vl + 8) = (u32x2){vr.z, vr.w}; }
            __syncthreads();
        }
        const int b = bh >> 3, h = bh & 7;
#pragma unroll
        for (int qb = 0; qb < 2; ++qb) {
            const float lt = lsum[qb] + __shfl_xor(lsum[qb], 32), inv = 1.0f / lt;
            const int orow = b * SEQ + q0 + 64 * wid + 32 * qb + l31;
            bf16_t* dst = Y + (size_t)orow * DM + h * VD;
            { float ss = 0.f;
#pragma unroll
              for (int dvb = 0; dvb < 2; ++dvb)
#pragma unroll
                  for (int i = 0; i < 16; ++i) { const float v = O[dvb][qb][i] * inv; ss += v * v; }
              ss += __shfl_xor(ss, 32);
              if (hl == 0) ssq_ah[(size_t)orow * NH + h] = ss; }
#pragma unroll
            for (int dvb = 0; dvb < 2; ++dvb)
#pragma unroll
                for (int g = 0; g < 4; g += 2) {
                    const unsigned a0 = pkbf(O[dvb][qb][4 * g] * inv, O[dvb][qb][4 * g + 1] * inv), a1 = pkbf(O[dvb][qb][4 * g + 2] * inv, O[dvb][qb][4 * g + 3] * inv);
                    const unsigned b0 = pkbf(O[dvb][qb][4 * g + 4] * inv, O[dvb][qb][4 * g + 5] * inv), b1 = pkbf(O[dvb][qb][4 * g + 6] * inv, O[dvb][qb][4 * g + 7] * inv);
                    const auto s0 = __builtin_amdgcn_permlane32_swap(a0, b0, false, false), s1 = __builtin_amdgcn_permlane32_swap(a1, b1, false, false);
                    u32x4 w; w.x = s0[0]; w.y = s1[0]; w.z = s0[1]; w.w = s1[1];
                    *(u32x4*)(dst + 32 * dvb + 8 * (g + hl)) = w; }
        }
    }
}

constexpr int HY_CS = 8224, HY_URS = 4880, HY_UP = 8 * HY_CS, HY_X0 = HY_UP + 8 * HY_URS, HY_END = HY_X0 + 8 * 2048 * 2;
static_assert(HY_END <= LDS_BYTES, "hyena LDS");
DI void phase_hyena(const P& p, LAS unsigned char* lds) {
    const int tid = o_tid(), lane = tid & 63, wid = tid >> 6, l31 = lane & 31, hl = lane >> 5;
    const int bid = o_bid(), nb = o_nb();
    const bf16_t* uhT = (const bf16_t*)(p.ws + WS_Z); const bf16_t* kfil = (const bf16_t*)(p.ws + WS_KFIL); bf16_t* yhT = (bf16_t*)(p.ws + WS_YHT);
    for (int c = bid; c < HYW; c += nb) {
        __syncthreads();
        { const bf16_t* kr = kfil + (size_t)c * 4096; const int q = tid;
          const u32x4 A = *(const u32x4*)(kr + 8 * q); const u32x4 B = (q < 511) ? *(const u32x4*)(kr + 8 * q + 8) : (u32x4){0u, 0u, 0u, 0u};
          const unsigned d[8] = {A.x, A.y, A.z, A.w, B.x, B.y, B.z, B.w};
#pragma unroll
          for (int r = 0; r < 8; ++r) { const int e = r >> 1; u32x4 o;
              if ((r & 1) == 0) { o.x = d[e]; o.y = d[e + 1]; o.z = d[e + 2]; o.w = d[e + 3]; }
              else { o.x = __builtin_amdgcn_alignbit(d[e + 1], d[e], 16); o.y = __builtin_amdgcn_alignbit(d[e + 2], d[e + 1], 16); o.z = __builtin_amdgcn_alignbit(d[e + 3], d[e + 2], 16); o.w = __builtin_amdgcn_alignbit(d[e + 4], d[e + 3], 16); }
              *(LAS u32x4*)(lds + r * HY_CS + 16 * q) = o; } }
        if (tid < 384) { const int b = tid / 48, k = tid % 48; LAS unsigned char* row = lds + HY_UP + b * HY_URS; const int off = (k < 24) ? k * 16 : (2240 * 2 + (k - 24) * 16); *(LAS u32x4*)(row + off) = (u32x4){0u, 0u, 0u, 0u}; }
        { float w0[3], w1[3], w2[3], bb[3];
#pragma unroll
          for (int a = 0; a < 3; ++a) { const int ch = a * HYW + c; w0[a] = p.sc_w[ch]; w1[a] = p.sc_w[1536 + ch]; w2[a] = p.sc_w[3072 + ch]; bb[a] = p.sc_b[ch]; }
#pragma unroll 2
          for (int i = 0; i < 4; ++i) {
              const int ch = tid + 512 * i, b = ch >> 8, t0 = (ch & 255) * 8, m0 = b * SEQ + t0;
              float r[3][8];
#pragma unroll
              for (int a = 0; a < 3; ++a) {
                  const bf16_t* row = uhT + (size_t)(a * HYW + c) * MTOK + m0;
                  const u32x4 v = *(const u32x4*)row; const float pv = t0 > 0 ? bf2f(row[-1]) : 0.f, nv = t0 < SEQ - 8 ? bf2f(row[8]) : 0.f;
                  const float x[10] = {pv, lo2f(v.x), hi2f(v.x), lo2f(v.y), hi2f(v.y), lo2f(v.z), hi2f(v.z), lo2f(v.w), hi2f(v.w), nv};
#pragma unroll
                  for (int k = 0; k < 8; ++k) r[a][k] = w0[a] * x[k] + w1[a] * x[k + 1] + w2[a] * x[k + 2] + bb[a];
              }
              u32x4 uo, xo;
              uo.x = pkbf(r[1][0] * r[2][0], r[1][1] * r[2][1]); uo.y = pkbf(r[1][2] * r[2][2], r[1][3] * r[2][3]); uo.z = pkbf(r[1][4] * r[2][4], r[1][5] * r[2][5]); uo.w = pkbf(r[1][6] * r[2][6], r[1][7] * r[2][7]);
              xo.x = pkbf(r[0][0], r[0][1]); xo.y = pkbf(r[0][2], r[0][3]); xo.z = pkbf(r[0][4], r[0][5]); xo.w = pkbf(r[0][6], r[0][7]);
              *(LAS u32x4*)(lds + HY_UP + b * HY_URS + (192 + t0) * 2) = uo; *(LAS u32x4*)(lds + HY_X0 + (b * SEQ + t0) * 2) = xo;
          } }
        __syncthreads();
        const int T0 = 256 * wid, rho = (-l31) & 7, bcol = l31 & 7, mcol = l31 >> 3;
        const LAS unsigned char* ap = lds + rho * HY_CS + 2 * (1856 - T0 + 8 * hl - l31 - rho);
        const LAS unsigned char* bp = lds + HY_UP + bcol * HY_URS + (64 * mcol + 8 * hl) * 2;
        f32x16 C0, C1;
#pragma unroll
        for (int i = 0; i < 16; ++i) { C0[i] = 0.f; C1[i] = 0.f; }
        bf16x8 am2 = *(const LAS bf16x8*)(ap - 64), am1 = *(const LAS bf16x8*)(ap - 32);
#pragma unroll 4
        for (int e = 0; e < 140; ++e) {
            const bf16x8 ac = *(const LAS bf16x8*)(ap + 32 * e); const bf16x8 bf = *(const LAS bf16x8*)(bp + 32 * e);
            C0 = MFMA32(ac, bf, C0); C1 = MFMA32(am2, bf, C1);
            am2 = am1; am1 = ac;
        }
        { const float bias = p.hy_bias[c];
#pragma unroll
          for (int rb = 0; rb < 2; ++rb)
#pragma unroll
              for (int g = 0; g < 4; g += 2) {
                  unsigned pw[2][2];
#pragma unroll
                  for (int gg = 0; gg < 2; ++gg) {
                      const int t0 = T0 + 64 * mcol + 32 * rb + 8 * (g + gg) + 4 * hl;
                      const u32x2 uw = *(const LAS u32x2*)(lds + HY_UP + bcol * HY_URS + (192 + t0) * 2), xw = *(const LAS u32x2*)(lds + HY_X0 + (bcol * SEQ + t0) * 2);
                      const float uu[4] = {lo2f(uw.x), hi2f(uw.x), lo2f(uw.y), hi2f(uw.y)}, xx[4] = {lo2f(xw.x), hi2f(xw.x), lo2f(xw.y), hi2f(xw.y)};
                      float y[4];
#pragma unroll
                      for (int j = 0; j < 4; ++j) { const float cv = rb == 0 ? C0[4 * (g + gg) + j] : C1[4 * (g + gg) + j]; y[j] = xx[j] * (cv + bias * uu[j]); }
                      pw[gg][0] = pkbf(y[0], y[1]); pw[gg][1] = pkbf(y[2], y[3]); }
                  const auto s0 = __builtin_amdgcn_permlane32_swap(pw[0][0], pw[1][0], false, false), s1 = __builtin_amdgcn_permlane32_swap(pw[0][1], pw[1][1], false, false);
                  u32x4 w; w.x = s0[0]; w.y = s1[0]; w.z = s0[1]; w.w = s1[1];
                  *(u32x4*)(yhT + (size_t)c * MTOK + bcol * SEQ + T0 + 64 * mcol + 32 * rb + 8 * (g + hl)) = w; } }
    }
}

DI void phase_attn_naive(const P& p) {
    const int lane = o_tid() & 63, wid = o_tid() >> 6;
    for (int vb = o_bid() * 8 + wid; vb < 64 * 32; vb += o_nb() * 8) {
    const int bh = vb >> 5, q = (vb & 31) * 64 + lane;
    const bf16_t* Q = (const bf16_t*)(p.ws + WS_Q) + ((size_t)bh * SEQ + q) * QKD;
    const bf16_t* K = (const bf16_t*)(p.ws + WS_K) + (size_t)bh * SEQ * QKD;
    const bf16_t* V = (const bf16_t*)(p.ws + WS_V) + (size_t)bh * VD * SEQ;
    float qv[QKD];
#pragma unroll
    for (int i = 0; i < QKD; ++i) qv[i] = bf2f(Q[i]);
    float o[VD];
#pragma unroll
    for (int i = 0; i < VD; ++i) o[i] = 0.f;
    float mx = -1e30f, l = 0.f;
    for (int k = 0; k < SEQ; ++k) {
        float s = 0.f;
#pragma unroll
        for (int i = 0; i < QKD; ++i) s += qv[i] * bf2f(K[(size_t)k * QKD + i]);
        const float mn = fmaxf(mx, s), al = exp2f(mx - mn), pr = exp2f(s - mn); mx = mn; l = l * al + pr;
#pragma unroll
        for (int i = 0; i < VD; ++i) o[i] = o[i] * al + pr * bf2f(V[(size_t)i * SEQ + k]);
    }
    const int b = bh >> 3, h = bh & 7; bf16_t* dst = (bf16_t*)(p.ws + WS_YATT) + ((size_t)(b * SEQ + q)) * 512 + h * VD;
#pragma unroll
    for (int i = 0; i < VD; ++i) dst[i] = f2bf(o[i] / l);
    }
}
DI void phase_hy_prep_naive(const P& p) {
    for (size_t idx = (size_t)o_bid() * NTHREADS + o_tid(); idx < (size_t)512 * MTOK; idx += (size_t)o_nb() * NTHREADS) {
    const int c = idx / MTOK, m = idx % MTOK, t = m & 2047;
    const bf16_t* uhT = (const bf16_t*)(p.ws + WS_Z);
    float r[3];
#pragma unroll
    for (int part = 0; part < 3; ++part) { const int ch = part * 512 + c; const bf16_t* row = uhT + (size_t)ch * MTOK + m;
        const float a = t > 0 ? bf2f(row[-1]) : 0.f, b = bf2f(row[0]), d = t < 2047 ? bf2f(row[1]) : 0.f;
        r[part] = a * p.sc_w[ch] + b * p.sc_w[1536 + ch] + d * p.sc_w[2 * 1536 + ch] + p.sc_b[ch]; }
    bf16_t* U = (bf16_t*)p.out; bf16_t* X0 = U + (size_t)512 * MTOK;
    U[idx] = f2bf(r[1] * r[2]); X0[idx] = f2bf(r[0]);
    }
}
DI void phase_hy_conv_naive(const P& p) {
    for (size_t idx = (size_t)o_bid() * NTHREADS + o_tid(); idx < (size_t)512 * MTOK; idx += (size_t)o_nb() * NTHREADS) {
    const int c = idx / MTOK, m = idx % MTOK, t = m & 2047, b = m >> 11;
    const bf16_t* U = (const bf16_t*)p.out + (size_t)c * MTOK + (size_t)b * SEQ; const bf16_t* X0 = (const bf16_t*)p.out + (size_t)512 * MTOK;
    const bf16_t* kr = (const bf16_t*)(p.ws + WS_KFIL) + (size_t)c * 4096;
    float acc = 0.f;
    for (int s = 0; s < SEQ; ++s) acc += bf2f(kr[2048 - t + s]) * bf2f(U[s]);
    const float y = bf2f(X0[idx]) * (acc + p.hy_bias[c] * bf2f(U[t]));
    ((bf16_t*)(p.ws + WS_YHT))[idx] = f2bf(y);
    }
}

#define XB_TMO      128
#define XB_XCNT(j)  (256  + 64 * (j))
#define XB_XSUB(j)  (1280 + 64 * (j))
#define XB_XGEN(j)  (2304 + 64 * (j))
#define XB_TOP      3328
#define XB_TOPGEN   3392
#define XCD_BAR_WORDS 3456
#define XB_SPIN_CAP (1u << 18)
DI unsigned xb_ld(unsigned* p)              { return __hip_atomic_load(p, __ATOMIC_RELAXED, __HIP_MEMORY_SCOPE_AGENT); }
DI unsigned xb_add(unsigned* p, unsigned v) { return __hip_atomic_fetch_add(p, v, __ATOMIC_RELAXED, __HIP_MEMORY_SCOPE_AGENT); }
DI unsigned xb_xcc_id() { return (unsigned)__builtin_amdgcn_s_getreg((3 << 11) | 20) & 0xFu; }
#define XB_SPIN(cond, bar) do { unsigned _sp = 0; while (cond) { __builtin_amdgcn_s_sleep(1); \
    if ((++_sp & 255u) == 0u) { if (xb_ld(&(bar)[XB_TMO])) break; if (_sp > XB_SPIN_CAP) { atomicAdd(&(bar)[XB_TMO], 1u); break; } } } } while (0)
struct XcdBarrier { unsigned* bar; unsigned x; volatile LAS unsigned* st; };
DI XcdBarrier xcd_barrier_post(unsigned* bar, volatile LAS unsigned* st) {
    XcdBarrier b; b.bar = bar; b.x = xb_xcc_id(); b.st = st;
    if (threadIdx.x == 0) (void)xb_add(&bar[XB_XCNT(b.x)], 1u);
    return b;
}
DI void xcd_barrier_complete(unsigned* bar, unsigned x, unsigned& nloc, unsigned& nx) {
    const unsigned G = gridDim.x * gridDim.y * gridDim.z;
    unsigned sum, cnt, mine, sp = 0u;
    for (;;) {
        sum = 0u; cnt = 0u; mine = 0u;
#pragma unroll
        for (unsigned j = 0; j < 16; ++j) { const unsigned c = xb_ld(&bar[XB_XCNT(j)]); sum += c; cnt += (c > 0u) ? 1u : 0u; mine = (j == x) ? c : mine; }
        if (sum == G) break;
        __builtin_amdgcn_s_sleep(1);
        if ((++sp & 255u) == 0u) { if (xb_ld(&bar[XB_TMO])) break; if (sp > XB_SPIN_CAP) { atomicAdd(&bar[XB_TMO], 1u); break; } }
    }
    nloc = mine > 0u ? mine : 1u; nx = cnt > 0u ? cnt : 1u;
}
DI void xcd_barrier(const XcdBarrier& b) {
    asm volatile("s_waitcnt vmcnt(0)" ::: "memory");
    __syncthreads();
    if (threadIdx.x == 0) {
        unsigned* bar = b.bar;
        __builtin_amdgcn_s_waitcnt(0);
        unsigned nloc = b.st[0], nx = b.st[1];
        if (nloc == 0u) { xcd_barrier_complete(bar, b.x, nloc, nx); b.st[0] = nloc; b.st[1] = nx; }
        const unsigned old = xb_add(&bar[XB_XSUB(b.x)], 1u);
        const unsigned gen = old / nloc;
        if (old + 1u == (gen + 1u) * nloc) {
            __builtin_amdgcn_fence(__ATOMIC_RELEASE, "agent");
            asm volatile("s_waitcnt vmcnt(0)" ::: "memory");
            const unsigned og = xb_add(&bar[XB_TOP], 1u);
            const unsigned tg = og / nx;
            if (og + 1u == (tg + 1u) * nx) xb_add(&bar[XB_TOPGEN], 1u);
            else XB_SPIN(xb_ld(&bar[XB_TOPGEN]) == tg, bar);
            __builtin_amdgcn_fence(__ATOMIC_ACQUIRE, "agent");
            xb_add(&bar[XB_XGEN(b.x)], 1u);
            asm volatile("s_waitcnt vmcnt(0)" ::: "memory");
        } else {
            XB_SPIN(xb_ld(&bar[XB_XGEN(b.x)]) == gen, bar);
            __builtin_amdgcn_fence(__ATOMIC_ACQUIRE, "agent");
            asm volatile("s_waitcnt vmcnt(0)" ::: "memory");
        }
    }
    __syncthreads();
}

enum { PH_PREP = 0, PH_G1, PH_G23, PH_HYP, PH_HYC, PH_QKPREP, PH_ATTN, PH_MIX, PH_G4, PH_G5, PH_G6, PH_G7, PH_COUNT };
DI void run_phase(const P& p, int ph, int dry = 0) {
    extern __shared__ __attribute__((aligned(16))) unsigned char shm[];
    switch (ph) {
        case PH_PREP: phase_prep(p, (LAS unsigned char*)shm); break;
        case PH_G1: phase_g1(p, (LAS unsigned char*)shm, dry); break;
#if NAIVE_HYENA
        case PH_G23: phase_g23(p, (LAS unsigned char*)shm); break;
#else
        case PH_G23: phase_g23(p, (LAS unsigned char*)shm); phase_hyena(p, (LAS unsigned char*)shm); break;
#endif
        case PH_QKPREP: phase_qkprep(p); phase_mixprep(p, shm); break;
        case PH_HYP: phase_hy_prep_naive(p); break;
        case PH_HYC: phase_hy_conv_naive(p); break;
#if NAIVE_ATTN
        case PH_ATTN: phase_attn_naive(p); break;
#else
        case PH_ATTN: phase_attn(p, (LAS unsigned char*)shm); break;
#endif
        case PH_MIX: break;
        case PH_G4: phase_g4(p, (LAS unsigned char*)shm, dry); break;
        case PH_G5: phase_g5(p, (LAS unsigned char*)shm); break;
        case PH_G6: phase_g6(p, (LAS unsigned char*)shm, dry); break;
        case PH_G7: phase_g7(p, (LAS unsigned char*)shm, dry); break;
    }
}
template <int PH> __global__ void __launch_bounds__(NTHREADS, 2) k_multi(P p) {
    run_phase(p, PH);
}
template <int PH> static void launch_phase(const P& p, int grid, hipStream_t stream) {
    static bool attr = false;
    if (!attr) { hipFuncSetAttribute((const void*)k_multi<PH>, hipFuncAttributeMaxDynamicSharedMemorySize, LDS_BYTES); attr = true; }
    hipLaunchKernelGGL(k_multi<PH>, dim3(grid), dim3(NTHREADS), LDS_BYTES, stream, p);
}
__global__ void __launch_bounds__(NTHREADS, 2) k_mega(P p) {
    cg::grid_group grid = cg::this_grid();
    extern __shared__ __attribute__((aligned(16))) unsigned char shm_top[];
    volatile LAS unsigned* st = (volatile LAS unsigned*)((LAS unsigned char*)shm_top + LDS_BYTES - 16);
    if (threadIdx.x == 0) { st[0] = 0u; st[1] = 0u; }
    __syncthreads();
    const XcdBarrier bar = xcd_barrier_post((unsigned*)(p.ws + WS_BAR), st);
#define GSYNC() xcd_barrier(bar)
#define RUNP(ph) do { run_phase(p, ph, 0); if (PROBE_REP == (ph)) { GSYNC(); run_phase(p, ph, 1); } } while (0)
    if (p.ws == nullptr) grid.sync();
    RUNP(PH_PREP); GSYNC();
    RUNP(PH_G1); GSYNC();
    RUNP(PH_G23); GSYNC();
    if (PROBE_REP == 100) { extern __shared__ __attribute__((aligned(16))) unsigned char shm_h[]; phase_hyena(p, (LAS unsigned char*)shm_h); GSYNC(); }
#if NAIVE_HYENA
    run_phase(p, PH_HYP); GSYNC();
    run_phase(p, PH_HYC); GSYNC();
#endif
    RUNP(PH_QKPREP); GSYNC();
    RUNP(PH_ATTN); GSYNC();
    RUNP(PH_G4); GSYNC();
    RUNP(PH_G5); GSYNC();
    RUNP(PH_G6); GSYNC();
    RUNP(PH_G7);
}

extern "C" void kernel_launch(void* const* d_in, const int* in_sizes, int n_in, void* d_out, int out_size, void* d_ws, size_t ws_size, hipStream_t stream) {
    static int grid = 0;
    if (grid == 0) {
        int dev = 0, cus = 0, per_cu = 0;
        hipGetDevice(&dev); hipDeviceGetAttribute(&cus, hipDeviceAttributeMultiprocessorCount, dev);
        if (cus <= 0) cus = 256;
        grid = cus;
#if N_LAUNCH_MODE == 1
        hipFuncSetAttribute((const void*)k_mega, hipFuncAttributeMaxDynamicSharedMemorySize, LDS_BYTES);
        hipOccupancyMaxActiveBlocksPerMultiprocessor(&per_cu, (const void*)k_mega, NTHREADS, LDS_BYTES);
        if (per_cu < 1) { fprintf(stderr, "kernel_launch: occupancy query says %d blocks/CU\n", per_cu); per_cu = 1; }
        grid = cus;
#endif
        if (ws_size < 256 * MiB) fprintf(stderr, "kernel_launch: workspace too small: %zu\n", ws_size);
    }
    P p{};
    const float** pp = (const float**)&p;
    for (int i = 0; i < 32; ++i) pp[i] = (const float*)d_in[i];
    p.out = (float*)d_out; p.ws = (unsigned char*)d_ws;
#if N_LAUNCH_MODE == 1
    hipMemsetAsync((unsigned char*)d_ws + WS_BAR, 0, XCD_BAR_WORDS * 4, stream);
    void* args[] = {&p};
    hipError_t e = hipLaunchCooperativeKernel((const void*)k_mega, dim3(grid), dim3(NTHREADS), args, LDS_BYTES, stream);
    if (e != hipSuccess) fprintf(stderr, "cooperative launch failed: %s (grid %d)\n", hipGetErrorString(e), grid);
#else
    launch_phase<PH_PREP>(p, grid, stream);
    launch_phase<PH_G1>(p, grid, stream);
    launch_phase<PH_G23>(p, grid, stream);
    launch_phase<PH_HYP>(p, grid, stream);
    launch_phase<PH_HYC>(p, grid, stream);
    launch_phase<PH_QKPREP>(p, grid, stream);
    launch_phase<PH_ATTN>(p, grid, stream);
    launch_phase<PH_MIX>(p, grid, stream);
    launch_phase<PH_G4>(p, grid, stream);
    launch_phase<PH_G5>(p, grid, stream);
    launch_phase<PH_G6>(p, grid, stream);
    launch_phase<PH_G7>(p, grid, stream);
#endif
}
```

```cpp
#include <hip/hip_runtime.h>
#include <hip/hip_cooperative_groups.h>
#include <cstdio>
namespace cg = cooperative_groups;

#ifndef N_LAUNCH_MODE
#define N_LAUNCH_MODE 1
#endif
#ifndef PROBE_REP
#define PROBE_REP -1
#endif
#ifndef NAIVE_ATTN
#define NAIVE_ATTN 0
#endif
#ifndef NAIVE_HYENA
#define NAIVE_HYENA 0
#endif

typedef unsigned short bf16_t;
typedef short bf16x8 __attribute__((ext_vector_type(8)));
typedef float f32x4 __attribute__((ext_vector_type(4)));
typedef float f32x16 __attribute__((ext_vector_type(16)));
typedef unsigned u32x4 __attribute__((ext_vector_type(4)));
typedef unsigned u32x2 __attribute__((ext_vector_type(2)));
#define LAS __attribute__((address_space(3)))
#define DI __device__ __forceinline__

constexpr int MTOK = 16384, SEQ = 2048, NB = 8, DM = 1024, PLE = 256;
constexpr int NH = 8, QKD = 96, NOPE = 64, ROPE = 32, VD = 64, QL = 768, KVL = 256;
constexpr int HYW = 512, INW = 2592, INWP = 2816, MLAW = 1056, DFF = 2816;
constexpr float EPS = 1e-6f;
constexpr int NTHREADS = 512;
constexpr int LDS_BYTES = 160 * 1024 - 4096;

constexpr size_t MiB = 1024 * 1024;
constexpr size_t WS_WIN = 0;
constexpr size_t WS_WUQ = WS_WIN + (size_t)INWP * DM * 2;
constexpr size_t WS_WUKV = WS_WUQ + (size_t)QL * QL * 2;
constexpr size_t WS_WOUT = WS_WUKV + (size_t)1024 * KVL * 2;
constexpr size_t WS_WUP = WS_WOUT + (size_t)DM * DM * 2;
constexpr size_t WS_WDOWN = WS_WUP + (size_t)2 * DFF * DM * 2;
constexpr size_t WS_WPLE = WS_WDOWN + (size_t)DM * DFF * 2;
constexpr size_t WS_WGATE = WS_WPLE + (size_t)DM * PLE * 2;
constexpr size_t WS_WEND = WS_WGATE + (size_t)DM * DM * 2;
static_assert(WS_WEND <= 29 * MiB, "weights");
constexpr size_t WS_STATS = 29 * MiB;
constexpr size_t WS_BAR = 29 * MiB + 512 * 1024;
constexpr size_t WS_KFIL = 30 * MiB;
constexpr size_t WS_PB = 34 * MiB;
constexpr size_t WS_X = 42 * MiB;
constexpr size_t WS_Y = 75 * MiB;
constexpr size_t WS_Z = 109 * MiB;
constexpr size_t WS_Q = 157 * MiB;
constexpr size_t WS_K = 181 * MiB;
constexpr size_t WS_V = 205 * MiB;
constexpr size_t WS_YHT = 221 * MiB;
constexpr size_t WS_YATT = 237 * MiB;
constexpr size_t WS_SSQAH = 253 * MiB;
constexpr size_t WS_ACT = 141 * MiB;
constexpr size_t WS_KRAW2 = WS_YATT;

struct P {
    const float *x, *p, *norm_mix, *w_in, *sc_w, *sc_b, *q_norm, *w_uq, *kv_norm, *w_ukv, *qk_nq, *qk_nk,
        *f_w1, *f_b1, *f_w2, *f_b2, *f_w3, *f_b3, *f_wout, *f_freq, *hy_bias, *on_attn, *on_hy, *w_out,
        *norm_ffn, *w_up, *fc_w, *fc_b, *w_down, *w_ple, *w_gate, *ple_norm;
    float* out; unsigned char* ws;
};

DI int o_tid() { int t = threadIdx.x; asm volatile("" : "+v"(t)); return t; }
DI int o_bid() { int t = blockIdx.x; asm volatile("" : "+s"(t)); return t; }
DI int o_nb() { int t = gridDim.x; asm volatile("" : "+s"(t)); return t; }
DI bf16_t f2bf(float f) { unsigned u = __float_as_uint(f); u += 0x7FFFu + ((u >> 16) & 1u); return (bf16_t)(u >> 16); }
DI float bf2f(bf16_t b) { return __uint_as_float(((unsigned)b) << 16); }
typedef __bf16 bf16x2_t __attribute__((ext_vector_type(2)));
typedef float f32x2_t __attribute__((ext_vector_type(2)));
DI unsigned pkbf(float a, float b) { f32x2_t f = {a, b}; bf16x2_t h = __builtin_convertvector(f, bf16x2_t); return __builtin_bit_cast(unsigned, h); }
DI unsigned pk2(float lo, float hi) { return (unsigned)f2bf(lo) | ((unsigned)f2bf(hi) << 16); }
DI float lo2f(unsigned w) { return __uint_as_float(w << 16); }
DI float hi2f(unsigned w) { return __uint_as_float(w & 0xffff0000u); }

namespace pg8 {
constexpr int BM = 256, BK = 64, HALF = 128, HTB = HALF * BK * 2, STAGE_BYTES = 8 * HTB, NXCD = 8, WGM = 8;
__host__ __device__ __forceinline__ int lds_byte(int r, int c) { const int st = (r >> 4) * 2 + (c >> 5), rr = r & 15, cc = c & 31, ob = rr * 64 + cc * 2; return st * 1024 + (ob ^ (((ob >> 9) & 1) << 5)); }
__host__ __device__ __forceinline__ void stage_rc(int b, int& R, int& C) { const int st = b / 1024, sb = b % 1024, swz = sb ^ (((sb >> 9) & 1) << 5); R = (st >> 1) * 16 + swz / 64; C = (st & 1) * 32 + (swz % 64) / 2; }
__host__ __device__ __forceinline__ int perm32(int rho) { const int n = rho >> 4, i = rho & 15; return 8 * (i >> 2) + 4 * n + (i & 3); }
struct Unit { int pm, pn; };
struct Gemm { const bf16_t* A; const bf16_t* Bt; int K, lda, nM, nN, TS, GS; int ldb = 0; int rperm = 0; int permB = 1; };
struct StaticOrder {
    int nM, nN, nwg, G, c;
    __host__ __device__ void init(int nM_, int nN_, int G_, int c_) { nM = nM_; nN = nN_; nwg = nM * nN; G = G_; c = c_; }
    __host__ __device__ bool next(int i, Unit& u) const {
        const long L = (long)i * G + c; if (L >= nwg) return false;
        int wgid = (int)L; { const int q = nwg / NXCD, r = nwg % NXCD, xcd = wgid % NXCD, off = wgid / NXCD; wgid = (xcd < r ? xcd * (q + 1) : r * (q + 1) + (xcd - r) * q) + off; }
        const int nig = WGM * nN, gid = wgid / nig, fm = gid * WGM, gsz = (nM - fm) < WGM ? (nM - fm) : WGM;
        u.pm = fm + ((wgid % nig) % gsz); u.pn = (wgid % nig) / gsz; return true;
    }
};
DI unsigned cvt_pk_bf16(float lo, float hi) { unsigned r; asm volatile("v_cvt_pk_bf16_f32 %0, %1, %2" : "=v"(r) : "v"(lo), "v"(hi)); return r; }

template <class Epi>
__device__ __forceinline__ void gemm_phase(LAS unsigned char* lds, const Gemm g, const StaticOrder& S, const Epi& E) {
    const int tid = o_tid(), wid = __builtin_amdgcn_readfirstlane(tid >> 6), lane = tid & 63, wr = wid >> 2, wc = wid & 3, fr = lane & 15, fq = lane >> 4;
    const int K = g.K, nt = K / BK, ldb = g.ldb ? g.ldb : K;
    unsigned voffA[2], voffB[2];
#pragma unroll
    for (int i = 0; i < 2; ++i) { int R, C; stage_rc(tid * 16 + i * 8192, R, C);
        const int rs = g.rperm ? (4 * (R & 15) + ((R >> 4) & 3)) : (R & 63);
        voffA[i] = (unsigned)(((R >> 6) * g.GS + rs) * g.lda + C) * 2u; const int Rb = g.permB ? ((R & ~31) + perm32(R & 31)) : R; voffB[i] = (unsigned)(Rb * ldb + C) * 2u; }
    const size_t kstep = (size_t)(BK * 2);
    const size_t hstepA = (size_t)(2 * g.GS) * g.lda * 2, tstepA = (size_t)g.TS * g.lda * 2;
    const size_t hstepB = (size_t)HALF * ldb * 2, tstepB = 2 * hstepB;
    const unsigned ldsw = (unsigned)wid * 1024u;
    const int aoff = lds_byte(wr * 64 + fr, fq * 8), boff = lds_byte(wc * 32 + fr, fq * 8);
#define PG8_SA(b, h) (((b) * 2 + (h)) * HTB)
#define PG8_SB(b, h) ((4 + (b) * 2 + (h)) * HTB)
#define PG8_STAGE(bufoff, gbase, voff) do { _Pragma("unroll") for (int _i = 0; _i < 2; ++_i) \
        __builtin_amdgcn_global_load_lds((const unsigned*)((const char*)(gbase) + (voff)[_i]), (LAS unsigned*)(lds + (bufoff) + ldsw + _i * 8192), 16, 0, 0); } while (0)
#define PG8_LDA(dst, b, h) do { _Pragma("unroll") for (int m = 0; m < 4; ++m) _Pragma("unroll") for (int k = 0; k < 2; ++k) dst[m][k] = *(const LAS bf16x8*)(lds + PG8_SA(b, h) + aoff + m * 2048 + k * 1024); } while (0)
#define PG8_LDB(dst, b, h) do { _Pragma("unroll") for (int n = 0; n < 2; ++n) _Pragma("unroll") for (int k = 0; k < 2; ++k) dst[n][k] = *(const LAS bf16x8*)(lds + PG8_SB(b, h) + boff + n * 2048 + k * 1024); } while (0)
#define PG8_MMA(ai, bj, At, Bt) do { __builtin_amdgcn_s_setprio(1); _Pragma("unroll") for (int m = 0; m < 4; ++m) _Pragma("unroll") for (int n = 0; n < 2; ++n) _Pragma("unroll") for (int k = 0; k < 2; ++k) \
        acc[ai][bj][m][n] = __builtin_amdgcn_mfma_f32_16x16x32_bf16(Bt[n][k], At[m][k], acc[ai][bj][m][n], 0, 0, 0); __builtin_amdgcn_s_setprio(0); } while (0)
#define PG8_WAIT_V(n) asm volatile("s_waitcnt vmcnt(" #n ")" ::: "memory")
#define PG8_WAIT_L(n) asm volatile("s_waitcnt lgkmcnt(" #n ")" ::: "memory")
#define PG8_BAR __builtin_amdgcn_s_barrier()
#define PG8_SCHED __builtin_amdgcn_sched_barrier(0)
    Unit cur, nxt; int ui = 0;
    if (!S.next(0, cur)) return;
    f32x4 acc[2][2][4][2];
    if constexpr (Epi::PREFETCH) E.prefetch(cur, wr, wc, lane);
    if constexpr (Epi::INIT) E.init(acc, cur, wr, wc, fr, fq);
    else {
#pragma unroll
    for (int a = 0; a < 2; ++a)
#pragma unroll
        for (int b = 0; b < 2; ++b)
#pragma unroll
            for (int m = 0; m < 4; ++m)
#pragma unroll
                for (int n = 0; n < 2; ++n) acc[a][b][m][n] = (f32x4){0.f, 0.f, 0.f, 0.f};
    }
    bf16x8 At[4][2], B0[2][2], B1[2][2];
    const char* cA = (const char*)g.A + (size_t)cur.pm * tstepA; const char* cB = (const char*)g.Bt + (size_t)cur.pn * tstepB;
    PG8_STAGE(PG8_SB(0, 0), cB, voffB); PG8_STAGE(PG8_SA(0, 0), cA, voffA); PG8_STAGE(PG8_SB(0, 1), cB + hstepB, voffB); PG8_STAGE(PG8_SA(0, 1), cA + hstepA, voffA);
    if (wr == 1) PG8_BAR;
    PG8_WAIT_V(4); PG8_BAR;
    PG8_STAGE(PG8_SB(1, 0), cB + kstep, voffB); PG8_STAGE(PG8_SA(1, 0), cA + kstep, voffA); PG8_STAGE(PG8_SB(1, 1), cB + hstepB + kstep, voffB);
    PG8_WAIT_V(6); PG8_BAR;
    for (;;) {
        const bool has_next = S.next(ui + 1, nxt);
        const char* nA = has_next ? (const char*)g.A + (size_t)nxt.pm * tstepA : cA; const char* nB = has_next ? (const char*)g.Bt + (size_t)nxt.pn * tstepB : cB;
        for (int t = 0; t < nt; t += 2) {
            const bool last = (t == nt - 2);
            if constexpr (Epi::MIDSCALE) { if (t == Epi::MID_T) E.mid(acc, cur, wr, wc, fr, fq); }
            const char* a1 = cA + (size_t)(t + 1) * kstep;
            const char* a2 = last ? nA : cA + (size_t)(t + 2) * kstep; const char* b2 = last ? nB : cB + (size_t)(t + 2) * kstep;
            const char* a3 = a2 + kstep; const char* b3 = b2 + kstep;
            PG8_LDB(B0, 0, 0); PG8_SCHED; PG8_LDA(At, 0, 0); PG8_STAGE(PG8_SA(1, 1), a1 + hstepA, voffA);
            PG8_WAIT_L(8); PG8_BAR; PG8_WAIT_L(0); PG8_MMA(0, 0, At, B0); PG8_BAR; PG8_SCHED;
            PG8_LDB(B1, 0, 1); PG8_STAGE(PG8_SB(0, 0), b2, voffB);
            PG8_BAR; PG8_WAIT_L(0); PG8_MMA(0, 1, At, B1); PG8_BAR;
            PG8_LDA(At, 0, 1); PG8_STAGE(PG8_SA(0, 0), a2, voffA);
            PG8_BAR; PG8_WAIT_L(0); PG8_MMA(1, 0, At, B0); PG8_BAR; PG8_SCHED;
            PG8_STAGE(PG8_SB(0, 1), b2 + hstepB, voffB);
            PG8_WAIT_V(6); PG8_BAR; PG8_MMA(1, 1, At, B1); PG8_BAR;
            PG8_LDB(B0, 1, 0); PG8_SCHED; PG8_LDA(At, 1, 0); PG8_STAGE(PG8_SA(0, 1), a2 + hstepA, voffA);
            PG8_WAIT_L(8); PG8_BAR; PG8_WAIT_L(0); PG8_MMA(0, 0, At, B0); PG8_BAR; PG8_SCHED;
            PG8_LDB(B1, 1, 1); PG8_STAGE(PG8_SB(1, 0), b3, voffB);
            PG8_BAR; PG8_WAIT_L(0); PG8_MMA(0, 1, At, B1); PG8_BAR;
            PG8_LDA(At, 1, 1); PG8_STAGE(PG8_SA(1, 0), a3, voffA);
            PG8_BAR; PG8_WAIT_L(0); PG8_MMA(1, 0, At, B0); PG8_BAR; PG8_SCHED;
            PG8_STAGE(PG8_SB(1, 1), b3 + hstepB, voffB);
            PG8_WAIT_V(6); PG8_BAR; PG8_MMA(1, 1, At, B1); PG8_BAR;
        }
        E(acc, cur, wr, wc, fr, fq);
        if (!has_next) break;
        if constexpr (Epi::PREFETCH) E.prefetch(nxt, wr, wc, lane);
        if constexpr (Epi::INIT) E.init(acc, nxt, wr, wc, fr, fq);
        else {
#pragma unroll
        for (int a = 0; a < 2; ++a)
#pragma unroll
            for (int b = 0; b < 2; ++b)
#pragma unroll
                for (int m = 0; m < 4; ++m)
#pragma unroll
                    for (int n = 0; n < 2; ++n) acc[a][b][m][n] = (f32x4){0.f, 0.f, 0.f, 0.f};
        }
        cur = nxt; cA = nA; cB = nB; ++ui;
    }
    PG8_WAIT_V(0);
    if (wr == 0) PG8_BAR;
    PG8_BAR;
#undef PG8_SA
#undef PG8_SB
#undef PG8_STAGE
#undef PG8_LDA
#undef PG8_LDB
#undef PG8_MMA
#undef PG8_WAIT_V
#undef PG8_WAIT_L
#undef PG8_BAR
#undef PG8_SCHED
}
}
typedef f32x4 Acc[2][2][4][2];

struct EpiProj {
    static constexpr bool MIDSCALE = false;
    static constexpr bool PREFETCH = false;
    static constexpr bool INIT = false;
    bf16_t* projm; const float* rs1; float* ssq_q; float* ssq_kv; int dry;
    DI void operator()(const Acc& acc, const pg8::Unit& u, int wr, int wc, int fr, int fq) const {
        asm volatile("" : "+v"(fr), "+v"(fq));
        float rsv[2][4];
#pragma unroll
        for (int ai = 0; ai < 2; ++ai)
#pragma unroll
            for (int m = 0; m < 4; ++m) rsv[ai][m] = rs1[u.pm * 256 + ai * 128 + wr * 64 + m * 16 + fr];
#pragma unroll
        for (int ai = 0; ai < 2; ++ai)
#pragma unroll
            for (int m = 0; m < 4; ++m) {
                const int row = u.pm * 256 + ai * 128 + wr * 64 + m * 16 + fr; const float rs = rsv[ai][m]; float ss = 0.f;
#pragma unroll
                for (int bj = 0; bj < 2; ++bj)
                    { const int c0 = u.pn * 256 + bj * 128 + wc * 32 + 8 * fq; const f32x4 v0 = acc[ai][bj][m][0] * rs, v1 = acc[ai][bj][m][1] * rs;
                        if (c0 < MLAW) { u32x4 w; w.x = pkbf(v0[0], v0[1]); w.y = pkbf(v0[2], v0[3]); w.z = pkbf(v1[0], v1[1]); w.w = pkbf(v1[2], v1[3]); *(u32x4*)(projm + (size_t)row * MLAW + c0) = w;
                            ss += v0[0] * v0[0] + v0[1] * v0[1] + v0[2] * v0[2] + v0[3] * v0[3] + v1[0] * v1[0] + v1[1] * v1[1] + v1[2] * v1[2] + v1[3] * v1[3]; }
                    }
                if (u.pn <= 3 && !dry) { ss += __shfl_xor(ss, 16); ss += __shfl_xor(ss, 32); if (fq == 0) atomicAdd((u.pn < 3 ? ssq_q : ssq_kv) + row, ss); }
            }
    }
};
struct EpiHyT {
    static constexpr bool MIDSCALE = false;
    static constexpr bool PREFETCH = false;
    static constexpr bool INIT = false;
    bf16_t* uhT; const float* rs1;
    DI void operator()(const Acc& acc, const pg8::Unit& u, int wr, int wc, int fr, int fq) const {
        asm volatile("" : "+v"(fr), "+v"(fq));
        f32x4 rsv[2][2];
#pragma unroll
        for (int bj = 0; bj < 2; ++bj)
#pragma unroll
            for (int n = 0; n < 2; ++n) rsv[bj][n] = *(const f32x4*)(rs1 + u.pn * 256 + bj * 128 + wc * 32 + 8 * fq + 4 * n);
#pragma unroll
        for (int ai = 0; ai < 2; ++ai)
#pragma unroll
            for (int m = 0; m < 4; ++m) {
                const int ch = u.pm * 256 + ai * 128 + wr * 64 + m * 16 + fr;
#pragma unroll
                for (int bj = 0; bj < 2; ++bj)
                    { const int c0 = u.pn * 256 + bj * 128 + wc * 32 + 8 * fq; const f32x4 v0 = acc[ai][bj][m][0] * rsv[bj][0], v1 = acc[ai][bj][m][1] * rsv[bj][1];
                        u32x4 w; w.x = pkbf(v0[0], v0[1]); w.y = pkbf(v0[2], v0[3]); w.z = pkbf(v1[0], v1[1]); w.w = pkbf(v1[2], v1[3]); *(u32x4*)(uhT + (size_t)ch * MTOK + c0) = w; }
            }
    }
};
struct EpiQ {
    static constexpr bool MIDSCALE = false;
    static constexpr bool PREFETCH = false;
    static constexpr bool INIT = false;
    bf16_t* qraw; const float* ssq_q;
    DI void operator()(const Acc& acc, const pg8::Unit& u, int wr, int wc, int fr, int fq) const {
        asm volatile("" : "+v"(fr), "+v"(fq));
        float rsv[2][4];
#pragma unroll
        for (int ai = 0; ai < 2; ++ai)
#pragma unroll
            for (int m = 0; m < 4; ++m) rsv[ai][m] = ssq_q[u.pm * 256 + ai * 128 + wr * 64 + m * 16 + fr];
#pragma unroll
        for (int ai = 0; ai < 2; ++ai)
#pragma unroll
            for (int m = 0; m < 4; ++m) {
                const int row = u.pm * 256 + ai * 128 + wr * 64 + m * 16 + fr; const float rs = rsqrtf(rsv[ai][m] * (1.0f / QL) + EPS);
#pragma unroll
                for (int bj = 0; bj < 2; ++bj)
                    { const int c0 = u.pn * 256 + bj * 128 + wc * 32 + 8 * fq; const f32x4 v0 = acc[ai][bj][m][0] * rs, v1 = acc[ai][bj][m][1] * rs;
                        u32x4 w; w.x = pkbf(v0[0], v0[1]); w.y = pkbf(v0[2], v0[3]); w.z = pkbf(v1[0], v1[1]); w.w = pkbf(v1[2], v1[3]); *(u32x4*)(qraw + (size_t)row * QL + c0) = w; }
                asm volatile("" ::: "memory");
            }
    }
};
struct EpiK {
    static constexpr bool MIDSCALE = false;
    static constexpr bool PREFETCH = false;
    static constexpr bool INIT = false;
    bf16_t* kraw; const float* ssq_kv;
    DI void operator()(const Acc& acc, const pg8::Unit& u, int wr, int wc, int fr, int fq) const {
        asm volatile("" : "+v"(fr), "+v"(fq));
        float rsv[2][4];
#pragma unroll
        for (int ai = 0; ai < 2; ++ai)
#pragma unroll
            for (int m = 0; m < 4; ++m) rsv[ai][m] = ssq_kv[u.pm * 256 + ai * 128 + wr * 64 + m * 16 + fr];
#pragma unroll
        for (int ai = 0; ai < 2; ++ai)
#pragma unroll
            for (int m = 0; m < 4; ++m) {
                const int row = u.pm * 256 + ai * 128 + wr * 64 + m * 16 + fr; const float rs = rsqrtf(rsv[ai][m] * (1.0f / KVL) + EPS);
#pragma unroll
                for (int bj = 0; bj < 2; ++bj)
                    { const int c0 = u.pn * 256 + bj * 128 + wc * 32 + 8 * fq; const f32x4 v0 = acc[ai][bj][m][0] * rs, v1 = acc[ai][bj][m][1] * rs;
                        u32x4 w; w.x = pkbf(v0[0], v0[1]); w.y = pkbf(v0[2], v0[3]); w.z = pkbf(v1[0], v1[1]); w.w = pkbf(v1[2], v1[3]); *(u32x4*)(kraw + (size_t)row * 512 + c0) = w; }
            }
    }
};
struct EpiVT {
    static constexpr bool MIDSCALE = false;
    static constexpr bool PREFETCH = false;
    static constexpr bool INIT = false;
    bf16_t* vt; const float* ssq_kv;
    DI void operator()(const Acc& acc, const pg8::Unit& u, int wr, int wc, int fr, int fq) const {
        asm volatile("" : "+v"(fr), "+v"(fq));
        f32x4 rsv[2][2];
#pragma unroll
        for (int bj = 0; bj < 2; ++bj)
#pragma unroll
            for (int n = 0; n < 2; ++n) { const f32x4 q = *(const f32x4*)(ssq_kv + u.pn * 256 + bj * 128 + wc * 32 + 8 * fq + 4 * n);
#pragma unroll
                for (int j = 0; j < 4; ++j) rsv[bj][n][j] = rsqrtf(q[j] * (1.0f / KVL) + EPS); }
#pragma unroll
        for (int ai = 0; ai < 2; ++ai)
#pragma unroll
            for (int m = 0; m < 4; ++m) {
                const int ch = u.pm * 256 + ai * 128 + wr * 64 + m * 16 + fr;
#pragma unroll
                for (int bj = 0; bj < 2; ++bj)
                    { const int c0 = u.pn * 256 + bj * 128 + wc * 32 + 8 * fq, b = c0 >> 11, s0 = c0 & 2047; const f32x4 v0 = acc[ai][bj][m][0] * rsv[bj][0], v1 = acc[ai][bj][m][1] * rsv[bj][1];
                        u32x4 w; w.x = pkbf(v0[0], v0[1]); w.y = pkbf(v0[2], v0[3]); w.z = pkbf(v1[0], v1[1]); w.w = pkbf(v1[2], v1[3]); *(u32x4*)(vt + ((size_t)b * 512 + ch) * SEQ + s0) = w; }
            }
    }
};
struct EpiOut {
    static constexpr bool MIDSCALE = true;
    static constexpr bool PREFETCH = false;
    static constexpr bool INIT = true;
    static constexpr int MID_T = 8;
    const bf16_t* xb; bf16_t* x1b; float* ssq2; const float* ssq_a; int dry;
    DI void mid(Acc& acc, const pg8::Unit& u, int wr, int wc, int fr, int fq) const {
        asm volatile("" : "+v"(fr), "+v"(fq));
#pragma unroll
        for (int ai = 0; ai < 2; ++ai)
#pragma unroll
            for (int m = 0; m < 4; ++m) { const f32x4* q = (const f32x4*)(ssq_a + (size_t)(u.pm * 256 + ai * 128 + wr * 64 + m * 16 + fr) * NH); const f32x4 q0 = q[0], q1 = q[1];
                const float rs = rsqrtf(((q0[0] + q0[1]) + (q0[2] + q0[3]) + (q1[0] + q1[1]) + (q1[2] + q1[3])) * (1.0f / 512) + EPS);
#pragma unroll
                for (int bj = 0; bj < 2; ++bj)
#pragma unroll
                    for (int n = 0; n < 2; ++n) acc[ai][bj][m][n] *= rs; }
    }
    DI void init(Acc& acc, const pg8::Unit& u, int wr, int wc, int fr, int fq) const {
        asm volatile("" : "+v"(fr), "+v"(fq));
#pragma unroll
        for (int ai = 0; ai < 2; ++ai)
#pragma unroll
            for (int m = 0; m < 4; ++m) { const int row = u.pm * 256 + ai * 128 + wr * 64 + m * 16 + fr; const f32x4* q = (const f32x4*)(ssq_a + (size_t)row * NH); const f32x4 q0 = q[0], q1 = q[1];
                const float ir = sqrtf(((q0[0] + q0[1]) + (q0[2] + q0[3]) + (q1[0] + q1[1]) + (q1[2] + q1[3])) * (1.0f / 512) + EPS);
#pragma unroll
                for (int bj = 0; bj < 2; ++bj)
                    { const u32x4 w = *(const u32x4*)(xb + (size_t)row * DM + u.pn * 256 + bj * 128 + wc * 32 + 8 * fq);
                        acc[ai][bj][m][0] = (f32x4){lo2f(w.x), hi2f(w.x), lo2f(w.y), hi2f(w.y)} * ir; acc[ai][bj][m][1] = (f32x4){lo2f(w.z), hi2f(w.z), lo2f(w.w), hi2f(w.w)} * ir; } }
    }
    DI void operator()(const Acc& acc, const pg8::Unit& u, int wr, int wc, int fr, int fq) const {
        asm volatile("" : "+v"(fr), "+v"(fq));
#pragma unroll
        for (int ai = 0; ai < 2; ++ai)
#pragma unroll
            for (int m = 0; m < 4; ++m) {
                const int row = u.pm * 256 + ai * 128 + wr * 64 + m * 16 + fr; float ss = 0.f;
#pragma unroll
                for (int bj = 0; bj < 2; ++bj)
                    { const int c0 = u.pn * 256 + bj * 128 + wc * 32 + 8 * fq; const size_t o = (size_t)row * DM + c0;
                        const f32x4 v0 = acc[ai][bj][m][0], v1 = acc[ai][bj][m][1];
                        u32x4 w; w.x = pkbf(v0[0], v0[1]); w.y = pkbf(v0[2], v0[3]); w.z = pkbf(v1[0], v1[1]); w.w = pkbf(v1[2], v1[3]); *(u32x4*)(x1b + o) = w;
                        ss += v0[0] * v0[0] + v0[1] * v0[1] + v0[2] * v0[2] + v0[3] * v0[3] + v1[0] * v1[0] + v1[1] * v1[1] + v1[2] * v1[2] + v1[3] * v1[3]; }
                ss += __shfl_xor(ss, 16); ss += __shfl_xor(ss, 32); if (fq == 0 && !dry) atomicAdd(ssq2 + row, ss);
            }
    }
};
struct EpiPle {
    static constexpr bool MIDSCALE = false;
    static constexpr bool PREFETCH = false;
    static constexpr bool INIT = false;
    bf16_t* eraw; float* ssq_e; int dry;
    DI void operator()(const Acc& acc, const pg8::Unit& u, int wr, int wc, int fr, int fq) const {
        asm volatile("" : "+v"(fr), "+v"(fq));
#pragma unroll
        for (int ai = 0; ai < 2; ++ai)
#pragma unroll
            for (int m = 0; m < 4; ++m) {
                const int row = u.pm * 256 + ai * 128 + wr * 64 + m * 16 + fr; float ss = 0.f;
#pragma unroll
                for (int bj = 0; bj < 2; ++bj)
                    { const int c0 = u.pn * 256 + bj * 128 + wc * 32 + 8 * fq; const f32x4 v0 = acc[ai][bj][m][0], v1 = acc[ai][bj][m][1];
                        u32x4 w; w.x = pkbf(v0[0], v0[1]); w.y = pkbf(v0[2], v0[3]); w.z = pkbf(v1[0], v1[1]); w.w = pkbf(v1[2], v1[3]); *(u32x4*)(eraw + (size_t)row * DM + c0) = w;
                        ss += v0[0] * v0[0] + v0[1] * v0[1] + v0[2] * v0[2] + v0[3] * v0[3] + v1[0] * v1[0] + v1[1] * v1[1] + v1[2] * v1[2] + v1[3] * v1[3]; }
                ss += __shfl_xor(ss, 16); ss += __shfl_xor(ss, 32); if (fq == 0 && !dry) atomicAdd(ssq_e + row, ss);                asm volatile("" ::: "memory");
            }
    }
};
DI float dpp_prev16(float v) { return __builtin_bit_cast(float, __builtin_amdgcn_update_dpp(0, __builtin_bit_cast(int, v), 0x121, 0xf, 0xf, false)); }
DI float dpp_next16(float v) { return __builtin_bit_cast(float, __builtin_amdgcn_update_dpp(0, __builtin_bit_cast(int, v), 0x12f, 0xf, 0xf, false)); }
struct EpiFfn {
    static constexpr bool MIDSCALE = false;
    static constexpr bool PREFETCH = true;
    static constexpr bool INIT = false;
    bf16_t* act; const float* ssq2; const float* cw; const float* cb; LAS float* slots;
    DI void prefetch(const pg8::Unit& u, int wr, int wc, int lane) const {
        asm volatile("" : "+v"(lane) :: "memory");
        LAS float* sl = slots + (wr * 4 + wc) * 384;
        const int pi = lane >> 3, fg = lane & 7, fb = u.pn * 128 + wc * 32 + 4 * fg;
        const float* src = ((pi & 3) == 3) ? (cb + (pi >> 2) * DFF + fb) : (cw + (pi & 3) * (2 * DFF) + (pi >> 2) * DFF + fb);
        __builtin_amdgcn_global_load_lds((const unsigned*)src, (LAS unsigned*)sl, 16, 0, 0);
#pragma unroll
        for (int ai = 0; ai < 2; ++ai) { const int tk = u.pm * 248 - 1 + (2 * ai + wr) * 62 + lane; const int tc = tk < 0 ? 0 : (tk >= MTOK ? MTOK - 1 : tk);
            __builtin_amdgcn_global_load_lds((const unsigned*)(ssq2 + tc), (LAS unsigned*)(sl + 256 + ai * 64), 4, 0, 0); }
    }
    DI void operator()(const Acc& acc, const pg8::Unit& u, int wr, int wc, int fr, int fq) const {
        asm volatile("" : "+v"(fr), "+v"(fq));
        LAS float* sl = slots + (wr * 4 + wc) * 384;
        f32x4 rsa[2];
#pragma unroll
        for (int ai = 0; ai < 2; ++ai) rsa[ai] = *(const LAS f32x4*)(sl + 256 + ai * 64 + 4 * fr);
#pragma unroll
        for (int ai = 0; ai < 2; ++ai) {
            const int tok0 = u.pm * 248 - 1 + (2 * ai + wr) * 62 + 4 * fr;
            float rsv[4], sP[4], sN[4];
#pragma unroll
            for (int m = 0; m < 4; ++m) { rsv[m] = rsqrtf(rsa[ai][m] * (1.0f / DM) + EPS); const int t = (tok0 + m) & 2047; sP[m] = (t == 2047) ? 0.f : rsv[m]; sN[m] = (t == 0) ? 0.f : rsv[m]; }
#pragma unroll
            for (int n = 0; n < 2; ++n) {
                const int f0 = u.pn * 128 + wc * 32 + 8 * fq + 4 * n;
                unsigned pk[2][4];
#pragma unroll
                for (int jp = 0; jp < 2; ++jp) {
                    float r[2][4];
#pragma unroll
                    for (int jj = 0; jj < 2; ++jj) {
                        const int j = 2 * jp + jj;
                        float gc[4];
#pragma unroll
                        for (int half = 0; half < 2; ++half) {
                            const LAS float* pp = sl + (4 * half) * 32 + 8 * fq + 4 * n + j; const float w0 = pp[0], w1 = pp[32], w2 = pp[64], bb = pp[96];
                            float x[4], xp[4], xn[4];
#pragma unroll
                            for (int m = 0; m < 4; ++m) { const float a = acc[ai][half][m][n][j]; x[m] = a * rsv[m]; xp[m] = a * sP[m]; xn[m] = a * sN[m]; }
                            const float pe = __builtin_bit_cast(float, __builtin_amdgcn_update_dpp(0, __builtin_bit_cast(int, xp[3]), 0x111, 0xf, 0xf, true));
                            const float ne = __builtin_bit_cast(float, __builtin_amdgcn_update_dpp(0, __builtin_bit_cast(int, xn[0]), 0x101, 0xf, 0xf, true));
#pragma unroll
                            for (int m = 0; m < 4; ++m) {
                                const float pv = (m == 0) ? pe : xp[m > 0 ? m - 1 : 0], nv = (m == 3) ? ne : xn[m < 3 ? m + 1 : 3];
                                const float cv = w0 * pv + w1 * x[m] + w2 * nv + bb;
                                if (half == 0) gc[m] = cv; else r[jj][m] = gc[m] * __builtin_amdgcn_rcpf(1.0f + __builtin_amdgcn_exp2f(-1.4426950408889634f * gc[m])) * cv; }
                        }
                    }
#pragma unroll
                    for (int m = 0; m < 4; ++m) pk[jp][m] = pkbf(r[0][m], r[1][m]);
                    __builtin_amdgcn_sched_barrier(0);
                }
#pragma unroll
                for (int m = 0; m < 4; ++m) {
                    const int L = 4 * fr + m, tk = tok0 + m;
                    if (L >= 1 && L <= 62 && tk >= 0 && tk < MTOK) { u32x2 w; w.x = pk[0][m]; w.y = pk[1][m]; *(u32x2*)(act + (size_t)tk * DFF + f0) = w; }
                }
            }
        }
    }
};
struct EpiDown {
    static constexpr bool MIDSCALE = false;
    static constexpr bool PREFETCH = false;
    static constexpr bool INIT = true;
    const bf16_t* x1b; bf16_t* x2b; int dry;
    DI void init(Acc& acc, const pg8::Unit& u, int wr, int wc, int fr, int fq) const {
        asm volatile("" : "+v"(fr), "+v"(fq));
#pragma unroll
        for (int ai = 0; ai < 2; ++ai)
#pragma unroll
            for (int m = 0; m < 4; ++m) { const int row = u.pm * 256 + ai * 128 + wr * 64 + m * 16 + fr;
#pragma unroll
                for (int bj = 0; bj < 2; ++bj)
                    { const u32x4 w = *(const u32x4*)(x1b + (size_t)row * DM + u.pn * 256 + bj * 128 + wc * 32 + 8 * fq);
                        acc[ai][bj][m][0] = (f32x4){lo2f(w.x), hi2f(w.x), lo2f(w.y), hi2f(w.y)}; acc[ai][bj][m][1] = (f32x4){lo2f(w.z), hi2f(w.z), lo2f(w.w), hi2f(w.w)}; } }
    }
    DI void operator()(const Acc& acc, const pg8::Unit& u, int wr, int wc, int fr, int fq) const {
        asm volatile("" : "+v"(fr), "+v"(fq));
        if (dry) return;
#pragma unroll
        for (int ai = 0; ai < 2; ++ai)
#pragma unroll
            for (int m = 0; m < 4; ++m) {
                const int row = u.pm * 256 + ai * 128 + wr * 64 + m * 16 + fr;
#pragma unroll
                for (int bj = 0; bj < 2; ++bj)
                    { const int c0 = u.pn * 256 + bj * 128 + wc * 32 + 8 * fq; const size_t o = (size_t)row * DM + c0;
                        const f32x4 v0 = acc[ai][bj][m][0], v1 = acc[ai][bj][m][1];
                        u32x4 w; w.x = pkbf(v0[0], v0[1]); w.y = pkbf(v0[2], v0[3]); w.z = pkbf(v1[0], v1[1]); w.w = pkbf(v1[2], v1[3]); *(u32x4*)(x2b + o) = w; }
            }
    }
};
struct EpiGate {
    static constexpr bool MIDSCALE = false;
    static constexpr bool PREFETCH = false;
    static constexpr bool INIT = false;
    float* out; const bf16_t* x2b; const bf16_t* eraw; const float* ssq_e; const float* gn; int dry;
    DI void operator()(const Acc& acc, const pg8::Unit& u, int wr, int wc, int fr, int fq) const {
        asm volatile("" : "+v"(fr), "+v"(fq));
        float rsv[2][4];
#pragma unroll
        for (int ai = 0; ai < 2; ++ai)
#pragma unroll
            for (int m = 0; m < 4; ++m) rsv[ai][m] = ssq_e[u.pm * 256 + ai * 128 + wr * 64 + m * 16 + fr];
#pragma unroll
        for (int ai = 0; ai < 2; ++ai)
#pragma unroll
            for (int m = 0; m < 4; ++m) {
                const int row = u.pm * 256 + ai * 128 + wr * 64 + m * 16 + fr; const float rs = rsqrtf(rsv[ai][m] * (1.0f / DM) + EPS);
#pragma unroll
                for (int bj = 0; bj < 2; ++bj)
#pragma unroll
                    for (int n = 0; n < 2; ++n) {
                        const int c0 = u.pn * 256 + bj * 128 + wc * 32 + 8 * fq + 4 * n; const size_t o = (size_t)row * DM + c0;
                        const u32x2 ew = *(const u32x2*)(eraw + o); const f32x4 g4 = *(const f32x4*)(gn + c0); const f32x4 a = acc[ai][bj][m][n];
                        f32x4 e; e[0] = lo2f(ew.x); e[1] = hi2f(ew.x); e[2] = lo2f(ew.y); e[3] = hi2f(ew.y);
                        const u32x2 xw = *(const u32x2*)(x2b + o); f32x4 v = (f32x4){lo2f(xw.x), hi2f(xw.x), lo2f(xw.y), hi2f(xw.y)};
#pragma unroll
                        for (int j = 0; j < 4; ++j) v[j] += __builtin_amdgcn_rcpf(1.0f + __builtin_amdgcn_exp2f(-1.4426950408889634f * a[j])) * e[j] * rs * g4[j];
                        if (!dry) __builtin_nontemporal_store(v, (f32x4*)(out + o)); }
                if (m & 1) asm volatile("" ::: "memory");
            }
    }
};

DI float wt_gain(const P& p, int mode, int k) {
    switch (mode) { case 1: return p.norm_mix[k]; case 2: return p.q_norm[k]; case 3: return p.kv_norm[k]; case 4: return k < 512 ? p.on_attn[k] : p.on_hy[k - 512]; case 5: return p.norm_ffn[k]; default: return 1.0f; }
}
DI void wt_tile_wave(const P& p, const float* __restrict__ src, bf16_t* __restrict__ dst, int K, int N, int tk, int tn, int mode, LAS float* lw, int lane) {
    const int k0 = tk * 64, n0 = tn * 64;
#pragma unroll
    for (int i = 0; i < 16; ++i) { const int idx = lane + 64 * i, kk = idx >> 4, c4 = idx & 15, n = n0 + 4 * c4;
        f32x4 v = (f32x4){0.f, 0.f, 0.f, 0.f}; if (n < N) v = __builtin_nontemporal_load((const f32x4*)(src + (size_t)(k0 + kk) * N + n));
        lw[kk * 65 + 4 * c4] = v[0]; lw[kk * 65 + 4 * c4 + 1] = v[1]; lw[kk * 65 + 4 * c4 + 2] = v[2]; lw[kk * 65 + 4 * c4 + 3] = v[3]; }
#pragma unroll
    for (int i = 0; i < 8; ++i) { const int idx = lane + 64 * i, nn = idx >> 3, k8 = idx & 7, n = n0 + nn, k = k0 + 8 * k8;
        float v[8];
#pragma unroll
        for (int j = 0; j < 8; ++j) v[j] = lw[(8 * k8 + j) * 65 + nn] * wt_gain(p, mode, k + j);
        if (n < N) { int dr = n; if (mode == 5) { dr = (n < DFF) ? ((n >> 7) * 256 + (n & 127)) : (((n - DFF) >> 7) * 256 + 128 + ((n - DFF) & 127)); }
            if (mode == 3) { dr = ((n & 127) < 64) ? ((n >> 7) * 64 + (n & 63)) : (512 + (n >> 7) * 64 + (n & 63)); }
            u32x4 w; w.x = pkbf(v[0], v[1]); w.y = pkbf(v[2], v[3]); w.z = pkbf(v[4], v[5]); w.w = pkbf(v[6], v[7]);
            *(u32x4*)(dst + (size_t)dr * K + k) = w; } }
}
DI void phase_prep(const P& p, LAS unsigned char* lds) {
    const int bid = o_bid(), nb = o_nb(), tid = o_tid(), lane = tid & 63, wid = tid >> 6;
    unsigned char* ws = p.ws;
    { LAS float* lw = (LAS float*)(lds + wid * (64 * 65 * 4));
      const int gw = bid * 8 + wid, nw = nb * 8;
      int base = 0;
#define WT_JOB(SRC, DST, KK, NN, MODE) do { const int tK = (KK) / 64, tN = ((NN) + 63) / 64, nt = tK * tN; \
          for (int t = ((gw - base) % nw + nw) % nw; t < nt; t += nw) wt_tile_wave(p, (SRC), (bf16_t*)(ws + (DST)), (KK), (NN), t % tK, t / tK, (MODE), lw, lane); \
          base += nt; } while (0)
      WT_JOB(p.w_up, WS_WUP, DM, 2 * DFF, 5);
      WT_JOB(p.w_down, WS_WDOWN, DFF, DM, 0);
      WT_JOB(p.w_in, WS_WIN, DM, INW, 1);
      WT_JOB(p.w_out, WS_WOUT, DM, DM, 4);
      WT_JOB(p.w_gate, WS_WGATE, DM, DM, 0);
      WT_JOB(p.w_uq, WS_WUQ, QL, QL, 2);
      WT_JOB(p.w_ukv, WS_WUKV, KVL, 1024, 3);
      WT_JOB(p.w_ple, WS_WPLE, PLE, DM, 0);
#undef WT_JOB
    }
    { u32x4* z = (u32x4*)(ws + WS_WIN + (size_t)INW * DM * 2); const int n16 = (INWP - INW) * DM * 2 / 16;
      for (int i = bid * NTHREADS + tid; i < n16; i += nb * NTHREADS) z[i] = (u32x4){0u, 0u, 0u, 0u}; }
    { float* st = (float*)(ws + WS_STATS) + MTOK; for (int i = bid * NTHREADS + tid; i < 5 * MTOK; i += nb * NTHREADS) st[i] = 0.f; }
    { bf16_t* xb = (bf16_t*)(ws + WS_X); float* rs1 = (float*)(ws + WS_STATS);
      for (int row0 = (bid * 8 + wid) * 4; row0 < MTOK; row0 += nb * 32) {
          f32x4 v[4][4];
#pragma unroll
          for (int r = 0; r < 4; ++r)
#pragma unroll
              for (int i = 0; i < 4; ++i) v[r][i] = __builtin_nontemporal_load((const f32x4*)(p.x + (size_t)(row0 + r) * DM) + lane + 64 * i);
#pragma unroll
          for (int r = 0; r < 4; ++r) { float ss = 0.f;
#pragma unroll
              for (int i = 0; i < 4; ++i) { const f32x4 t = v[r][i]; ss += t[0] * t[0] + t[1] * t[1] + t[2] * t[2] + t[3] * t[3];
                  u32x2 w; w.x = pkbf(t[0], t[1]); w.y = pkbf(t[2], t[3]); ((u32x2*)(xb + (size_t)(row0 + r) * DM))[lane + 64 * i] = w; }
#pragma unroll
              for (int o = 32; o >= 1; o >>= 1) ss += __shfl_xor(ss, o);
              if (lane == 0) rs1[row0 + r] = rsqrtf(ss * (1.0f / DM) + EPS); }
      } }
    { const f32x4* ps = (const f32x4*)p.p; u32x2* pd = (u32x2*)(ws + WS_PB);
      for (int i0 = bid * NTHREADS + tid; i0 < MTOK * PLE / 4; i0 += 8 * nb * NTHREADS) {
          f32x4 v[8];
#pragma unroll
          for (int k = 0; k < 8; ++k) { const int i = i0 + k * nb * NTHREADS; v[k] = (i < MTOK * PLE / 4) ? __builtin_nontemporal_load(ps + i) : (f32x4){0.f, 0.f, 0.f, 0.f}; }
#pragma unroll
          for (int k = 0; k < 8; ++k) { const int i = i0 + k * nb * NTHREADS; if (i < MTOK * PLE / 4) { u32x2 w; w.x = pkbf(v[k][0], v[k][1]); w.y = pkbf(v[k][2], v[k][3]); pd[i] = w; } } } }
    { bf16_t* kfil = (bf16_t*)(ws + WS_KFIL);
      LAS float* h3s = (LAS float*)(lds + 8 * 64 * 65 * 4);
      for (int lg = bid; lg < SEQ / 8; lg += nb) {
          const int l = lg * 8 + wid;
          const float t = (float)l / (float)(SEQ - 1);
          const float w = 6.283185307179586f * (float)l / (float)SEQ;
          float z = 0.f;
          if (lane == 0) z = t;
          else if (lane <= 16) { const float fb = 1e-4f + (float)(lane - 1) * ((15.0f - 1e-4f) / 15.0f); z = cosf(w * fb); }
          else if (lane <= 32) { const float fb = 1e-4f + (float)(lane - 17) * ((15.0f - 1e-4f) / 15.0f); z = -sinf(w * fb); }
          const float fr = p.f_freq[lane];
          float a = p.f_b1[lane];
          for (int i = 0; i < 33; ++i) a += __shfl(z, i) * p.f_w1[i * 64 + lane];
          float h = sinf(fr * a);
          a = p.f_b2[lane];
          for (int i = 0; i < 64; ++i) a += __shfl(h, i) * p.f_w2[i * 64 + lane];
          h = sinf(fr * a);
          a = p.f_b3[lane];
          for (int i = 0; i < 64; ++i) a += __shfl(h, i) * p.f_w3[i * 64 + lane];
          h = sinf(fr * a);
          __syncthreads();
          h3s[wid * 64 + lane] = h;
          __syncthreads();
          float o[8][2];
#pragma unroll
          for (int q = 0; q < 8; ++q) { o[q][0] = 0.f; o[q][1] = 0.f; }
#pragma unroll 1
          for (int jb = 0; jb < 64; jb += 16) {
              float w0[16], w1[16];
              const float* wp = p.f_wout + (size_t)jb * 1024 + tid;
#pragma unroll
              for (int j = 0; j < 16; ++j) { w0[j] = wp[j * 1024]; w1[j] = wp[j * 1024 + 512]; }
#pragma unroll
              for (int j4 = 0; j4 < 4; ++j4) {
#pragma unroll
                  for (int q = 0; q < 8; ++q) { const f32x4 hv = *(const LAS f32x4*)(h3s + q * 64 + jb + 4 * j4);
#pragma unroll
                      for (int k = 0; k < 4; ++k) { o[q][0] += hv[k] * w0[4 * j4 + k]; o[q][1] += hv[k] * w1[4 * j4 + k]; } }
                  __builtin_amdgcn_sched_barrier(0); } }
          const float mind = logf(1e-2f) / 0.3f, maxd = logf(1e-2f) / 1.5f;
          const int c = tid; const float delta = fabsf(mind + (float)c * ((maxd - mind) / 511.0f));
          float ff[8], fb[8];
#pragma unroll
          for (int q = 0; q < 8; ++q) { const int lq = lg * 8 + q; const float tq = (float)lq / (float)(SEQ - 1); const float dec = expf(-tq * delta); ff[q] = o[q][0] * dec; fb[q] = o[q][1] * dec; }
          { bf16_t* row = kfil + (size_t)c * 4096;
            u32x4 w; w.x = pkbf(lg == 0 ? ff[0] : fb[0], fb[1]); w.y = pkbf(fb[2], fb[3]); w.z = pkbf(fb[4], fb[5]); w.w = pkbf(fb[6], fb[7]);
            *(u32x4*)(row + 2048 + 8 * lg) = w;
            bf16_t* f0 = row + 2041 - 8 * lg;
            f0[0] = f2bf(ff[7]); *(unsigned*)(f0 + 1) = pkbf(ff[6], ff[5]); *(unsigned*)(f0 + 3) = pkbf(ff[4], ff[3]); *(unsigned*)(f0 + 5) = pkbf(ff[2], ff[1]);
            if (lg != 0) f0[7] = f2bf(ff[0]); }
          if (lg == 0) kfil[(size_t)c * 4096] = 0;
      } }
}

DI void phase_qkprep(const P& p) {
    const int bid = o_bid(), nb = o_nb(), lane = o_tid() & 63, wid = o_tid() >> 6;
    unsigned char* ws = p.ws;
    const bf16_t* qraw = (const bf16_t*)((const unsigned char*)p.out + 32 * MiB); const bf16_t* kraw = (const bf16_t*)(ws + WS_KRAW2); const bf16_t* projm = (const bf16_t*)(ws + WS_Y);
    bf16_t* Qh = (bf16_t*)(ws + WS_Q); bf16_t* Kh = (bf16_t*)(ws + WS_K);
    const int h = lane >> 3, sub = lane & 7;
    const float qscale = 0.10206207261596575f * 1.4426950408889634f;
    float gq[12], gk[12];
#pragma unroll
    for (int i = 0; i < 8; ++i) { gq[i] = p.qk_nq[8 * sub + i]; gk[i] = p.qk_nk[8 * sub + i]; }
#pragma unroll
    for (int e = 0; e < 2; ++e) { gq[8 + e] = p.qk_nq[64 + 2 * sub + e]; gq[10 + e] = p.qk_nq[80 + 2 * sub + e]; gk[8 + e] = p.qk_nk[64 + 2 * sub + e]; gk[10 + e] = p.qk_nk[80 + 2 * sub + e]; }
    float invf[2];
#pragma unroll
    for (int e = 0; e < 2; ++e) invf[e] = powf(10000.0f, -(float)(2 * sub + e) / 16.0f);
    for (int row0 = (bid * 8 + wid) * 2; row0 < MTOK; row0 += nb * 16) {
        u32x4 la[2][2]; unsigned l1[2][2], l2[2][2];
#pragma unroll
        for (int tt = 0; tt < 2; ++tt) {
            const int row = row0 + tt;
            const bf16_t* q = qraw + (size_t)row * QL + h * QKD; const bf16_t* k = kraw + (size_t)row * 512 + h * 64; const bf16_t* pe = projm + (size_t)row * MLAW + 1024;
            la[tt][0] = *(const u32x4*)(q + 8 * sub); l1[tt][0] = *(const unsigned*)(q + 64 + 2 * sub); l2[tt][0] = *(const unsigned*)(q + 80 + 2 * sub);
            la[tt][1] = *(const u32x4*)(k + 8 * sub); l1[tt][1] = *(const unsigned*)(pe + 2 * sub); l2[tt][1] = *(const unsigned*)(pe + 16 + 2 * sub);
        }
#pragma unroll
        for (int tt = 0; tt < 2; ++tt) {
        const int row = row0 + tt;
        const int b = row >> 11, s = row & 2047;
        float cs[2], sn[2];
#pragma unroll
        for (int e = 0; e < 2; ++e) { const float ang = (float)s * invf[e]; sn[e] = sinf(ang); cs[e] = cosf(ang); }
#pragma unroll
        for (int which = 0; which < 2; ++which) {
            float v[12];
            { const u32x4 a = la[tt][which]; const unsigned r1 = l1[tt][which], r2 = l2[tt][which];
              v[0] = lo2f(a.x); v[1] = hi2f(a.x); v[2] = lo2f(a.y); v[3] = hi2f(a.y); v[4] = lo2f(a.z); v[5] = hi2f(a.z); v[6] = lo2f(a.w); v[7] = hi2f(a.w);
              v[8] = lo2f(r1); v[9] = hi2f(r1); v[10] = lo2f(r2); v[11] = hi2f(r2); }
            float ss = 0.f;
#pragma unroll
            for (int i = 0; i < 12; ++i) ss += v[i] * v[i];
            ss += __shfl_xor(ss, 1); ss += __shfl_xor(ss, 2); ss += __shfl_xor(ss, 4);
            const float rs = rsqrtf(ss * (1.0f / QKD) + EPS) * (which == 0 ? qscale : 1.0f);
#pragma unroll
            for (int i = 0; i < 12; ++i) v[i] *= rs * (which == 0 ? gq[i] : gk[i]);
            float r[4];
#pragma unroll
            for (int e = 0; e < 2; ++e) { r[e] = v[8 + e] * cs[e] - v[10 + e] * sn[e]; r[2 + e] = v[10 + e] * cs[e] + v[8 + e] * sn[e]; }
            bf16_t* dst = (which == 0 ? Qh : Kh) + ((size_t)(b * NH + h) * SEQ + s) * QKD;
            u32x4 w; w.x = pkbf(v[0], v[1]); w.y = pkbf(v[2], v[3]); w.z = pkbf(v[4], v[5]); w.w = pkbf(v[6], v[7]);
            *(u32x4*)(dst + 8 * sub) = w; *(unsigned*)(dst + 64 + 2 * sub) = pkbf(r[0], r[1]); *(unsigned*)(dst + 80 + 2 * sub) = pkbf(r[2], r[3]);
        }
        }
    }
}

DI void phase_mixprep(const P& p, unsigned char* shm) {
    const int bid = o_bid(), nb = o_nb(), tid = o_tid(), lane = tid & 63, wid = tid >> 6;
    unsigned char* ws = p.ws;
    const bf16_t* yhT = (const bf16_t*)(ws + WS_YHT); bf16_t* ymix = (bf16_t*)p.out;
    bf16_t* tile = (bf16_t*)shm;
    float* part = (float*)(shm + 512 * 66 * 2);
    for (int t0 = bid; t0 < MTOK / 64; t0 += nb) {
        const int m0 = t0 * 64;
        u32x4 hr[8];
#pragma unroll
        for (int i = 0; i < 8; ++i) { const int idx = tid + NTHREADS * i, c = idx >> 3, q = idx & 7; hr[i] = *(const u32x4*)(yhT + (size_t)c * MTOK + m0 + q * 8); }
#pragma unroll
        for (int i = 0; i < 8; ++i) { const int idx = tid + NTHREADS * i, c = idx >> 3, q = idx & 7; const u32x4 a = hr[i];
            unsigned* d = (unsigned*)(tile + c * 66 + q * 8); d[0] = a.x; d[1] = a.y; d[2] = a.z; d[3] = a.w; }
        __syncthreads();
        { const int tok = lane, part_i = wid; float ss = 0.f;
          for (int c = part_i * 64; c < part_i * 64 + 64; ++c) { const float v = bf2f(tile[c * 66 + tok]); ss += v * v; }
          part[part_i * 64 + tok] = ss; }
        __syncthreads();
        { const int tok = lane, part_i = wid; float ss = 0.f;
#pragma unroll
          for (int i = 0; i < 8; ++i) ss += part[i * 64 + tok];
          const float rs = rsqrtf(ss * (1.0f / 512) + EPS);
          bf16_t* dst = ymix + (size_t)(m0 + tok) * DM + 512 + part_i * 64;
#pragma unroll
          for (int g = 0; g < 8; ++g) { float v[8];
#pragma unroll
              for (int i = 0; i < 8; ++i) v[i] = bf2f(tile[(part_i * 64 + g * 8 + i) * 66 + tok]) * rs;
              u32x4 w; w.x = pkbf(v[0], v[1]); w.y = pkbf(v[2], v[3]); w.z = pkbf(v[4], v[5]); w.w = pkbf(v[6], v[7]); *(u32x4*)(dst + g * 8) = w; } }
        __syncthreads();
    }
}

DI void phase_g1(const P& p, LAS unsigned char* shm, int dry) {
    unsigned char* ws = p.ws; float* st = (float*)(ws + WS_STATS);
    { pg8::Gemm g{(const bf16_t*)(ws + WS_X), (const bf16_t*)(ws + WS_WIN), DM, DM, 64, 5, 256, 64};
      pg8::StaticOrder S; S.init(g.nM, g.nN, o_nb(), o_bid());
      EpiProj E{(bf16_t*)(ws + WS_Y), st, st + MTOK, st + 2 * MTOK, dry};
      pg8::gemm_phase(shm, g, S, E); }
    { pg8::Gemm g{(const bf16_t*)(ws + WS_WIN) + (size_t)MLAW * DM, (const bf16_t*)(ws + WS_X), DM, DM, 6, 64, 256, 64};
      pg8::StaticOrder S; S.init(g.nM, g.nN, o_nb(), (o_bid() + 192) % o_nb());
      EpiHyT E{(bf16_t*)(ws + WS_Z), st};
      pg8::gemm_phase(shm, g, S, E); }
}
DI void phase_g23(const P& p, LAS unsigned char* shm) {
    unsigned char* ws = p.ws; float* st = (float*)(ws + WS_STATS);
    { pg8::Gemm g{(const bf16_t*)(ws + WS_Y), (const bf16_t*)(ws + WS_WUQ), QL, MLAW, 64, 3, 256, 64};
      pg8::StaticOrder S; S.init(g.nM, g.nN, o_nb(), o_bid());
      EpiQ E{(bf16_t*)((unsigned char*)p.out + 32 * MiB), st + MTOK};
      pg8::gemm_phase(shm, g, S, E); }
    { pg8::Gemm g{(const bf16_t*)(ws + WS_Y) + QL, (const bf16_t*)(ws + WS_WUKV), KVL, MLAW, 64, 2, 256, 64};
      pg8::StaticOrder S; S.init(g.nM, g.nN, o_nb(), (o_bid() + 64) % o_nb());
      EpiK E{(bf16_t*)(ws + WS_KRAW2), st + 2 * MTOK};
      pg8::gemm_phase(shm, g, S, E); }
    { pg8::Gemm g{(const bf16_t*)(ws + WS_WUKV) + (size_t)512 * KVL, (const bf16_t*)(ws + WS_Y) + QL, KVL, KVL, 2, 64, 256, 64, MLAW};
      pg8::StaticOrder S; S.init(g.nM, g.nN, o_nb(), (o_bid() + 192) % o_nb());
      EpiVT E{(bf16_t*)(ws + WS_V), st + 2 * MTOK};
      pg8::gemm_phase(shm, g, S, E); }
}
DI void phase_g4(const P& p, LAS unsigned char* shm, int dry) {
    unsigned char* ws = p.ws; float* st = (float*)(ws + WS_STATS);
    { pg8::Gemm g{(const bf16_t*)p.out, (const bf16_t*)(ws + WS_WOUT), DM, DM, 64, 4, 256, 64};
      pg8::StaticOrder S; S.init(g.nM, g.nN, o_nb(), o_bid());
      EpiOut E{(const bf16_t*)(ws + WS_X), (bf16_t*)(ws + WS_Y + 4096), st + 3 * MTOK, (const float*)(ws + WS_SSQAH), dry};
      pg8::gemm_phase(shm, g, S, E); }
}
DI void phase_g5(const P& p, LAS unsigned char* shm) {
    unsigned char* ws = p.ws; float* st = (float*)(ws + WS_STATS);
    pg8::Gemm g{(const bf16_t*)(ws + WS_Y + 4096) - DM, (const bf16_t*)(ws + WS_WUP), DM, DM, 67, 22, 248, 62, 0, 1};
    pg8::StaticOrder S; S.init(g.nM, g.nN, o_nb(), o_bid());
    EpiFfn E{(bf16_t*)(ws + WS_ACT), st + 3 * MTOK, p.fc_w, p.fc_b, (LAS float*)(shm + pg8::STAGE_BYTES)};
    pg8::gemm_phase(shm, g, S, E);
}
DI void phase_g6(const P& p, LAS unsigned char* shm, int dry) {
    unsigned char* ws = p.ws;
    pg8::Gemm g{(const bf16_t*)(ws + WS_ACT), (const bf16_t*)(ws + WS_WDOWN), DFF, DFF, 64, 4, 256, 64};
    pg8::StaticOrder S; S.init(g.nM, g.nN, o_nb(), o_bid());
    { EpiDown E{(const bf16_t*)(ws + WS_Y + 4096), (bf16_t*)(ws + WS_X), dry};
      pg8::gemm_phase(shm, g, S, E); }
    float* st = (float*)(ws + WS_STATS);
    { pg8::Gemm g{(const bf16_t*)(ws + WS_PB), (const bf16_t*)(ws + WS_WPLE), PLE, PLE, 64, 4, 256, 64};
      pg8::StaticOrder S; S.init(g.nM, g.nN, o_nb(), o_bid());
      EpiPle E{(bf16_t*)(ws + WS_Z), st + 4 * MTOK, dry};
      pg8::gemm_phase(shm, g, S, E); }
}
DI void phase_g7(const P& p, LAS unsigned char* shm, int dry) {
    unsigned char* ws = p.ws; float* st = (float*)(ws + WS_STATS);
    pg8::Gemm g{(const bf16_t*)(ws + WS_X), (const bf16_t*)(ws + WS_WGATE), DM, DM, 64, 4, 256, 64};
    pg8::StaticOrder S; S.init(g.nM, g.nN, o_nb(), o_bid());
    EpiGate E{p.out, (const bf16_t*)(ws + WS_X), (const bf16_t*)(ws + WS_Z), st + 4 * MTOK, p.ple_norm, dry};
    pg8::gemm_phase(shm, g, S, E);
}

#define MFMA32(a, b, c) __builtin_amdgcn_mfma_f32_32x32x16_bf16((a), (b), (c), 0, 0, 0)
constexpr int AT_KRS = 208, AT_VRS = 136, AT_KBYTES = 64 * AT_KRS, AT_VBYTES = 64 * AT_VRS, AT_BUF = AT_KBYTES + AT_VBYTES;
DI void phase_attn(const P& p, LAS unsigned char* lds) {
    const int tid = o_tid(), lane = tid & 63, wid = tid >> 6, l31 = lane & 31, hl = lane >> 5;
    const int bid = o_bid(), nb = o_nb();
    const bf16_t* Qg = (const bf16_t*)(p.ws + WS_Q); const bf16_t* Kg = (const bf16_t*)(p.ws + WS_K); const bf16_t* Vg = (const bf16_t*)(p.ws + WS_V);
    bf16_t* Y = (bf16_t*)p.out;
    float* ssq_ah = (float*)(p.ws + WS_SSQAH);
    const int kl0 = (tid / 12) * AT_KRS + (tid % 12) * 16, kl1 = ((512 + tid) / 12) * AT_KRS + ((512 + tid) % 12) * 16;
    const int vdv = tid >> 3, vpart = tid & 7, vl = vdv * AT_VRS + vpart * 16;
    for (int it0 = bid; it0 < 256; it0 += nb) {
        const int item = ((it0 & 7) * 8 + ((it0 >> 3) >> 2)) * 4 + ((it0 >> 3) & 3);
        const int bh = item >> 2, q0 = (item & 3) * 512;
        bf16x8 Qf[2][6];
#pragma unroll
        for (int qb = 0; qb < 2; ++qb)
#pragma unroll
            for (int kk = 0; kk < 6; ++kk) Qf[qb][kk] = *(const bf16x8*)(Qg + ((size_t)bh * SEQ + q0 + 64 * wid + 32 * qb + l31) * QKD + 16 * kk + 8 * hl);
        f32x16 O[2][2];
#pragma unroll
        for (int a = 0; a < 2; ++a)
#pragma unroll
            for (int b = 0; b < 2; ++b)
#pragma unroll
                for (int i = 0; i < 16; ++i) O[a][b][i] = 0.f;
        float mrow[2] = {0.f, 0.f}, lsum[2] = {0.f, 0.f}; bool refs = false;
        const unsigned char* Kt = (const unsigned char*)(Kg + (size_t)bh * SEQ * QKD);
        const unsigned char* Vt = (const unsigned char*)(Vg + (size_t)bh * VD * SEQ) + (size_t)vdv * SEQ * 2 + vpart * 16;
        u32x4 kr0 = *(const u32x4*)(Kt + tid * 16), kr1 = (u32x4){0u, 0u, 0u, 0u}, vr = *(const u32x4*)(Vt);
        if (tid < 256) kr1 = *(const u32x4*)(Kt + (512 + tid) * 16);
        __syncthreads();
        *(LAS u32x4*)(lds + kl0) = kr0; if (tid < 256) *(LAS u32x4*)(lds + kl1) = kr1;
        *(LAS u32x2*)(lds + AT_KBYTES + vl) = (u32x2){vr.x, vr.y}; *(LAS u32x2*)(lds + AT_KBYTES + vl + 8) = (u32x2){vr.z, vr.w};
        __syncthreads();
#pragma unroll 1
        for (int it = 0; it < 32; ++it) {
            LAS unsigned char* kb_ = lds + (it & 1) * AT_BUF; LAS unsigned char* vb_ = kb_ + AT_KBYTES;
            if (it + 1 < 32) {
                kr0 = *(const u32x4*)(Kt + (size_t)(it + 1) * 12288 + tid * 16); if (tid < 256) kr1 = *(const u32x4*)(Kt + (size_t)(it + 1) * 12288 + (512 + tid) * 16);
                vr = *(const u32x4*)(Vt + (size_t)(it + 1) * 128); }
            f32x16 S[2][2];
#pragma unroll
            for (int a = 0; a < 2; ++a)
#pragma unroll
                for (int b = 0; b < 2; ++b)
#pragma unroll
                    for (int i = 0; i < 16; ++i) S[a][b][i] = 0.f;
#pragma unroll
            for (int kb = 0; kb < 2; ++kb)
#pragma unroll
                for (int kk = 0; kk < 6; ++kk) {
                    const bf16x8 a = *(const LAS bf16x8*)(kb_ + (32 * kb + l31) * AT_KRS + 32 * kk + 16 * hl);
                    S[kb][0] = MFMA32(a, Qf[0][kk], S[kb][0]); S[kb][1] = MFMA32(a, Qf[1][kk], S[kb][1]); }
#pragma unroll
            for (int qb = 0; qb < 2; ++qb) {
                float mx = S[0][qb][0];
#pragma unroll
                for (int i = 1; i < 16; ++i) mx = fmaxf(mx, S[0][qb][i]);
#pragma unroll
                for (int i = 0; i < 16; ++i) mx = fmaxf(mx, S[1][qb][i]);
                { float mx2 = mx; asm volatile("" : "+v"(mx2));
                  const auto r = __builtin_amdgcn_permlane32_swap(__builtin_bit_cast(unsigned, mx), __builtin_bit_cast(unsigned, mx2), false, false);
                  mx = fmaxf(__builtin_bit_cast(float, r[0]), __builtin_bit_cast(float, r[1])); }
                { const float rel = mx - mrow[qb]; const bool need = (it == 0) ? (fabsf(rel) > 8.0f) : (rel > 8.0f);
                  if (__builtin_amdgcn_ballot_w64(need) != 0ull) {
                      const float d = need ? rel : 0.f, alpha = (it == 0) ? 1.0f : __builtin_amdgcn_exp2f(-d);
                      mrow[qb] += d; lsum[qb] *= alpha; refs = true;
#pragma unroll
                      for (int dvb = 0; dvb < 2; ++dvb)
#pragma unroll
                          for (int i = 0; i < 16; ++i) O[dvb][qb][i] *= alpha;
                  } }
                if (refs) {
                    const float mm = mrow[qb];
#pragma unroll
                    for (int kb = 0; kb < 2; ++kb)
#pragma unroll
                        for (int i = 0; i < 16; ++i) S[kb][qb][i] -= mm;
                }
                float ps = 0.f;
#pragma unroll
                for (int kb = 0; kb < 2; ++kb)
#pragma unroll
                    for (int i = 0; i < 16; ++i) { const float e = __builtin_amdgcn_exp2f(S[kb][qb][i]); S[kb][qb][i] = e; ps += e; }
                lsum[qb] += ps;
            }
#pragma unroll
            for (int c = 0; c < 4; ++c) {
                const int kb = c >> 1, s8 = (c & 1) * 8;
                bf16x8 pf[2];
#pragma unroll
                for (int qb = 0; qb < 2; ++qb) { u32x4 w; w.x = pkbf(S[kb][qb][s8 + 0], S[kb][qb][s8 + 1]); w.y = pkbf(S[kb][qb][s8 + 2], S[kb][qb][s8 + 3]);
                    w.z = pkbf(S[kb][qb][s8 + 4], S[kb][qb][s8 + 5]); w.w = pkbf(S[kb][qb][s8 + 6], S[kb][qb][s8 + 7]); pf[qb] = __builtin_bit_cast(bf16x8, w); }
#pragma unroll
                for (int dvb = 0; dvb < 2; ++dvb) {
                    const LAS unsigned char* va = vb_ + (32 * dvb + l31) * AT_VRS + (16 * c + 4 * hl) * 2;
                    const u32x2 lo = *(const LAS u32x2*)va, hi = *(const LAS u32x2*)(va + 16);
                    const bf16x8 a = __builtin_bit_cast(bf16x8, (u32x4){lo.x, lo.y, hi.x, hi.y});
                    O[dvb][0] = MFMA32(a, pf[0], O[dvb][0]); O[dvb][1] = MFMA32(a, pf[1], O[dvb][1]); }
            }
            if (it + 1 < 32) {
                LAS unsigned char* kn = lds + ((it + 1) & 1) * AT_BUF;
                *(LAS u32x4*)(kn + kl0) = kr0; if (tid < 256) *(LAS u32x4*)(kn + kl1) = kr1;
                *(LAS u32x2*)(kn + AT_KBYTES + vl) = (u32x2){vr.x, vr.y}; *(LAS u32x2*)(kn + AT_KBYTES + vl + 8) = (u32x2){vr.z, vr.w}; }
            __syncthreads();
        }
        const int b = bh >> 3, h = bh & 7;
#pragma unroll
        for (int qb = 0; qb < 2; ++qb) {
            const float lt = lsum[qb] + __shfl_xor(lsum[qb], 32), inv = 1.0f / lt;
            const int orow = b * SEQ + q0 + 64 * wid + 32 * qb + l31;
            bf16_t* dst = Y + (size_t)orow * DM + h * VD;
            { float ss = 0.f;
#pragma unroll
              for (int dvb = 0; dvb < 2; ++dvb)
#pragma unroll
                  for (int i = 0; i < 16; ++i) { const float v = O[dvb][qb][i] * inv; ss += v * v; }
              ss += __shfl_xor(ss, 32);
              if (hl == 0) ssq_ah[(size_t)orow * NH + h] = ss; }
#pragma unroll
            for (int dvb = 0; dvb < 2; ++dvb)
#pragma unroll
                for (int g = 0; g < 4; g += 2) {
                    const unsigned a0 = pkbf(O[dvb][qb][4 * g] * inv, O[dvb][qb][4 * g + 1] * inv), a1 = pkbf(O[dvb][qb][4 * g + 2] * inv, O[dvb][qb][4 * g + 3] * inv);
                    const unsigned b0 = pkbf(O[dvb][qb][4 * g + 4] * inv, O[dvb][qb][4 * g + 5] * inv), b1 = pkbf(O[dvb][qb][4 * g + 6] * inv, O[dvb][qb][4 * g + 7] * inv);
                    const auto s0 = __builtin_amdgcn_permlane32_swap(a0, b0, false, false), s1 = __builtin_amdgcn_permlane32_swap(a1, b1, false, false);
                    u32x4 w; w.x = s0[0]; w.y = s1[0]; w.z = s0[1]; w.w = s1[1];
                    *(u32x4*)(dst + 32 * dvb + 8 * (g + hl)) = w; }
        }
    }
}

constexpr int HY_CS = 8224, HY_URS = 4880, HY_UP = 8 * HY_CS, HY_X0 = HY_UP + 8 * HY_URS, HY_END = HY_X0 + 8 * 2048 * 2;
static_assert(HY_END <= LDS_BYTES, "hyena LDS");
DI void phase_hyena(const P& p, LAS unsigned char* lds) {
    const int tid = o_tid(), lane = tid & 63, wid = tid >> 6, l31 = lane & 31, hl = lane >> 5;
    const int bid = o_bid(), nb = o_nb();
    const bf16_t* uhT = (const bf16_t*)(p.ws + WS_Z); const bf16_t* kfil = (const bf16_t*)(p.ws + WS_KFIL); bf16_t* yhT = (bf16_t*)(p.ws + WS_YHT);
    for (int c = bid; c < HYW; c += nb) {
        __syncthreads();
        { const bf16_t* kr = kfil + (size_t)c * 4096; const int q = tid;
          const u32x4 A = *(const u32x4*)(kr + 8 * q); const u32x4 B = (q < 511) ? *(const u32x4*)(kr + 8 * q + 8) : (u32x4){0u, 0u, 0u, 0u};
          const unsigned d[8] = {A.x, A.y, A.z, A.w, B.x, B.y, B.z, B.w};
#pragma unroll
          for (int r = 0; r < 8; ++r) { const int e = r >> 1; u32x4 o;
              if ((r & 1) == 0) { o.x = d[e]; o.y = d[e + 1]; o.z = d[e + 2]; o.w = d[e + 3]; }
              else { o.x = __builtin_amdgcn_alignbit(d[e + 1], d[e], 16); o.y = __builtin_amdgcn_alignbit(d[e + 2], d[e + 1], 16); o.z = __builtin_amdgcn_alignbit(d[e + 3], d[e + 2], 16); o.w = __builtin_amdgcn_alignbit(d[e + 4], d[e + 3], 16); }
              *(LAS u32x4*)(lds + r * HY_CS + 16 * q) = o; } }
        if (tid < 384) { const int b = tid / 48, k = tid % 48; LAS unsigned char* row = lds + HY_UP + b * HY_URS; const int off = (k < 24) ? k * 16 : (2240 * 2 + (k - 24) * 16); *(LAS u32x4*)(row + off) = (u32x4){0u, 0u, 0u, 0u}; }
        { float w0[3], w1[3], w2[3], bb[3];
#pragma unroll
          for (int a = 0; a < 3; ++a) { const int ch = a * HYW + c; w0[a] = p.sc_w[ch]; w1[a] = p.sc_w[1536 + ch]; w2[a] = p.sc_w[3072 + ch]; bb[a] = p.sc_b[ch]; }
#pragma unroll 2
          for (int i = 0; i < 4; ++i) {
              const int ch = tid + 512 * i, b = ch >> 8, t0 = (ch & 255) * 8, m0 = b * SEQ + t0;
              float r[3][8];
#pragma unroll
              for (int a = 0; a < 3; ++a) {
                  const bf16_t* row = uhT + (size_t)(a * HYW + c) * MTOK + m0;
                  const u32x4 v = *(const u32x4*)row; const float pv = t0 > 0 ? bf2f(row[-1]) : 0.f, nv = t0 < SEQ - 8 ? bf2f(row[8]) : 0.f;
                  const float x[10] = {pv, lo2f(v.x), hi2f(v.x), lo2f(v.y), hi2f(v.y), lo2f(v.z), hi2f(v.z), lo2f(v.w), hi2f(v.w), nv};
#pragma unroll
                  for (int k = 0; k < 8; ++k) r[a][k] = w0[a] * x[k] + w1[a] * x[k + 1] + w2[a] * x[k + 2] + bb[a];
              }
              u32x4 uo, xo;
              uo.x = pkbf(r[1][0] * r[2][0], r[1][1] * r[2][1]); uo.y = pkbf(r[1][2] * r[2][2], r[1][3] * r[2][3]); uo.z = pkbf(r[1][4] * r[2][4], r[1][5] * r[2][5]); uo.w = pkbf(r[1][6] * r[2][6], r[1][7] * r[2][7]);
              xo.x = pkbf(r[0][0], r[0][1]); xo.y = pkbf(r[0][2], r[0][3]); xo.z = pkbf(r[0][4], r[0][5]); xo.w = pkbf(r[0][6], r[0][7]);
              *(LAS u32x4*)(lds + HY_UP + b * HY_URS + (192 + t0) * 2) = uo; *(LAS u32x4*)(lds + HY_X0 + (b * SEQ + t0) * 2) = xo;
          } }
        __syncthreads();
        const int T0 = 256 * wid, rho = (-l31) & 7, bcol = l31 & 7, mcol = l31 >> 3;
        const LAS unsigned char* ap = lds + rho * HY_CS + 2 * (1856 - T0 + 8 * hl - l31 - rho);
        const LAS unsigned char* bp = lds + HY_UP + bcol * HY_URS + (64 * mcol + 8 * hl) * 2;
        f32x16 C0, C1;
#pragma unroll
        for (int i = 0; i < 16; ++i) { C0[i] = 0.f; C1[i] = 0.f; }
        bf16x8 am2 = *(const LAS bf16x8*)(ap - 64), am1 = *(const LAS bf16x8*)(ap - 32);
#pragma unroll 4
        for (int e = 0; e < 140; ++e) {
            const bf16x8 ac = *(const LAS bf16x8*)(ap + 32 * e); const bf16x8 bf = *(const LAS bf16x8*)(bp + 32 * e);
            C0 = MFMA32(ac, bf, C0); C1 = MFMA32(am2, bf, C1);
            am2 = am1; am1 = ac;
        }
        { const float bias = p.hy_bias[c];
#pragma unroll
          for (int rb = 0; rb < 2; ++rb)
#pragma unroll
              for (int g = 0; g < 4; g += 2) {
                  unsigned pw[2][2];
#pragma unroll
                  for (int gg = 0; gg < 2; ++gg) {
                      const int t0 = T0 + 64 * mcol + 32 * rb + 8 * (g + gg) + 4 * hl;
                      const u32x2 uw = *(const LAS u32x2*)(lds + HY_UP + bcol * HY_URS + (192 + t0) * 2), xw = *(const LAS u32x2*)(lds + HY_X0 + (bcol * SEQ + t0) * 2);
                      const float uu[4] = {lo2f(uw.x), hi2f(uw.x), lo2f(uw.y), hi2f(uw.y)}, xx[4] = {lo2f(xw.x), hi2f(xw.x), lo2f(xw.y), hi2f(xw.y)};
                      float y[4];
#pragma unroll
                      for (int j = 0; j < 4; ++j) { const float cv = rb == 0 ? C0[4 * (g + gg) + j] : C1[4 * (g + gg) + j]; y[j] = xx[j] * (cv + bias * uu[j]); }
                      pw[gg][0] = pkbf(y[0], y[1]); pw[gg][1] = pkbf(y[2], y[3]); }
                  const auto s0 = __builtin_amdgcn_permlane32_swap(pw[0][0], pw[1][0], false, false), s1 = __builtin_amdgcn_permlane32_swap(pw[0][1], pw[1][1], false, false);
                  u32x4 w; w.x = s0[0]; w.y = s1[0]; w.z = s0[1]; w.w = s1[1];
                  *(u32x4*)(yhT + (size_t)c * MTOK + bcol * SEQ + T0 + 64 * mcol + 32 * rb + 8 * (g + hl)) = w; } }
    }
}

DI void phase_attn_naive(const P& p) {
    const int lane = o_tid() & 63, wid = o_tid() >> 6;
    for (int vb = o_bid() * 8 + wid; vb < 64 * 32; vb += o_nb() * 8) {
    const int bh = vb >> 5, q = (vb & 31) * 64 + lane;
    const bf16_t* Q = (const bf16_t*)(p.ws + WS_Q) + ((size_t)bh * SEQ + q) * QKD;
    const bf16_t* K = (const bf16_t*)(p.ws + WS_K) + (size_t)bh * SEQ * QKD;
    const bf16_t* V = (const bf16_t*)(p.ws + WS_V) + (size_t)bh * VD * SEQ;
    float qv[QKD];
#pragma unroll
    for (int i = 0; i < QKD; ++i) qv[i] = bf2f(Q[i]);
    float o[VD];
#pragma unroll
    for (int i = 0; i < VD; ++i) o[i] = 0.f;
    float mx = -1e30f, l = 0.f;
    for (int k = 0; k < SEQ; ++k) {
        float s = 0.f;
#pragma unroll
        for (int i = 0; i < QKD; ++i) s += qv[i] * bf2f(K[(size_t)k * QKD + i]);
        const float mn = fmaxf(mx, s), al = exp2f(mx - mn), pr = exp2f(s - mn); mx = mn; l = l * al + pr;
#pragma unroll
        for (int i = 0; i < VD; ++i) o[i] = o[i] * al + pr * bf2f(V[(size_t)i * SEQ + k]);
    }
    const int b = bh >> 3, h = bh & 7; bf16_t* dst = (bf16_t*)(p.ws + WS_YATT) + ((size_t)(b * SEQ + q)) * 512 + h * VD;
#pragma unroll
    for (int i = 0; i < VD; ++i) dst[i] = f2bf(o[i] / l);
    }
}
DI void phase_hy_prep_naive(const P& p) {
    for (size_t idx = (size_t)o_bid() * NTHREADS + o_tid(); idx < (size_t)512 * MTOK; idx += (size_t)o_nb() * NTHREADS) {
    const int c = idx / MTOK, m = idx % MTOK, t = m & 2047;
    const bf16_t* uhT = (const bf16_t*)(p.ws + WS_Z);
    float r[3];
#pragma unroll
    for (int part = 0; part < 3; ++part) { const int ch = part * 512 + c; const bf16_t* row = uhT + (size_t)ch * MTOK + m;
        const float a = t > 0 ? bf2f(row[-1]) : 0.f, b = bf2f(row[0]), d = t < 2047 ? bf2f(row[1]) : 0.f;
        r[part] = a * p.sc_w[ch] + b * p.sc_w[1536 + ch] + d * p.sc_w[2 * 1536 + ch] + p.sc_b[ch]; }
    bf16_t* U = (bf16_t*)p.out; bf16_t* X0 = U + (size_t)512 * MTOK;
    U[idx] = f2bf(r[1] * r[2]); X0[idx] = f2bf(r[0]);
    }
}
DI void phase_hy_conv_naive(const P& p) {
    for (size_t idx = (size_t)o_bid() * NTHREADS + o_tid(); idx < (size_t)512 * MTOK; idx += (size_t)o_nb() * NTHREADS) {
    const int c = idx / MTOK, m = idx % MTOK, t = m & 2047, b = m >> 11;
    const bf16_t* U = (const bf16_t*)p.out + (size_t)c * MTOK + (size_t)b * SEQ; const bf16_t* X0 = (const bf16_t*)p.out + (size_t)512 * MTOK;
    const bf16_t* kr = (const bf16_t*)(p.ws + WS_KFIL) + (size_t)c * 4096;
    float acc = 0.f;
    for (int s = 0; s < SEQ; ++s) acc += bf2f(kr[2048 - t + s]) * bf2f(U[s]);
    const float y = bf2f(X0[idx]) * (acc + p.hy_bias[c] * bf2f(U[t]));
    ((bf16_t*)(p.ws + WS_YHT))[idx] = f2bf(y);
    }
}

#define XB_TMO      128
#define XB_XCNT(j)  (256  + 64 * (j))
#define XB_XSUB(j)  (1280 + 64 * (j))
#define XB_XGEN(j)  (2304 + 64 * (j))
#define XB_TOP      3328
#define XB_TOPGEN   3392
#define XCD_BAR_WORDS 3456
#define XB_SPIN_CAP (1u << 18)
DI unsigned xb_ld(unsigned* p)              { return __hip_atomic_load(p, __ATOMIC_RELAXED, __HIP_MEMORY_SCOPE_AGENT); }
DI unsigned xb_add(unsigned* p, unsigned v) { return __hip_atomic_fetch_add(p, v, __ATOMIC_RELAXED, __HIP_MEMORY_SCOPE_AGENT); }
DI unsigned xb_xcc_id() { return (unsigned)__builtin_amdgcn_s_getreg((3 << 11) | 20) & 0xFu; }
#define XB_SPIN(cond, bar) do { unsigned _sp = 0; while (cond) { __builtin_amdgcn_s_sleep(1); \
    if ((++_sp & 255u) == 0u) { if (xb_ld(&(bar)[XB_TMO])) break; if (_sp > XB_SPIN_CAP) { atomicAdd(&(bar)[XB_TMO], 1u); break; } } } } while (0)
struct XcdBarrier { unsigned* bar; unsigned x; volatile LAS unsigned* st; };
DI XcdBarrier xcd_barrier_post(unsigned* bar, volatile LAS unsigned* st) {
    XcdBarrier b; b.bar = bar; b.x = xb_xcc_id(); b.st = st;
    if (threadIdx.x == 0) (void)xb_add(&bar[XB_XCNT(b.x)], 1u);
    return b;
}
DI void xcd_barrier_complete(unsigned* bar, unsigned x, unsigned& nloc, unsigned& nx) {
    const unsigned G = gridDim.x * gridDim.y * gridDim.z;
    unsigned sum, cnt, mine, sp = 0u;
    for (;;) {
        sum = 0u; cnt = 0u; mine = 0u;
#pragma unroll
        for (unsigned j = 0; j < 16; ++j) { const unsigned c = xb_ld(&bar[XB_XCNT(j)]); sum += c; cnt += (c > 0u) ? 1u : 0u; mine = (j == x) ? c : mine; }
        if (sum == G) break;
        __builtin_amdgcn_s_sleep(1);
        if ((++sp & 255u) == 0u) { if (xb_ld(&bar[XB_TMO])) break; if (sp > XB_SPIN_CAP) { atomicAdd(&bar[XB_TMO], 1u); break; } }
    }
    nloc = mine > 0u ? mine : 1u; nx = cnt > 0u ? cnt : 1u;
}
DI void xcd_barrier(const XcdBarrier& b) {
    asm volatile("s_waitcnt vmcnt(0)" ::: "memory");
    __syncthreads();
    if (threadIdx.x == 0) {
        unsigned* bar = b.bar;
        __builtin_amdgcn_s_waitcnt(0);
        unsigned nloc = b.st[0], nx = b.st[1];
        if (nloc == 0u) { xcd_barrier_complete(bar, b.x, nloc, nx); b.st[0] = nloc; b.st[1] = nx; }
        const unsigned old = xb_add(&bar[XB_XSUB(b.x)], 1u);
        const unsigned gen = old / nloc;
        if (old + 1u == (gen + 1u) * nloc) {
            __builtin_amdgcn_fence(__ATOMIC_RELEASE, "agent");
            asm volatile("s_waitcnt vmcnt(0)" ::: "memory");
            const unsigned og = xb_add(&bar[XB_TOP], 1u);
            const unsigned tg = og / nx;
            if (og + 1u == (tg + 1u) * nx) xb_add(&bar[XB_TOPGEN], 1u);
            else XB_SPIN(xb_ld(&bar[XB_TOPGEN]) == tg, bar);
            __builtin_amdgcn_fence(__ATOMIC_ACQUIRE, "agent");
            xb_add(&bar[XB_XGEN(b.x)], 1u);
            asm volatile("s_waitcnt vmcnt(0)" ::: "memory");
        } else {
            XB_SPIN(xb_ld(&bar[XB_XGEN(b.x)]) == gen, bar);
            __builtin_amdgcn_fence(__ATOMIC_ACQUIRE, "agent");
            asm volatile("s_waitcnt vmcnt(0)" ::: "memory");
        }
    }
    __syncthreads();
}

enum { PH_PREP = 0, PH_G1, PH_G23, PH_HYP, PH_HYC, PH_QKPREP, PH_ATTN, PH_MIX, PH_G4, PH_G5, PH_G6, PH_G7, PH_COUNT };
DI void run_phase(const P& p, int ph, int dry = 0) {
    extern __shared__ __attribute__((aligned(16))) unsigned char shm[];
    switch (ph) {
        case PH_PREP: phase_prep(p, (LAS unsigned char*)shm); break;
        case PH_G1: phase_g1(p, (LAS unsigned char*)shm, dry); break;
#if NAIVE_HYENA
        case PH_G23: phase_g23(p, (LAS unsigned char*)shm); break;
#else
        case PH_G23: phase_g23(p, (LAS unsigned char*)shm); phase_hyena(p, (LAS unsigned char*)shm); break;
#endif
        case PH_QKPREP: phase_qkprep(p); phase_mixprep(p, shm); break;
        case PH_HYP: phase_hy_prep_naive(p); break;
        case PH_HYC: phase_hy_conv_naive(p); break;
#if NAIVE_ATTN
        case PH_ATTN: phase_attn_naive(p); break;
#else
        case PH_ATTN: phase_attn(p, (LAS unsigned char*)shm); break;
#endif
        case PH_MIX: break;
        case PH_G4: phase_g4(p, (LAS unsigned char*)shm, dry); break;
        case PH_G5: phase_g5(p, (LAS unsigned char*)shm); break;
        case PH_G6: phase_g6(p, (LAS unsigned char*)shm, dry); break;
        case PH_G7: phase_g7(p, (LAS unsigned char*)shm, dry); break;
    }
}
template <int PH> __global__ void __launch_bounds__(NTHREADS, 2) k_multi(P p) {
    run_phase(p, PH);
}
template <int PH> static void launch_phase(const P& p, int grid, hipStream_t stream) {
    static bool attr = false;
    if (!attr) { hipFuncSetAttribute((const void*)k_multi<PH>, hipFuncAttributeMaxDynamicSharedMemorySize, LDS_BYTES); attr = true; }
    hipLaunchKernelGGL(k_multi<PH>, dim3(grid), dim3(NTHREADS), LDS_BYTES, stream, p);
}
__global__ void __launch_bounds__(NTHREADS, 2) k_mega(P p) {
    cg::grid_group grid = cg::this_grid();
    extern __shared__ __attribute__((aligned(16))) unsigned char shm_top[];
    volatile LAS unsigned* st = (volatile LAS unsigned*)((LAS unsigned char*)shm_top + LDS_BYTES - 16);
    if (threadIdx.x == 0) { st[0] = 0u; st[1] = 0u; }
    __syncthreads();
    const XcdBarrier bar = xcd_barrier_post((unsigned*)(p.ws + WS_BAR), st);
#define GSYNC() xcd_barrier(bar)
#define RUNP(ph) do { run_phase(p, ph, 0); if (PROBE_REP == (ph)) { GSYNC(); run_phase(p, ph, 1); } } while (0)
    if (p.ws == nullptr) grid.sync();
    RUNP(PH_PREP); GSYNC();
    RUNP(PH_G1); GSYNC();
    RUNP(PH_G23); GSYNC();
    if (PROBE_REP == 100) { extern __shared__ __attribute__((aligned(16))) unsigned char shm_h[]; phase_hyena(p, (LAS unsigned char*)shm_h); GSYNC(); }
#if NAIVE_HYENA
    run_phase(p, PH_HYP); GSYNC();
    run_phase(p, PH_HYC); GSYNC();
#endif
    RUNP(PH_QKPREP); GSYNC();
    RUNP(PH_ATTN); GSYNC();
    RUNP(PH_G4); GSYNC();
    RUNP(PH_G5); GSYNC();
    RUNP(PH_G6); GSYNC();
    RUNP(PH_G7);
}

extern "C" void kernel_launch(void* const* d_in, const int* in_sizes, int n_in, void* d_out, int out_size, void* d_ws, size_t ws_size, hipStream_t stream) {
    static int grid = 0;
    if (grid == 0) {
        int dev = 0, cus = 0, per_cu = 0;
        hipGetDevice(&dev); hipDeviceGetAttribute(&cus, hipDeviceAttributeMultiprocessorCount, dev);
        if (cus <= 0) cus = 256;
        grid = cus;
#if N_LAUNCH_MODE == 1
        hipFuncSetAttribute((const void*)k_mega, hipFuncAttributeMaxDynamicSharedMemorySize, LDS_BYTES);
        hipOccupancyMaxActiveBlocksPerMultiprocessor(&per_cu, (const void*)k_mega, NTHREADS, LDS_BYTES);
        if (per_cu < 1) { fprintf(stderr, "kernel_launch: occupancy query says %d blocks/CU\n", per_cu); per_cu = 1; }
        grid = cus;
#endif
        if (ws_size < 256 * MiB) fprintf(stderr, "kernel_launch: workspace too small: %zu\n", ws_size);
    }
    P p{};
    const float** pp = (const float**)&p;
    for (int i = 0; i < 32; ++i) pp[i] = (const float*)d_in[i];
    p.out = (float*)d_out; p.ws = (unsigned char*)d_ws;
#if N_LAUNCH_MODE == 1
    hipMemsetAsync((unsigned char*)d_ws + WS_BAR, 0, XCD_BAR_WORDS * 4, stream);
    void* args[] = {&p};
    hipError_t e = hipLaunchCooperativeKernel((const void*)k_mega, dim3(grid), dim3(NTHREADS), args, LDS_BYTES, stream);
    if (e != hipSuccess) fprintf(stderr, "cooperative launch failed: %s (grid %d)\n", hipGetErrorString(e), grid);
#else
    launch_phase<PH_PREP>(p, grid, stream);
    launch_phase<PH_G1>(p, grid, stream);
    launch_phase<PH_G23>(p, grid, stream);
    launch_phase<PH_HYP>(p, grid, stream);
    launch_phase<PH_HYC>(p, grid, stream);
    launch_phase<PH_QKPREP>(p, grid, stream);
    launch_phase<PH_ATTN>(p, grid, stream);
    launch_phase<PH_MIX>(p, grid, stream);
    launch_phase<PH_G4>(p, grid, stream);
    launch_phase<PH_G5>(p, grid, stream);
    launch_phase<PH_G6>(p, grid, stream);
    launch_phase<PH_G7>(p, grid, stream);
#endif
}
```
